# Optimizing an MI355X kernel written in HIP

```python
import math
import jax
import jax.numpy as jnp
from jax import lax
import numpy as np

D_MODEL = 1024
BATCH = 8
SEQ = 8192
DEPTH = 2

N_BRANCH = 3
SSM_GROUP_WIDTH = 16
SSM_GROUPS = 16
D_SSM = SSM_GROUP_WIDTH * SSM_GROUPS
SSM_STATE = 64
SSM_DT_MIN = 1e-3
SSM_DT_MAX = 1e-1
HGRN_HEADS = 4
HGRN_KDIM = 64
HGRN_VDIM = 64
D_HGRN_K = HGRN_HEADS * HGRN_KDIM
D_HGRN_V = HGRN_HEADS * HGRN_VDIM
HGRN_CHUNK = 64
MOBA_HEADS = 4
MOBA_HEAD_DIM = 64
D_MOBA = MOBA_HEADS * MOBA_HEAD_DIM
MOBA_BLOCK = 256
MOBA_TOPK = 3
MOBA_QUERY_BLOCK = 32
IN_WIDTHS = (D_SSM, D_HGRN_K, D_HGRN_K, D_HGRN_V, D_HGRN_V, D_MOBA, D_MOBA, D_MOBA, N_BRANCH * D_MODEL)
D_IN = sum(IN_WIDTHS)
N_EXPERTS = 64
TOP_K = 6
D_EXPERT = 256
D_SHARED = 256
ROUTED_SCALE = 2.5
MOE_ROW_BLOCK = 256
N_MOD = 6
EPS = 1e-6

kernel_name = 'hybrid_s5_hgrn2_moba_moe_adaln'


def rms_norm(x, gain):
    xf = x.astype(jnp.float32)
    y = xf * lax.rsqrt(jnp.mean(xf * xf, axis=-1, keepdims=True) + EPS)
    return y * gain.astype(jnp.float32)


def _complex_affine_combine(earlier, later):
    a1r, a1i, b1r, b1i = earlier
    a2r, a2i, b2r, b2i = later
    return (a2r * a1r - a2i * a1i,
            a2r * a1i + a2i * a1r,
            a2r * b1r - a2i * b1i + b2r,
            a2r * b1i + a2i * b1r + b2i)


def s5_mixer(u, log_dt, lam_re, lam_im, b_re, b_im, c_re, c_im, d_skip, w_glu):
    bsz, seq, _ = u.shape
    f32 = jnp.float32
    ug = u.astype(f32).reshape(bsz, seq, SSM_GROUPS, SSM_GROUP_WIDTH)
    dt = jnp.exp(log_dt.astype(f32))[:, None]
    lr, li = lam_re.astype(f32), lam_im.astype(f32)
    mag = jnp.exp(lr * dt)
    abar_r, abar_i = mag * jnp.cos(li * dt), mag * jnp.sin(li * dt)
    inv = 1.0 / (lr * lr + li * li)
    coef_r = ((abar_r - 1.0) * lr + abar_i * li) * inv
    coef_i = (abar_i * lr - (abar_r - 1.0) * li) * inv
    br, bi = b_re.astype(f32), b_im.astype(f32)
    bbar_r = coef_r[..., None] * br - coef_i[..., None] * bi
    bbar_i = coef_r[..., None] * bi + coef_i[..., None] * br
    bu_r = jnp.einsum('blgh,gph->blgp', ug, bbar_r)
    bu_i = jnp.einsum('blgh,gph->blgp', ug, bbar_i)
    shp = (1, seq, SSM_GROUPS, SSM_STATE)
    a_r = jnp.broadcast_to(abar_r, shp)
    a_i = jnp.broadcast_to(abar_i, shp)
    _, _, s_r, s_i = lax.associative_scan(_complex_affine_combine, (a_r, a_i, bu_r, bu_i), axis=1)
    y = (jnp.einsum('blgp,ghp->blgh', s_r, c_re.astype(f32))
         - jnp.einsum('blgp,ghp->blgh', s_i, c_im.astype(f32)))
    y = (y + d_skip.astype(f32).reshape(SSM_GROUPS, SSM_GROUP_WIDTH) * ug).reshape(bsz, seq, D_SSM)
    z = (jax.nn.gelu(y).astype(u.dtype) @ w_glu).astype(f32)
    return z[..., :D_MODEL] * jax.nn.sigmoid(z[..., D_MODEL:])


def hgrn2_mixer(q, f_raw, inp, g, lower_bound, norm_g, w_o):
    bsz, seq, _ = q.shape
    f32 = jnp.float32
    n_chunks = seq // HGRN_CHUNK
    lb = lower_bound.astype(f32)
    forget = lb + (1.0 - lb) * jax.nn.sigmoid(f_raw.astype(f32))
    log_f = jnp.log(forget)
    key = 1.0 - forget

    def chunks(t, dim):
        return t.astype(f32).reshape(bsz, n_chunks, HGRN_CHUNK, HGRN_HEADS, dim).transpose(1, 0, 3, 2, 4)

    xs = (chunks(q, HGRN_KDIM), chunks(log_f, HGRN_KDIM), chunks(key, HGRN_KDIM), chunks(inp, HGRN_VDIM))
    causal = jnp.tril(jnp.ones((HGRN_CHUNK, HGRN_CHUNK), dtype=bool))[:, :, None]

    def step(state, xc):
        qc, lfc, kc, ic = xc
        cum = jnp.cumsum(lfc, axis=2)
        rel = cum[:, :, :, None, :] - cum[:, :, None, :, :]
        decay = jnp.exp(jnp.where(causal, rel, -jnp.inf))
        scores = jnp.einsum('bhtk,bhtsk,bhsk->bhts', qc, decay, kc)
        out = (jnp.einsum('bhts,bhsv->bhtv', scores, ic)
               + jnp.einsum('bhtk,bhkv->bhtv', qc * jnp.exp(cum), state))
        last = cum[:, :, -1, :]
        state = (jnp.exp(last)[..., None] * state
                 + jnp.einsum('bhsk,bhsv->bhkv', kc * jnp.exp(last[:, :, None, :] - cum), ic))
        return state, out

    s0 = jnp.zeros((bsz, HGRN_HEADS, HGRN_KDIM, HGRN_VDIM), f32)
    _, o = lax.scan(step, s0, xs)
    o = o.transpose(1, 0, 3, 2, 4).reshape(bsz, seq, HGRN_HEADS, HGRN_VDIM)
    o = rms_norm(o, norm_g) * jax.nn.silu(g.astype(f32).reshape(bsz, seq, HGRN_HEADS, HGRN_VDIM))
    return o.reshape(bsz, seq, D_HGRN_V).astype(q.dtype) @ w_o


def moba_mixer(q, k, v, q_norm_g, k_norm_g, w_o):
    bsz, seq, _ = q.shape
    f32 = jnp.float32
    hs = (bsz, seq, MOBA_HEADS, MOBA_HEAD_DIM)
    qh = rms_norm(q.reshape(hs), q_norm_g).transpose(0, 2, 1, 3) * (MOBA_HEAD_DIM ** -0.5)
    kh = rms_norm(k.reshape(hs), k_norm_g).transpose(0, 2, 1, 3)
    vh = v.astype(f32).reshape(hs).transpose(0, 2, 1, 3)
    n_blocks = -(-seq // MOBA_BLOCK)
    pad = ((0, 0), (0, 0), (0, n_blocks * MOBA_BLOCK - seq), (0, 0))
    kb = jnp.pad(kh, pad).reshape(bsz, MOBA_HEADS, n_blocks, MOBA_BLOCK, MOBA_HEAD_DIM)
    vb = jnp.pad(vh, pad).reshape(bsz, MOBA_HEADS, n_blocks, MOBA_BLOCK, MOBA_HEAD_DIM)
    kmean = jnp.mean(kb, axis=3)
    n_sel = min(MOBA_TOPK, n_blocks)
    b_ix = jnp.arange(bsz)[:, None, None, None]
    h_ix = jnp.arange(MOBA_HEADS)[None, :, None, None]
    block_ids = jnp.arange(n_blocks)
    key_offs = jnp.arange(MOBA_BLOCK)
    q_offs = jnp.arange(MOBA_QUERY_BLOCK)

    def query_block(qi):
        t0 = qi * MOBA_QUERY_BLOCK
        qc = lax.dynamic_slice_in_dim(qh, t0, MOBA_QUERY_BLOCK, axis=2)
        qpos = t0 + q_offs
        own = t0 // MOBA_BLOCK
        k_own = lax.dynamic_index_in_dim(kb, own, axis=2, keepdims=False)
        v_own = lax.dynamic_index_in_dim(vb, own, axis=2, keepdims=False)
        s_own = jnp.einsum('bhqd,bhnd->bhqn', qc, k_own)
        s_own = jnp.where((own * MOBA_BLOCK + key_offs)[None, :] <= qpos[:, None], s_own, -jnp.inf)
        gate = jnp.einsum('bhqd,bhjd->bhqj', qc, kmean)
        gate = jnp.where(block_ids < own, gate, -jnp.inf)
        _, sel = lax.top_k(gate, n_sel)
        valid = sel < own
        k_sel = kb[b_ix, h_ix, sel]
        v_sel = vb[b_ix, h_ix, sel]
        s_sel = jnp.einsum('bhqd,bhqjnd->bhqjn', qc, k_sel)
        s_sel = jnp.where(valid[..., None], s_sel, -jnp.inf)
        s = jnp.concatenate(
            [s_own, s_sel.reshape(bsz, MOBA_HEADS, MOBA_QUERY_BLOCK, n_sel * MOBA_BLOCK)], axis=-1)
        p = jax.nn.softmax(s, axis=-1)
        p_own = p[..., :MOBA_BLOCK]
        p_sel = p[..., MOBA_BLOCK:].reshape(bsz, MOBA_HEADS, MOBA_QUERY_BLOCK, n_sel, MOBA_BLOCK)
        return (jnp.einsum('bhqn,bhnd->bhqd', p_own, v_own)
                + jnp.einsum('bhqjn,bhqjnd->bhqd', p_sel, v_sel))

    o = lax.map(query_block, jnp.arange(seq // MOBA_QUERY_BLOCK))
    o = o.transpose(1, 0, 3, 2, 4).reshape(bsz, seq, D_MOBA)
    return o.astype(q.dtype) @ w_o


def moe_ffn(h, router_w, router_bias, w_gate, w_up, w_down, s_gate, s_up, s_down):
    bsz, seq, dm = h.shape
    f32 = jnp.float32
    n_tok = bsz * seq
    hf = h.reshape(n_tok, dm)
    scores = jax.nn.sigmoid((hf @ router_w).astype(f32))
    _, top_idx = lax.top_k(scores + router_bias.astype(f32), TOP_K)
    top_s = jnp.take_along_axis(scores, top_idx, axis=-1)
    top_w = top_s / jnp.sum(top_s, axis=-1, keepdims=True) * ROUTED_SCALE
    n_assign = n_tok * TOP_K
    e_flat = top_idx.reshape(n_assign)
    t_flat = jnp.repeat(jnp.arange(n_tok, dtype=jnp.int32), TOP_K)
    w_flat = top_w.reshape(n_assign)
    order = jnp.argsort(e_flat)
    e_sorted = e_flat[order]
    counts = jnp.bincount(e_flat, length=N_EXPERTS)
    starts = jnp.cumsum(counts) - counts
    padded = (counts + MOE_ROW_BLOCK - 1) // MOE_ROW_BLOCK * MOE_ROW_BLOCK
    padded_end = jnp.cumsum(padded)
    dest = (padded_end - padded)[e_sorted] + jnp.arange(n_assign) - starts[e_sorted]
    n_blocks = -(-n_assign // MOE_ROW_BLOCK) + N_EXPERTS
    n_rows = n_blocks * MOE_ROW_BLOCK
    row_tok = jnp.full((n_rows,), n_tok, jnp.int32).at[dest].set(t_flat[order])
    row_w = jnp.zeros((n_rows,), f32).at[dest].set(w_flat[order])
    block_expert = jnp.minimum(
        jnp.searchsorted(padded_end, jnp.arange(n_blocks) * MOE_ROW_BLOCK, side='right'), N_EXPERTS - 1)

    def block(acc, bi):
        rows = lax.dynamic_slice_in_dim(row_tok, bi * MOE_ROW_BLOCK, MOE_ROW_BLOCK)
        wts = lax.dynamic_slice_in_dim(row_w, bi * MOE_ROW_BLOCK, MOE_ROW_BLOCK)
        e = block_expert[bi]
        xb = jnp.take(hf, rows, axis=0, mode='fill', fill_value=0)
        hid = jax.nn.silu(xb @ w_gate[e]) * (xb @ w_up[e])
        yb = (hid @ w_down[e]).astype(f32) * wts[:, None]
        return acc.at[rows].add(yb, mode='drop'), None

    routed, _ = lax.scan(block, jnp.zeros((n_tok, dm), f32), jnp.arange(n_blocks))
    shared = (jax.nn.silu(hf @ s_gate) * (hf @ s_up)) @ s_down
    return (routed + shared.astype(f32)).reshape(bsz, seq, dm)


def setup_inputs(seed: int = 0) -> dict:
    key = jax.random.key(seed)
    k = jax.random.split(key, 32)
    f32 = jnp.float32

    def normal(kk, shape, scale):
        return jax.random.normal(kk, shape, f32) * scale

    def gain(kk, shape):
        return 1.0 + normal(kk, shape, 0.02)

    L, D, G, P, GW = DEPTH, D_MODEL, SSM_GROUPS, SSM_STATE, SSM_GROUP_WIDTH
    lam_im_base = jnp.pi * jnp.arange(P, dtype=f32)
    return {
        'x': normal(k[0], (BATCH, SEQ, D), 1.0),
        'c': normal(k[1], (BATCH, D), 1.0),
        'ada_w': normal(k[2], (L, D, N_MOD * D), 0.5 * D ** -0.5),
        'ada_b': normal(k[3], (L, N_MOD * D), 0.02),
        'norm1_g': gain(k[4], (L, D)),
        'w_in': normal(k[5], (L, D, D_IN), D ** -0.5),
        'ssm_log_dt': jax.random.uniform(k[6], (L, G), f32, math.log(SSM_DT_MIN), math.log(SSM_DT_MAX)),
        'ssm_lambda_re': -0.5 + normal(k[7], (L, G, P), 0.01),
        'ssm_lambda_im': lam_im_base + normal(k[8], (L, G, P), 0.01),
        'ssm_b_re': normal(k[9], (L, G, P, GW), (2 * GW) ** -0.5),
        'ssm_b_im': normal(k[10], (L, G, P, GW), (2 * GW) ** -0.5),
        'ssm_c_re': normal(k[11], (L, G, GW, P), (2 * P) ** -0.5),
        'ssm_c_im': normal(k[12], (L, G, GW, P), (2 * P) ** -0.5),
        'ssm_d': normal(k[13], (L, D_SSM), 1.0),
        'ssm_w_glu': normal(k[14], (L, D_SSM, 2 * D), D_SSM ** -0.5),
        'hgrn_lb_logits': normal(k[15], (L, D_HGRN_K), 1.0),
        'hgrn_norm_g': gain(k[16], (L, HGRN_VDIM)),
        'hgrn_w_o': normal(k[17], (L, D_HGRN_V, D), D_HGRN_V ** -0.5),
        'moba_q_norm_g': gain(k[18], (L, MOBA_HEAD_DIM)),
        'moba_k_norm_g': gain(k[19], (L, MOBA_HEAD_DIM)),
        'moba_w_o': normal(k[20], (L, D_MOBA, D), D_MOBA ** -0.5),
        'w_out': normal(k[21], (L, D, D), D ** -0.5),
        'norm2_g': gain(k[22], (L, D)),
        'router_w': normal(k[23], (L, D, N_EXPERTS), D ** -0.5),
        'router_bias': normal(k[24], (L, N_EXPERTS), 0.01),
        'exp_w_gate': normal(k[25], (L, N_EXPERTS, D, D_EXPERT), D ** -0.5),
        'exp_w_up': normal(k[26], (L, N_EXPERTS, D, D_EXPERT), D ** -0.5),
        'exp_w_down': normal(k[27], (L, N_EXPERTS, D_EXPERT, D), D_EXPERT ** -0.5),
        'shared_w_gate': normal(k[28], (L, D, D_SHARED), D ** -0.5),
        'shared_w_up': normal(k[29], (L, D, D_SHARED), D ** -0.5),
        'shared_w_down': normal(k[30], (L, D_SHARED, D), D_SHARED ** -0.5),
    }


def reference(x, c, ada_w, ada_b, norm1_g, w_in, ssm_log_dt, ssm_lambda_re, ssm_lambda_im,
              ssm_b_re, ssm_b_im, ssm_c_re, ssm_c_im, ssm_d, ssm_w_glu, hgrn_lb_logits,
              hgrn_norm_g, hgrn_w_o, moba_q_norm_g, moba_k_norm_g, moba_w_o, w_out, norm2_g,
              router_w, router_bias, exp_w_gate, exp_w_up, exp_w_down, shared_w_gate,
              shared_w_up, shared_w_down):
    f32 = jnp.float32
    bsz, seq, _ = x.shape
    lb_cum = jnp.cumsum(jax.nn.softmax(hgrn_lb_logits.astype(f32), axis=0), axis=0)
    lower_bounds = lb_cum - lb_cum[0:1]
    cond = jax.nn.silu(c.astype(f32))
    splits = np.cumsum(IN_WIDTHS)[:-1].tolist()
    for l in range(DEPTH):
        mod = cond @ ada_w[l].astype(f32) + ada_b[l].astype(f32)
        shift1, scale1, gate1, shift2, scale2, gate2 = [m[:, None, :] for m in jnp.split(mod, N_MOD, axis=-1)]
        h = (rms_norm(x, norm1_g[l]) * (1.0 + scale1) + shift1).astype(x.dtype)
        proj = h @ w_in[l]
        u, hq, hf, hi, hg, mq, mk, mv, gl = jnp.split(proj, splits, axis=-1)
        y_a = s5_mixer(u, ssm_log_dt[l], ssm_lambda_re[l], ssm_lambda_im[l], ssm_b_re[l], ssm_b_im[l],
                       ssm_c_re[l], ssm_c_im[l], ssm_d[l], ssm_w_glu[l])
        y_b = hgrn2_mixer(hq, hf, hi, hg, lower_bounds[l], hgrn_norm_g[l], hgrn_w_o[l])
        y_c = moba_mixer(mq, mk, mv, moba_q_norm_g[l], moba_k_norm_g[l], moba_w_o[l])
        gates = jax.nn.sigmoid(gl.astype(f32)).reshape(bsz, seq, N_BRANCH, D_MODEL)
        merged = gates[:, :, 0] * y_a + gates[:, :, 1] * y_b + gates[:, :, 2] * y_c
        x = x + (gate1 * (merged.astype(x.dtype) @ w_out[l])).astype(x.dtype)
        h2 = (rms_norm(x, norm2_g[l]) * (1.0 + scale2) + shift2).astype(x.dtype)
        y_ffn = moe_ffn(h2, router_w[l], router_bias[l], exp_w_gate[l], exp_w_up[l], exp_w_down[l],
                        shared_w_gate[l], shared_w_up[l], shared_w_down[l])
        x = x + (gate2 * y_ffn).astype(x.dtype)
    return x
```

```cpp
#include <hip/hip_runtime.h>
#include <cstdio>
#include <cstdint>

#define GAS __attribute__((address_space(1)))
#define LAS __attribute__((address_space(3)))
typedef unsigned short bf16;
typedef short bf16x8 __attribute__((ext_vector_type(8)));
typedef float f32x4 __attribute__((ext_vector_type(4)));
typedef float f32x2 __attribute__((ext_vector_type(2)));
typedef unsigned u32x4 __attribute__((ext_vector_type(4)));
typedef unsigned u32x2 __attribute__((ext_vector_type(2)));
typedef GAS unsigned gu32;
#define RLX_AGENT __ATOMIC_RELAXED, __HIP_MEMORY_SCOPE_AGENT
#define LDS_WAIT() asm volatile("s_waitcnt lgkmcnt(0)" ::: "memory")
#define VM_WAIT() asm volatile("s_waitcnt vmcnt(0)" ::: "memory")
#define DI __device__ __forceinline__

DI unsigned f2bf(float f) { unsigned u = __builtin_bit_cast(unsigned, f); return (u + 0x7fffu + ((u >> 16) & 1u)) >> 16; }
DI unsigned pk2(float lo, float hi) { return f2bf(lo) | (f2bf(hi) << 16); }
DI float bflo(unsigned w) { return __builtin_bit_cast(float, w << 16); }
DI float bfhi(unsigned w) { return __builtin_bit_cast(float, w & 0xffff0000u); }
DI float bf2f(bf16 b) { return __builtin_bit_cast(float, ((unsigned)b) << 16); }
DI unsigned cvt_pk_bf16(float lo, float hi) { unsigned r; asm volatile("v_cvt_pk_bf16_f32 %0, %1, %2" : "=v"(r) : "v"(lo), "v"(hi)); return r; }
DI float fsigmoid(float x) { return __builtin_amdgcn_rcpf(1.0f + __builtin_amdgcn_exp2f(-1.4426950408889634f * x)); }
DI float fsilu(float x) { return x * fsigmoid(x); }
DI float fexp(float x) { return __builtin_amdgcn_exp2f(1.4426950408889634f * x); }
DI float gelu_tanh(float y) { const float z = 1.5957691216057308f * (y + 0.044715f * y * y * y); return y * fsigmoid(z); }
DI void unpack8(const u32x4 w, float (&o)[8]) { o[0] = bflo(w.x); o[1] = bfhi(w.x); o[2] = bflo(w.y); o[3] = bfhi(w.y); o[4] = bflo(w.z); o[5] = bfhi(w.z); o[6] = bflo(w.w); o[7] = bfhi(w.w); }
DI u32x4 pack8(const float (&v)[8]) { u32x4 w; w.x = cvt_pk_bf16(v[0], v[1]); w.y = cvt_pk_bf16(v[2], v[3]); w.z = cvt_pk_bf16(v[4], v[5]); w.w = cvt_pk_bf16(v[6], v[7]); return w; }

namespace pg8 {
constexpr int BM = 256, BK = 64, HALF = 128, HTB = HALF * BK * 2, STAGE_BYTES = 8 * HTB, NXCD = 8, WGM = 8;
__host__ __device__ __forceinline__ int lds_byte(int r, int c) { const int st = (r >> 4) * 2 + (c >> 5), rr = r & 15, cc = c & 31, ob = rr * 64 + cc * 2; return st * 1024 + (ob ^ (((ob >> 9) & 1) << 5)); }
__host__ __device__ __forceinline__ void stage_rc(int b, int& R, int& C) { const int st = b / 1024, sb = b % 1024, swz = sb ^ (((sb >> 9) & 1) << 5); R = (st >> 1) * 16 + swz / 64; C = (st & 1) * 32 + (swz % 64) / 2; }
__host__ __device__ __forceinline__ int perm32(int rho) { const int n = rho >> 4, i = rho & 15; return 8 * (i >> 2) + 4 * n + (i & 3); }

struct GU { const char* A; const char* A2; const char* B; int nt1, nt, kstepA, kstepA2, bjump, pm, pn, e, lda, lda2; };

struct TileOrder {
    int nM, nN, nwg, G, c;
    DI void init(int M, int N, int G_, int c_) { nM = M / BM; nN = N / BM; nwg = nM * nN; G = G_; c = c_; }
    DI bool next(int i, int& pm, int& pn) const {
        const long L = (long)i * G + c; if (L >= nwg) return false;
        int wgid = (int)L; { const int q = nwg / NXCD, r = nwg % NXCD, xcd = wgid % NXCD, off = wgid / NXCD; wgid = (xcd < r ? xcd * (q + 1) : r * (q + 1) + (xcd - r) * q) + off; }
        const int nig = WGM * nN, gid = wgid / nig, fm = gid * WGM, gsz = (nM - fm) < WGM ? (nM - fm) : WGM;
        pm = fm + ((wgid % nig) % gsz); pn = (wgid % nig) / gsz; return true;
    }
};

template <class P>
__device__ __forceinline__ void gemm_phase(LAS unsigned char* lds, const P& S) {
    int tid = threadIdx.x; asm volatile("" : "+v"(tid));
    const int wid = __builtin_amdgcn_readfirstlane(tid >> 6), lane = tid & 63, wr = wid >> 2, wc = wid & 3, fr = lane & 15, fq = lane >> 4;
    int R[2], C[2]; unsigned voffB[2], voffA1[2], voffA2[2];
#pragma unroll
    for (int i = 0; i < 2; ++i) { stage_rc(tid * 16 + i * 8192, R[i], C[i]); const int Rb = P::PERM ? ((R[i] & ~31) + perm32(R[i] & 31)) : R[i]; voffB[i] = (unsigned)(Rb * S.ldb + C[i]) * 2u;
        voffA1[i] = (unsigned)(R[i] * S.lda + C[i]) * 2u; voffA2[i] = (unsigned)(R[i] * (S.lda2 - S.lda)) * 2u; }
    const unsigned hstepB = (unsigned)HALF * (unsigned)S.ldb * 2u;
    const unsigned ldsw = (unsigned)wid * 1024u;
    const int aoff = lds_byte(wr * 64 + fr, fq * 8), boff = lds_byte(wc * 32 + fr, fq * 8);
#define PG8_SA(b, h) (((b) * 2 + (h)) * HTB)
#define PG8_SB(b, h) ((4 + (b) * 2 + (h)) * HTB)
#define PG8_STAGE_A(bufoff, h, U, V, t) do { const int _t = (t); const bool _s2 = P::SEG2 && (_t >= (U).nt1); \
        const char* _gb = (_s2 ? (U).A2 + (size_t)(_t - (U).nt1) * (size_t)(U).kstepA2 : (U).A + (size_t)_t * (size_t)(U).kstepA) + (P::GATHER ? (size_t)0 : (size_t)(h) * (size_t)(128 * 2) * (size_t)(_s2 ? S.lda2 : S.lda)); \
        _Pragma("unroll") for (int _i = 0; _i < 2; ++_i) { const unsigned _o = P::GATHER ? (V)[h][_i] : (P::SEG2 ? (voffA1[_i] + (voffA2[_i] & (0u - (unsigned)_s2))) : voffA1[_i]); \
        __builtin_amdgcn_global_load_lds((const unsigned*)(_gb + _o), (LAS unsigned*)(lds + (bufoff) + ldsw + _i * 8192), 16, 0, 0); } } while (0)
#define PG8_STAGE_B(bufoff, h, U, t) do { const int _t = (t); const char* _gb = (U).B + (size_t)(h) * hstepB + (size_t)_t * 128u + ((P::SEG2 && _t >= (U).nt1) ? (size_t)(U).bjump : (size_t)0); \
        _Pragma("unroll") for (int _i = 0; _i < 2; ++_i) __builtin_amdgcn_global_load_lds((const unsigned*)(_gb + voffB[_i]), (LAS unsigned*)(lds + (bufoff) + ldsw + _i * 8192), 16, 0, 0); } while (0)
#define PG8_LDA(dst, b, h) do { _Pragma("unroll") for (int m = 0; m < 4; ++m) _Pragma("unroll") for (int k = 0; k < 2; ++k) dst[m][k] = *(const LAS bf16x8*)(lds + PG8_SA(b, h) + aoff + m * 2048 + k * 1024); } while (0)
#define PG8_LDB(dst, b, h) do { _Pragma("unroll") for (int n = 0; n < 2; ++n) _Pragma("unroll") for (int k = 0; k < 2; ++k) dst[n][k] = *(const LAS bf16x8*)(lds + PG8_SB(b, h) + boff + n * 2048 + k * 1024); } while (0)
#define PG8_MMA(ai, bj, At, Bt) do { __builtin_amdgcn_s_setprio(1); _Pragma("unroll") for (int m = 0; m < 4; ++m) _Pragma("unroll") for (int n = 0; n < 2; ++n) _Pragma("unroll") for (int k = 0; k < 2; ++k) \
        acc[ai][bj][m][n] = __builtin_amdgcn_mfma_f32_16x16x32_bf16(Bt[n][k], At[m][k], acc[ai][bj][m][n], 0, 0, 0); __builtin_amdgcn_s_setprio(0); } while (0)
#define PG8_WAIT_V(n) asm volatile("s_waitcnt vmcnt(" #n ")" ::: "memory")
#define PG8_WAIT_L(n) asm volatile("s_waitcnt lgkmcnt(" #n ")" ::: "memory")
#define PG8_BAR __builtin_amdgcn_s_barrier()
#define PG8_SCHED __builtin_amdgcn_sched_barrier(0)
    GU cur, nxt; int ui = 0;
    if (!S.next(0, cur)) return;
    unsigned vAc[2][2], vAn[2][2];
    if constexpr (P::GATHER) S.avoff(cur, R, C, vAc); else { vAc[0][0] = vAc[0][1] = vAc[1][0] = vAc[1][1] = 0u; }
    f32x4 acc[2][2][4][2];
#pragma unroll
    for (int a = 0; a < 2; ++a)
#pragma unroll
        for (int b = 0; b < 2; ++b)
#pragma unroll
            for (int m = 0; m < 4; ++m)
#pragma unroll
                for (int n = 0; n < 2; ++n) acc[a][b][m][n] = (f32x4){0.f, 0.f, 0.f, 0.f};
    bf16x8 At[4][2], B0[2][2], B1[2][2];
    PG8_STAGE_B(PG8_SB(0, 0), 0, cur, 0); PG8_STAGE_B(PG8_SB(0, 1), 1, cur, 0); PG8_STAGE_A(PG8_SA(0, 0), 0, cur, vAc, 0); PG8_STAGE_A(PG8_SA(0, 1), 1, cur, vAc, 0);
    if (wr == 1) PG8_BAR;
    PG8_WAIT_V(2); PG8_BAR;
    PG8_STAGE_B(PG8_SB(1, 0), 0, cur, 1); PG8_STAGE_A(PG8_SA(1, 0), 0, cur, vAc, 1); PG8_STAGE_B(PG8_SB(1, 1), 1, cur, 1);
    PG8_WAIT_V(6); PG8_BAR;
    for (;;) {
        const bool has_next = S.next(ui + 1, nxt);
        if (!has_next) nxt = cur;
        if constexpr (P::GATHER) { if (has_next) S.avoff(nxt, R, C, vAn); else {
#pragma unroll
            for (int h = 0; h < 2; ++h)
#pragma unroll
                for (int i = 0; i < 2; ++i) vAn[h][i] = vAc[h][i]; } }
        else { vAn[0][0] = vAn[0][1] = vAn[1][0] = vAn[1][1] = 0u; }
        const int nt = cur.nt;
        for (int t = 0; t < nt; t += 2) {
            const bool last = (t == nt - 2);
            GU U2 = cur; unsigned V2a[2][2]; int t2 = t + 2;
#pragma unroll
            for (int h = 0; h < 2; ++h)
#pragma unroll
                for (int i = 0; i < 2; ++i) V2a[h][i] = (P::GATHER && last) ? vAn[h][i] : vAc[h][i];
            if (last) { U2 = nxt; t2 = 0; }
            const int t3 = t2 + 1;
            PG8_LDB(B0, 0, 0); PG8_LDB(B1, 0, 1); PG8_SCHED; PG8_LDA(At, 0, 0); PG8_STAGE_A(PG8_SA(1, 1), 1, cur, vAc, t + 1);
            PG8_WAIT_V(8); PG8_WAIT_L(0); PG8_BAR; PG8_MMA(0, 0, At, B0); PG8_MMA(0, 1, At, B1); PG8_BAR; PG8_SCHED;
            PG8_LDA(At, 0, 1); PG8_STAGE_B(PG8_SB(0, 0), 0, U2, t2); PG8_STAGE_B(PG8_SB(0, 1), 1, U2, t2); PG8_STAGE_A(PG8_SA(0, 0), 0, U2, V2a, t2);
            PG8_WAIT_V(8); PG8_WAIT_L(0); PG8_BAR; PG8_MMA(1, 0, At, B0); PG8_MMA(1, 1, At, B1); PG8_BAR; PG8_SCHED;
            PG8_LDB(B0, 1, 0); PG8_LDB(B1, 1, 1); PG8_SCHED; PG8_LDA(At, 1, 0); PG8_STAGE_A(PG8_SA(0, 1), 1, U2, V2a, t2);
            PG8_WAIT_V(8); PG8_WAIT_L(0); PG8_BAR; PG8_MMA(0, 0, At, B0); PG8_MMA(0, 1, At, B1); PG8_BAR; PG8_SCHED;
            PG8_LDA(At, 1, 1); PG8_STAGE_B(PG8_SB(1, 0), 0, U2, t3); PG8_STAGE_B(PG8_SB(1, 1), 1, U2, t3); PG8_STAGE_A(PG8_SA(1, 0), 0, U2, V2a, t3);
            PG8_WAIT_V(8); PG8_WAIT_L(0); PG8_BAR; PG8_MMA(1, 0, At, B0); PG8_MMA(1, 1, At, B1); PG8_BAR; PG8_SCHED;
        }
        if (wr == 0) PG8_BAR;
        S.epi(acc, cur, wr, wc, fr, fq);
        if (!has_next) break;
#pragma unroll
        for (int a = 0; a < 2; ++a)
#pragma unroll
            for (int b = 0; b < 2; ++b)
#pragma unroll
                for (int m = 0; m < 4; ++m)
#pragma unroll
                    for (int n = 0; n < 2; ++n) acc[a][b][m][n] = (f32x4){0.f, 0.f, 0.f, 0.f};
        cur = nxt;
#pragma unroll
        for (int h = 0; h < 2; ++h)
#pragma unroll
            for (int i = 0; i < 2; ++i) vAc[h][i] = vAn[h][i];
        ++ui;
        if (wr == 1) PG8_BAR;
    }
    PG8_WAIT_V(0);
    PG8_BAR;
#undef PG8_SA
#undef PG8_SB
#undef PG8_STAGE_A
#undef PG8_STAGE_B
#undef PG8_LDA
#undef PG8_LDB
#undef PG8_MMA
#undef PG8_WAIT_V
#undef PG8_WAIT_L
#undef PG8_BAR
#undef PG8_SCHED
}
}
#include <hip/hip_bf16.h>
#include <cmath>
namespace attn_body {
using bf16=__hip_bfloat16;
using bf16x8=__attribute__((ext_vector_type(8)))short;
using s16x4=__attribute__((ext_vector_type(4)))short;
using f32x16=__attribute__((ext_vector_type(16)))float;
using u32x4=__attribute__((ext_vector_type(4)))unsigned;
constexpr int BATCH=8,NHEAD=4,SEQ=8192,D=64,DM=1792;
constexpr int NW=8,QBLK=32,QB=QBLK*NW,KVBLK=64,NQB=SEQ/QB;
constexpr int ATTN_PITCH=DM, ATTN_UNIT_ROWS=QB, OPITCH=256;
__device__ __forceinline__ int crow(int r,int hi){return (r&3)+8*(r>>2)+4*hi;}
#define SBAR() __builtin_amdgcn_sched_barrier(0)
__device__ __forceinline__ void cmask(f32x16&p0,f32x16&p1,int jb,int qrel,int hi){
  const float NEG=-INFINITY; int kb=64*jb+4*hi;
  #pragma unroll
  for(int r=0;r<16;++r){int kv=kb+(r&3)+8*(r>>2); if(kv>qrel)p0[r]=NEG; if(kv+32>qrel)p1[r]=NEG;}
}

__device__ __forceinline__ void bmask(f32x16&p0,f32x16&p1,bool keep){ if(!keep){
  #pragma unroll
  for(int r=0;r<16;++r){p0[r]=-120.f;p1[r]=-120.f;} } }
constexpr int NSLOT=3, SLOTB=8192;
constexpr int LDS_K=0, LDS_V=NSLOT*SLOTB, LDS_WS=2*NSLOT*SLOTB, LDS_OST=LDS_WS+NW*64*4, LDS_BYTES=LDS_OST+NW*4096;
constexpr float C2=0.125f*1.4426950408889634f;
__device__ __forceinline__ void glds16(const void*gsrc,unsigned lds_dst){unsigned keep;
  asm volatile("s_mov_b32 %0, m0\n\ts_mov_b32 m0, %2\n\ts_nop 0\n\tglobal_load_lds_dwordx4 %1, off\n\ts_mov_b32 m0, %0":"=&s"(keep):"v"(gsrc),"s"(lds_dst):"memory");}
__device__ __forceinline__ float max3f(float a,float b,float c){float r;asm("v_max3_f32 %0, %1, %2, %3":"=v"(r):"v"(a),"v"(b),"v"(c));return r;}
__device__ __forceinline__ float max2f(float a,float b){float r;asm("v_max_f32_e32 %0, %1, %2":"=v"(r):"v"(a),"v"(b));return r;}
__device__ __forceinline__ float fadd_s(float a,float b){float r;asm("v_add_f32_e32 %0, %1, %2":"=v"(r):"v"(a),"v"(b));return r;}
__device__ __forceinline__ float fsub_s(float a,float b){float r;asm("v_sub_f32_e32 %0, %1, %2":"=v"(r):"v"(a),"v"(b));return r;}
typedef float f32x2_t __attribute__((ext_vector_type(2))); typedef __bf16 bf16x2_t __attribute__((ext_vector_type(2)));
__device__ __forceinline__ unsigned cvtpk_s(float lo,float hi){f32x2_t v={lo,hi};bf16x2_t b=__builtin_convertvector(v,bf16x2_t);return __builtin_bit_cast(unsigned,b);}
#define WAIT_BAR(N) asm volatile("s_waitcnt vmcnt(" #N ") lgkmcnt(0)\n\ts_barrier":::"memory")

__device__ __forceinline__ void qkt(f32x16&p0,f32x16&p1,const char*Kslot,const bf16x8*qr,const f32x16&negm,int r32,int hi){
  const char*kb=Kslot+hi*1024+r32*16;
  #pragma unroll
  for(int d0=0;d0<4;++d0){
    const bf16x8 b0=*reinterpret_cast<const bf16x8*>(kb+d0*2048);
    const bf16x8 b1=*reinterpret_cast<const bf16x8*>(kb+d0*2048+512);
    if(d0==0){p0=__builtin_amdgcn_mfma_f32_32x32x16_bf16(b0,qr[0],negm,0,0,0);p1=__builtin_amdgcn_mfma_f32_32x32x16_bf16(b1,qr[0],negm,0,0,0);}
    else{p0=__builtin_amdgcn_mfma_f32_32x32x16_bf16(b0,qr[d0],p0,0,0,0);p1=__builtin_amdgcn_mfma_f32_32x32x16_bf16(b1,qr[d0],p1,0,0,0);}}
}
typedef __attribute__((address_space(3))) const char* lds_cptr;
typedef short v4i16_t __attribute__((ext_vector_type(4)));
__device__ __forceinline__ void kload8(bf16x8*kf,lds_cptr kp){
  kf[0]=*(const __attribute__((address_space(3))) bf16x8*)(kp);      kf[1]=*(const __attribute__((address_space(3))) bf16x8*)(kp+512);
  kf[2]=*(const __attribute__((address_space(3))) bf16x8*)(kp+2048); kf[3]=*(const __attribute__((address_space(3))) bf16x8*)(kp+2560);
  kf[4]=*(const __attribute__((address_space(3))) bf16x8*)(kp+4096); kf[5]=*(const __attribute__((address_space(3))) bf16x8*)(kp+4608);
  kf[6]=*(const __attribute__((address_space(3))) bf16x8*)(kp+6144); kf[7]=*(const __attribute__((address_space(3))) bf16x8*)(kp+6656);
}
__device__ __forceinline__ void kload2(bf16x8*kf,lds_cptr kp,int j){ kf[2*j]=*(const __attribute__((address_space(3))) bf16x8*)(kp+j*2048); kf[2*j+1]=*(const __attribute__((address_space(3))) bf16x8*)(kp+j*2048+512); }
__device__ __forceinline__ s16x4 vtr(lds_cptr p){ return __builtin_bit_cast(s16x4,__builtin_amdgcn_ds_read_tr16_b64_v4i16((__attribute__((address_space(3))) v4i16_t*)p)); }
__device__ __forceinline__ float rowmax(const f32x16&p0,const f32x16&p1){
  float a=max3f(p0[0],p0[1],p1[0]),b=max3f(p0[2],p0[3],p1[1]);a=max3f(a,p1[2],p1[3]);
  #pragma unroll
  for(int r=4;r<16;r+=4){a=max3f(a,p0[r],p0[r+1]);b=max3f(b,p0[r+2],p0[r+3]);a=max3f(a,p1[r],p1[r+1]);b=max3f(b,p1[r+2],p1[r+3]);}
  const float m=max2f(a,b);
  auto rr=__builtin_amdgcn_permlane32_swap(__float_as_uint(m),__float_as_uint(m),false,false);
  return max2f(__uint_as_float(rr[0]),__uint_as_float(rr[1]));
}
__device__ __forceinline__ void pv(f32x16*o,int vb,bf16x8 pa0,bf16x8 pa1,bf16x8 pa2,bf16x8 pa3){
  #pragma unroll
  for(int d0=0;d0<2;++d0){s16x4 lo[4],hi[4];
    #pragma unroll
    for(int ks=0;ks<4;++ks){
      asm volatile("ds_read_b64_tr_b16 %0,%1 offset:%c2":"=&v"(lo[ks]):"v"(vb),"i"(d0*4096+ks*1024):"memory");
      asm volatile("ds_read_b64_tr_b16 %0,%1 offset:%c2":"=&v"(hi[ks]):"v"(vb),"i"(d0*4096+ks*1024+512):"memory");}
    asm volatile("s_waitcnt lgkmcnt(0)":::"memory");SBAR();
    #define PK(k) (bf16x8){lo[k][0],lo[k][1],lo[k][2],lo[k][3],hi[k][0],hi[k][1],hi[k][2],hi[k][3]}
    o[d0]=__builtin_amdgcn_mfma_f32_32x32x16_bf16(pa0,PK(0),o[d0],0,0,0);
    o[d0]=__builtin_amdgcn_mfma_f32_32x32x16_bf16(pa1,PK(1),o[d0],0,0,0);
    o[d0]=__builtin_amdgcn_mfma_f32_32x32x16_bf16(pa2,PK(2),o[d0],0,0,0);
    o[d0]=__builtin_amdgcn_mfma_f32_32x32x16_bf16(pa3,PK(3),o[d0],0,0,0);
    #undef PK
  }
}

#ifndef ATTN_STORE16
#define ATTN_STORE16(p,v) (*(u32x4*)(p)=(v))
#endif
template<int THRL> __device__ __forceinline__ void attn_unit(int b,int h,int qb,const bf16*Q,const bf16*__restrict__ K,const bf16*__restrict__ V,bf16*O,const unsigned*SELM,char*shm){
  int tid_=threadIdx.x; asm volatile("":"+v"(tid_)); const int tid=tid_,lane=tid&63,r32=lane&31,hi=lane>>5; const int wid=__builtin_amdgcn_readfirstlane(tid>>6);
  const long rowbase=(long)b*SEQ; const int q0=qb*QB;
  const bf16*Qw=Q+(rowbase+q0+wid*QBLK)*DM+h*D;
  const bf16*Kh=K+rowbase*DM+h*D,*Vh=V+rowbase*DM+h*D;
  const unsigned lds0=(unsigned)(uintptr_t)shm;
  float*wsf=(float*)(shm+LDS_WS)+wid*64;
  const bf16*ksrc=Kh+(long)lane*DM+wid*8;
  const bf16*vsrc=Vh+(long)(16*(wid&3)+(lane>>2))*DM+(wid>>2)*32+(lane&3)*8;
  const unsigned kdst=lds0+LDS_K+wid*1024, vdst=lds0+LDS_V+wid*1024;
  #define DMA_K(t,slot) glds16(ksrc+(long)(t)*KVBLK*DM,(unsigned)__builtin_amdgcn_readfirstlane(kdst+(slot)))
  #define DMA_V(t,slot) glds16(vsrc+(long)(t)*KVBLK*DM,(unsigned)__builtin_amdgcn_readfirstlane(vdst+(slot)))
  const int vb0=(int)(lds0+LDS_V)+((lane>>4)&1)*32+(lane&3)*8+(4*hi+((lane&15)>>2))*64;
  const char*Kbase=shm+LDS_K; bf16x8 kf[8];
  const lds_cptr shm3=(lds_cptr)shm; const lds_cptr kp0=shm3+LDS_K+hi*1024+r32*16; const lds_cptr vp0=shm3+LDS_V+((lane>>4)&1)*32+(lane&3)*8+(4*hi+((lane&15)>>2))*64;
  const int NT=(q0+QB)/KVBLK;
  DMA_K(0,0);DMA_V(0,0);DMA_K(1,SLOTB);
  bf16x8 qr[4];
  #pragma unroll
  for(int d0=0;d0<4;++d0)qr[d0]=*reinterpret_cast<const bf16x8*>(&Qw[(long)r32*DM+d0*16+hi*8]);
  float mhat=0.f,l_reg=0.f;f32x16 o[2];o[0]=f32x16{};o[1]=f32x16{};f32x16 negm=f32x16{};asm volatile("":"+v"(negm));
  const int qrel=wid*QBLK+r32;
  const unsigned selm=SELM[(rowbase+q0+qrel)*NHEAD+h];
  #define CMASK(P0,P1,t) do{int jb_=(t)-(NT-4); if(jb_>=0)cmask(P0,P1,jb_,qrel,hi); else bmask(P0,P1,((selm>>((t)>>2))&1u)!=0u);}while(0)
  bool resc=false;
  #define START(P0,P1) do{ const float rm=rowmax(P0,P1); resc=false; \
    { const float dl=__builtin_fmaxf(rm,-60.f); mhat=fadd_s(mhat,dl); \
      _Pragma("unroll") for(int r=0;r<16;++r){P0[r]=fsub_s(P0[r],dl);P1[r]=fsub_s(P1[r],dl);} \
      _Pragma("unroll") for(int r=0;r<16;++r)negm[r]=-mhat; asm volatile("":"+v"(negm)); } \
    _Pragma("unroll") for(int r=0;r<16;++r)P0[r]=__builtin_amdgcn_exp2f(P0[r]); }while(0)
  #define RESC() do{ if(resc){ asm volatile("s_waitcnt lgkmcnt(0)":::"memory"); \
      _Pragma("unroll") for(int d_=0;d_<2;++d_) _Pragma("unroll") for(int r=0;r<16;++r)o[d_][r]*=wsf[crow(r,hi)]; } }while(0)
  f32x16 pA0,pA1,pB0,pB1;
  int sl_prev=0,sl_cur=0,sl_next=SLOTB;
  #define ROT() do{sl_prev=sl_cur;sl_cur=sl_next;sl_next=(sl_next==(NSLOT-1)*SLOTB)?0:sl_next+SLOTB;}while(0)
  DMA_K(2,2*SLOTB);
  WAIT_BAR(3);
  qkt(pA0,pA1,Kbase,qr,negm,r32,hi);asm volatile("s_nop 15\n\ts_nop 7":"+v"(pA0),"+v"(pA1));CMASK(pA0,pA1,0);
  START(pA0,pA1);
  _Pragma("unroll") for(int r=0;r<16;++r)pA1[r]=__builtin_amdgcn_exp2f(pA1[r]);
  WAIT_BAR(0);
  DMA_K(3,0);DMA_V(1,SLOTB);
  ROT();
  kload8(kf,kp0+sl_cur);
  WAIT_BAR(2);
  s16x4 vlo[8],vhi[8]; u32x4 pw0,pw1,pw2,pw3;
  #define PKW(P,B) cvtpk_s(P[B],P[B+1])
  #define PAF(k) __builtin_bit_cast(bf16x8,pw##k)
  #define VFR(i) (bf16x8){vlo[i][0],vlo[i][1],vlo[i][2],vlo[i][3],vhi[i][0],vhi[i][1],vhi[i][2],vhi[i][3]}
  #define PIN(x) asm volatile("":"+v"(x))
  #define MX3(a,b,c) __builtin_fmaxf(__builtin_fmaxf((a),(b)),(c))
  #define GAPA(MF,A0,A1,A2,A3,W0,W1,PW) do{ MF; sacc+=A0; sacc+=A1; sacc+=A2; sacc+=A3; PIN(sacc); W0; W1; PIN(PW); SBAR(); }while(0)
  #define EX(v) __builtin_amdgcn_exp2f(v)
  #define GAPB(MF,X,B) do{ MF; X[B]=EX(X[B]); X[B+1]=EX(X[B+1]); X[B+2]=EX(X[B+2]); X[B+3]=EX(X[B+3]); PIN(X); SBAR(); }while(0)
  #define VRD(i) do{ vlo[i]=vtr(vp_+(((i)>>2)*4096+((i)&3)*1024)); vhi[i]=vtr(vp_+(((i)>>2)*4096+((i)&3)*1024+512)); }while(0)
  #define KRD(G,j) do{ if(G){ kload2(kf,kp0+sl_next,j); SBAR(); } }while(0)
  #define STEP(C0,C1,P0,P1,t,GK,GV,GL) do{ SBAR(); \
    const lds_cptr vp_=vp0+sl_prev; \
    VRD(0); SBAR(); float sacc=(P0[0]+P0[1]); \
    GAPA(C0=__builtin_amdgcn_mfma_f32_32x32x16_bf16(kf[0],qr[0],negm,0,0,0), P0[2],P0[3],P0[4],P0[5],     pw0[0]=PKW(P0,0), pw0[1]=PKW(P0,2), pw0); \
    VRD(4); SBAR(); GAPA(C1=__builtin_amdgcn_mfma_f32_32x32x16_bf16(kf[1],qr[0],negm,0,0,0), P0[6],P0[7],P0[8],P0[9],     pw0[2]=PKW(P0,4), pw0[3]=PKW(P0,6), pw0); \
    VRD(1); SBAR(); GAPA(C0=__builtin_amdgcn_mfma_f32_32x32x16_bf16(kf[2],qr[1],C0,0,0,0),   P0[10],P0[11],P0[12],P0[13], pw1[0]=PKW(P0,8), pw1[1]=PKW(P0,10), pw1); \
    VRD(5); SBAR(); GAPA(C1=__builtin_amdgcn_mfma_f32_32x32x16_bf16(kf[3],qr[1],C1,0,0,0),   P0[14],P0[15],P1[0],P1[1],   pw1[2]=PKW(P0,12),pw1[3]=PKW(P0,14), pw1); \
    VRD(2); SBAR(); GAPA(C0=__builtin_amdgcn_mfma_f32_32x32x16_bf16(kf[4],qr[2],C0,0,0,0),   P1[2],P1[3],P1[4],P1[5],     pw2[0]=PKW(P1,0), pw2[1]=PKW(P1,2), pw2); \
    VRD(6); SBAR(); GAPA(C1=__builtin_amdgcn_mfma_f32_32x32x16_bf16(kf[5],qr[2],C1,0,0,0),   P1[6],P1[7],P1[8],P1[9],     pw2[2]=PKW(P1,4), pw2[3]=PKW(P1,6), pw2); \
    VRD(3); SBAR(); GAPA(C0=__builtin_amdgcn_mfma_f32_32x32x16_bf16(kf[6],qr[3],C0,0,0,0),   P1[10],P1[11],P1[12],P1[13], pw3[0]=PKW(P1,8), pw3[1]=PKW(P1,10), pw3); \
    VRD(7); SBAR(); GAPA(C1=__builtin_amdgcn_mfma_f32_32x32x16_bf16(kf[7],qr[3],C1,0,0,0),   P1[14],P1[15],0.f,0.f,       pw3[2]=PKW(P1,12),pw3[3]=PKW(P1,14), pw3); \
    l_reg+=sacc; \
    if(GK){DMA_K((t)+3,sl_cur);} if(GV){DMA_V((t)+1,sl_next);} \
    CMASK(C0,C1,t); \
    { float a=MX3(C0[0],C0[1],C1[0]),b=MX3(C0[2],C0[3],C1[1]); a=MX3(a,C1[2],C1[3]); \
      _Pragma("unroll") for(int r=4;r<16;r+=4){a=MX3(a,C0[r],C0[r+1]);b=MX3(b,C0[r+2],C0[r+3]);a=MX3(a,C1[r],C1[r+1]);b=MX3(b,C1[r+2],C1[r+3]);} \
      float rm=__builtin_fmaxf(a,b); { auto rr=__builtin_amdgcn_permlane32_swap(__float_as_uint(rm),__float_as_uint(rm),false,false); rm=__builtin_fmaxf(__uint_as_float(rr[0]),__uint_as_float(rr[1])); } \
      resc=false; \
      if(__builtin_expect(__any(rm>(float)THRL),0)){ const float dl=__builtin_fmaxf(rm,0.f); mhat+=dl; \
        _Pragma("unroll") for(int r=0;r<16;++r){C0[r]-=dl;C1[r]-=dl;} \
        _Pragma("unroll") for(int r=0;r<16;++r)negm[r]=-mhat; asm volatile("":"+v"(negm)); \
        const float f=__builtin_amdgcn_exp2f(-dl); l_reg*=f; if(hi==0)wsf[r32]=f; resc=true; } } \
    SBAR(); \
    GAPB(o[0]=__builtin_amdgcn_mfma_f32_32x32x16_bf16(PAF(0),VFR(0),o[0],0,0,0), C0,0); \
    GAPB(o[1]=__builtin_amdgcn_mfma_f32_32x32x16_bf16(PAF(0),VFR(4),o[1],0,0,0), C0,4); \
    KRD(GL,0); GAPB(o[0]=__builtin_amdgcn_mfma_f32_32x32x16_bf16(PAF(1),VFR(1),o[0],0,0,0), C0,8); \
    KRD(GL,1); GAPB(o[1]=__builtin_amdgcn_mfma_f32_32x32x16_bf16(PAF(1),VFR(5),o[1],0,0,0), C0,12); \
    KRD(GL,2); GAPB(o[0]=__builtin_amdgcn_mfma_f32_32x32x16_bf16(PAF(2),VFR(2),o[0],0,0,0), C1,0); \
    KRD(GL,3); GAPB(o[1]=__builtin_amdgcn_mfma_f32_32x32x16_bf16(PAF(2),VFR(6),o[1],0,0,0), C1,4); \
    GAPB(o[0]=__builtin_amdgcn_mfma_f32_32x32x16_bf16(PAF(3),VFR(3),o[0],0,0,0), C1,8); \
    GAPB(o[1]=__builtin_amdgcn_mfma_f32_32x32x16_bf16(PAF(3),VFR(7),o[1],0,0,0), C1,12); \
    }while(0)
  int t=1;
  #undef CMASK
  #define CMASK(P0,P1,t) do{ bmask(P0,P1,((selm>>((t)>>2))&1u)!=0u); }while(0)
  for(;t+5<NT;t+=2){
    STEP(pB0,pB1,pA0,pA1,t,true,true,true);     WAIT_BAR(2); RESC(); ROT();
    STEP(pA0,pA1,pB0,pB1,t+1,true,true,true);   WAIT_BAR(2); RESC(); ROT();
  }
  #undef CMASK
  #define CMASK(P0,P1,t) do{int jb_=(t)-(NT-4); if(jb_>=0)cmask(P0,P1,jb_,qrel,hi); else bmask(P0,P1,((selm>>((t)>>2))&1u)!=0u);}while(0)
  #define ENDW(tt) do{ if((tt)+3<NT){WAIT_BAR(2);} else if((tt)+2<NT){WAIT_BAR(1);} else {WAIT_BAR(0);} }while(0)
  for(;t+1<NT;t+=2){
    STEP(pB0,pB1,pA0,pA1,t,(t+3<NT),(t+1<NT),(t+1<NT));       ENDW(t);   RESC(); ROT();
    STEP(pA0,pA1,pB0,pB1,t+1,(t+4<NT),(t+2<NT),(t+2<NT));     ENDW(t+1); RESC(); ROT();
  }
  STEP(pB0,pB1,pA0,pA1,NT-1,false,false,false); RESC();
  { float sacc=pB0[0]+pB0[1]; _Pragma("unroll") for(int r=2;r<16;++r)sacc+=pB0[r]; _Pragma("unroll") for(int r=0;r<16;++r)sacc+=pB1[r]; l_reg+=sacc;
    pw0=(u32x4){PKW(pB0,0),PKW(pB0,2),PKW(pB0,4),PKW(pB0,6)};pw1=(u32x4){PKW(pB0,8),PKW(pB0,10),PKW(pB0,12),PKW(pB0,14)};pw2=(u32x4){PKW(pB1,0),PKW(pB1,2),PKW(pB1,4),PKW(pB1,6)};pw3=(u32x4){PKW(pB1,8),PKW(pB1,10),PKW(pB1,12),PKW(pB1,14)};
    SBAR(); pv(o,vb0+sl_cur,PAF(0),PAF(1),PAF(2),PAF(3)); }
  #undef PKW
  #undef PAF
  #undef VFR
  #undef PIN
  #undef MX3
  #undef GAPA
  #undef GAPB
  #undef EX
  #undef VRD
  #undef KRD
  #undef STEP
  #undef ENDW
  {auto rr=__builtin_amdgcn_permlane32_swap(__float_as_uint(l_reg),__float_as_uint(l_reg),false,false);l_reg=__uint_as_float(rr[0])+__uint_as_float(rr[1]);}
  if(hi==0)wsf[32+r32]=l_reg;asm volatile("s_waitcnt lgkmcnt(0)":::"memory");
  float rli[16];
  #pragma unroll
  for(int r=0;r<16;++r)rli[r]=__builtin_amdgcn_rcpf(wsf[32+crow(r,hi)]);
  bf16*Ow=O+(rowbase+q0+wid*QBLK)*OPITCH+h*D;
  { bf16*stg=(bf16*)(shm+LDS_OST)+wid*2048;
    #pragma unroll
    for(int r=0;r<16;++r){const int orow=crow(r,hi);
      #pragma unroll
      for(int d0=0;d0<2;++d0)stg[orow*64+d0*32+r32]=__float2bfloat16(o[d0][r]*rli[r]);}
    asm volatile("s_waitcnt lgkmcnt(0)":::"memory");
    #pragma unroll
    for(int i=0;i<4;++i){const int row=i*8+(lane>>3),ch=lane&7; const u32x4 v=*(const u32x4*)(stg+row*64+ch*8); ATTN_STORE16(Ow+(long)row*OPITCH+ch*8,v);} }
  asm volatile("s_waitcnt lgkmcnt(0)\n\ts_barrier":::"memory");
  #undef DMA_K
  #undef DMA_V
  #undef CMASK
  #undef START
  #undef RESC
  #undef ROT
}
constexpr int ATTN_LDS_BYTES=LDS_BYTES;
struct AttnTensors { const bf16* Q; const bf16* K; const bf16* V; bf16* O; const unsigned* SELM; };
struct AttnUnit { int bh; int qb; };
struct StaticOrder {
  int vcu, G;
  __device__ __forceinline__ explicit StaticOrder(int grid,int block):vcu((grid%8==0)?((block%8)*(grid/8)+block/8):block),G(grid){}
  __device__ __forceinline__ bool next(int i,AttnUnit&u)const{
    if(G==256){ if(i>=4)return false; const int s=vcu&7; u.bh=vcu>>3; u.qb=(i==0)?s:(i==1)?15-s:(i==2)?16+s:31-s; return true; }
    const int L=i*G+vcu; if(L>=BATCH*NHEAD*NQB)return false; u.bh=L/NQB; u.qb=NQB-1-(L%NQB); return true; }
  __device__ __forceinline__ void a_ready(const AttnUnit&)const{}
  __device__ __forceinline__ void done(const AttnUnit&)const{}
};
template<class Sched,int THRL=8> __device__ __forceinline__ void attn_phase(char*lds,const AttnTensors&T,const Sched&S){
  AttnUnit u;
  for(int i=0;S.next(i,u);++i){ S.a_ready(u); attn_unit<THRL>(u.bh/NHEAD,u.bh%NHEAD,u.qb,T.Q,T.K,T.V,T.O,T.SELM,lds); S.done(u); }
}
#undef SBAR
#undef WAIT_BAR
}

constexpr int NWAVES = 8, NTHR = 512;
constexpr int T_TOK = 65536, SEQ = 8192, NBATCH = 8, DM = 1024, DEPTH = 2;
constexpr int PMP = 1792;
constexpr int GLP = 3072;
constexpr int D_IN = 5120, NEXP = 64, NEXP1 = 65, TOPK = 6, DEXP = 256;
constexpr float EPS = 1e-6f;
constexpr int MAXROWS = 1600 * 256 + T_TOK;
constexpr size_t MiB = 1u << 20;
constexpr size_t WS_CTL = 0, CTL_ZERO_BYTES = 1 * MiB;
constexpr size_t WS_MOD = 1 * MiB;
constexpr size_t WS_KTAB = 2 * MiB;
constexpr size_t WS_A64 = 3 * MiB;
constexpr size_t WS_KMEAN = 4 * MiB;
constexpr size_t WS_WGU = 16 * MiB;
constexpr size_t WS_WD = 81 * MiB;
constexpr size_t WS_WR = WS_WD + (size_t)NEXP1 * 1024 * 256 * 2;
constexpr size_t WS_WIN = 114 * MiB;
constexpr size_t WS_WGLU = 124 * MiB;
constexpr size_t WS_WHO = 125 * MiB;
constexpr size_t WS_WMO = WS_WHO + 512 * 1024;
constexpr size_t WS_WOUT = 126 * MiB;
constexpr size_t WS_BT1 = 128 * MiB;
constexpr size_t WS_BT2 = 132 * MiB;
constexpr size_t WS_GL = 168 * MiB;
constexpr size_t WS_PM = 552 * MiB;
constexpr size_t WS_UG = 776 * MiB;
constexpr size_t WS_SLOC = 808 * MiB;
constexpr size_t WS_S0 = 816 * MiB;
constexpr size_t WS_HST = 820 * MiB;
constexpr size_t WS_HLAST = 884 * MiB;
constexpr size_t WS_SEL = 885 * MiB;
constexpr size_t WS_H = 896 * MiB;
constexpr size_t WS_YS5 = 904 * MiB;
constexpr size_t WS_OH = 936 * MiB;
constexpr size_t WS_OM = 968 * MiB;
constexpr size_t WS_MERGED = 776 * MiB;
constexpr size_t WS_H2 = 114 * MiB;
constexpr size_t WS_LOGITS = 242 * MiB;
constexpr size_t WS_TOPI = 258 * MiB;
constexpr size_t WS_TOPW = WS_TOPI + (size_t)T_TOK * 6 * 4;
constexpr size_t WS_POS = WS_TOPW + (size_t)T_TOK * 6 * 4;
constexpr size_t WS_ROWTOK = WS_POS + (size_t)T_TOK * 6 * 4;
constexpr size_t WS_ROWW = WS_ROWTOK + (size_t)MAXROWS * 4;
constexpr size_t WS_HID = 268 * MiB;
constexpr size_t WS_Y = 500 * MiB;
constexpr size_t WS_END = WS_Y + (size_t)MAXROWS * 512 * 2;
static_assert(WS_ROWW + (size_t)MAXROWS * 4 <= WS_HID && WS_HID + (size_t)MAXROWS * 256 * 2 <= WS_Y && WS_END <= 1024 * MiB, "ws map");
static_assert(WS_WR + 256 * 1024 * 2 <= WS_WIN && WS_BT2 + (size_t)16 * 1024 * 1152 * 2 <= WS_GL, "ws map 2");
constexpr int CW_TMO = 0;
constexpr int CW_CNT = 1024;
constexpr int CW_CUR = 1280;
constexpr int CW_BAR = 4096;
constexpr int RING_OFF = 0, RING_BYTES = 131072;
constexpr int LDSCTL_OFF = RING_BYTES, MISC_OFF = LDSCTL_OFF + 1024;
constexpr int LDS_BYTES = 147456;

#define XB_TMO      128
#define XB_XCNT(j)  (256  + 64 * (j))
#define XB_XSUB(j)  (1280 + 64 * (j))
#define XB_XGEN(j)  (2304 + 64 * (j))
#define XB_TOP      3328
#define XB_TOPGEN   3392
#define XCD_BAR_WORDS 3456
#define XB_SPIN_CAP (1u << 18)

__device__ __forceinline__ unsigned xb_ld(unsigned* p)              { return __hip_atomic_load(p, __ATOMIC_RELAXED, __HIP_MEMORY_SCOPE_AGENT); }
__device__ __forceinline__ unsigned xb_add(unsigned* p, unsigned v) { return __hip_atomic_fetch_add(p, v, __ATOMIC_RELAXED, __HIP_MEMORY_SCOPE_AGENT); }
__device__ __forceinline__ unsigned xb_xcc_id() { return (unsigned)__builtin_amdgcn_s_getreg((3 << 11) | 20) & 0xFu; }
#define XB_SPIN(cond, bar) do { unsigned _sp = 0; while (cond) { __builtin_amdgcn_s_sleep(1); \
    if ((++_sp & 255u) == 0u) { if (xb_ld(&(bar)[XB_TMO])) break; if (_sp > XB_SPIN_CAP) { atomicAdd(&(bar)[XB_TMO], 1u); break; } } } } while (0)

struct XcdBarrier {
    unsigned* bar; unsigned x;
    volatile LAS unsigned* st;
};

__device__ __forceinline__ XcdBarrier xcd_barrier_post(unsigned* bar, volatile LAS unsigned* st) {
    XcdBarrier b; b.bar = bar; b.x = xb_xcc_id(); b.st = st;
    if (threadIdx.x == 0) (void)xb_add(&bar[XB_XCNT(b.x)], 1u);
    return b;
}
__device__ __forceinline__ void xcd_barrier_complete(unsigned* bar, unsigned x, unsigned& nloc, unsigned& nx) {
    const unsigned G = gridDim.x * gridDim.y * gridDim.z;
    unsigned sum, cnt, mine, sp = 0u;
    for (;;) {
        sum = 0u; cnt = 0u; mine = 0u;
#pragma unroll
        for (unsigned j = 0; j < 16; ++j) { const unsigned c = xb_ld(&bar[XB_XCNT(j)]); sum += c; cnt += (c > 0u) ? 1u : 0u; mine = (j == x) ? c : mine; }
        if (sum == G) break;
        __builtin_amdgcn_s_sleep(1);
        if ((++sp & 255u) == 0u) { if (xb_ld(&bar[XB_TMO])) break; if (sp > XB_SPIN_CAP) { atomicAdd(&bar[XB_TMO], 1u); break; } }
    }
    nloc = mine > 0u ? mine : 1u; nx = cnt > 0u ? cnt : 1u;
}

__device__ __forceinline__ void xcd_barrier(const XcdBarrier& b) {
    asm volatile("s_waitcnt vmcnt(0)" ::: "memory");
    __syncthreads();
    if (threadIdx.x == 0) {
        unsigned* bar = b.bar;
        __builtin_amdgcn_s_waitcnt(0);
        unsigned nloc = b.st[0], nx = b.st[1];
        if (nloc == 0u) { xcd_barrier_complete(bar, b.x, nloc, nx); b.st[0] = nloc; b.st[1] = nx; }
        const unsigned old = xb_add(&bar[XB_XSUB(b.x)], 1u);
        const unsigned gen = old / nloc;
        if (old + 1u == (gen + 1u) * nloc) {
            __builtin_amdgcn_fence(__ATOMIC_RELEASE, "agent");
            asm volatile("s_waitcnt vmcnt(0)" ::: "memory");
            const unsigned og = xb_add(&bar[XB_TOP], 1u);
            const unsigned tg = og / nx;
            if (og + 1u == (tg + 1u) * nx) xb_add(&bar[XB_TOPGEN], 1u);
            else XB_SPIN(xb_ld(&bar[XB_TOPGEN]) == tg, bar);
            __builtin_amdgcn_fence(__ATOMIC_ACQUIRE, "agent");
            xb_add(&bar[XB_XGEN(b.x)], 1u);
            asm volatile("s_waitcnt vmcnt(0)" ::: "memory");
        } else {
            XB_SPIN(xb_ld(&bar[XB_XGEN(b.x)]) == gen, bar);
            __builtin_amdgcn_fence(__ATOMIC_ACQUIRE, "agent");
            asm volatile("s_waitcnt vmcnt(0)" ::: "memory");
        }
    }
    __syncthreads();
}


struct Frame {
    LAS unsigned char* lds; unsigned char* ldsg;
    volatile LAS unsigned* MISC;
    gu32* ctl;
    unsigned char* ws;
    int tid, lane, wave, vcu, G;
    float* out;
};
constexpr int PTR_OFF = 131072 + 2048;
DI const float* inp(const Frame& F, int i) { const LAS unsigned* p = (const LAS unsigned*)(F.lds + PTR_OFF) + 2 * i; const unsigned lo = __builtin_amdgcn_readfirstlane(p[0]), hi = __builtin_amdgcn_readfirstlane(p[1]); return (const float*)(GAS const float*)(((unsigned long long)hi << 32) | lo); }
DI float wave_sum(float v) {
#pragma unroll
    for (int o = 1; o < 64; o <<= 1) v += __shfl_xor(v, o);
    return v;
}
#define WGBAR() do { asm volatile("s_waitcnt vmcnt(0) lgkmcnt(0)" ::: "memory"); __builtin_amdgcn_s_barrier(); asm volatile("" ::: "memory"); } while (0)

enum { I_X = 0, I_C, I_ADAW, I_ADAB, I_N1G, I_WIN, I_LOGDT, I_LRE, I_LIM, I_BRE, I_BIM, I_CRE, I_CIM, I_SSMD, I_WGLU, I_LBL, I_HNG, I_HWO, I_MQG, I_MKG, I_MWO, I_WOUT, I_N2G,
       I_RW, I_RB, I_EWG, I_EWU, I_EWD, I_SWG, I_SWU, I_SWD };

DI int rowmap(int mode, int n) {
    if (mode == 0) return n;
    if (mode == 1) return (n < 1024) ? ((n >> 7) * 256 + (n & 127)) : (((n - 1024) >> 7) * 256 + 128 + ((n - 1024) & 127));
    if (mode == 2) return (n >> 7) * 256 + (n & 127);
    return (n >> 7) * 256 + 128 + (n & 127);
}
DI void transpose_item(const float* W, int K, int N, bf16* WT, int ldk, int mode, LAS float* scr, int item, int lane) {
    const int nblk = N / 32, kb = item / nblk, nb = item % nblk, k0 = 64 * kb, n0 = 32 * nb;
#pragma unroll 8
    for (int i = 0; i < 32; ++i) { const int kk = 2 * i + (lane >> 5); scr[kk * 33 + (lane & 31)] = W[(size_t)(k0 + kk) * N + n0 + (lane & 31)]; }
    LDS_WAIT(); asm volatile("" ::: "memory");
    const int c = lane & 7;
#pragma unroll
    for (int j = 0; j < 4; ++j) { const int n = (lane >> 3) + 8 * j; const LAS float* s = scr + (8 * c) * 33 + n;
        u32x4 o; o.x = pk2(s[0 * 33], s[1 * 33]); o.y = pk2(s[2 * 33], s[3 * 33]); o.z = pk2(s[4 * 33], s[5 * 33]); o.w = pk2(s[6 * 33], s[7 * 33]);
        *(GAS u32x4*)(WT + (size_t)rowmap(mode, n0 + n) * ldk + k0 + 8 * c) = o; }
    LDS_WAIT(); asm volatile("" ::: "memory");
}
struct TJob { const float* src; size_t sstride; int nb, K, N; bf16* dst; size_t dstride; int ldk, mode; };
DI void p0_convert(Frame& F, int l) {
    LAS float* scr = (LAS float*)(F.lds + RING_OFF + F.wave * 16384);
    const int gw = F.vcu * NWAVES + F.wave, NGW = F.G * NWAVES;
    unsigned char* ws = F.ws;
    TJob jobs[12];
    jobs[0] = TJob{inp(F, I_WIN) + (size_t)l * 1024 * D_IN, 0, 1, 1024, D_IN, (bf16*)(ws + WS_WIN), 0, 1024, 0};
    jobs[1] = TJob{inp(F, I_WGLU) + (size_t)l * 256 * 2048, 0, 1, 256, 2048, (bf16*)(ws + WS_WGLU), 0, 256, 1};
    jobs[2] = TJob{inp(F, I_HWO) + (size_t)l * 256 * 1024, 0, 1, 256, 1024, (bf16*)(ws + WS_WHO), 0, 256, 0};
    jobs[3] = TJob{inp(F, I_MWO) + (size_t)l * 256 * 1024, 0, 1, 256, 1024, (bf16*)(ws + WS_WMO), 0, 256, 0};
    jobs[4] = TJob{inp(F, I_WOUT) + (size_t)l * 1024 * 1024, 0, 1, 1024, 1024, (bf16*)(ws + WS_WOUT), 0, 1024, 0};
    jobs[5] = TJob{inp(F, I_RW) + (size_t)l * 1024 * 64, 0, 1, 1024, 64, (bf16*)(ws + WS_WR), 0, 1024, 0};
    jobs[6] = TJob{inp(F, I_EWG) + (size_t)l * NEXP * 1024 * 256, (size_t)1024 * 256, NEXP, 1024, 256, (bf16*)(ws + WS_WGU), (size_t)512 * 1024, 1024, 2};
    jobs[7] = TJob{inp(F, I_EWU) + (size_t)l * NEXP * 1024 * 256, (size_t)1024 * 256, NEXP, 1024, 256, (bf16*)(ws + WS_WGU), (size_t)512 * 1024, 1024, 3};
    jobs[8] = TJob{inp(F, I_EWD) + (size_t)l * NEXP * 256 * 1024, (size_t)256 * 1024, NEXP, 256, 1024, (bf16*)(ws + WS_WD), (size_t)1024 * 256, 256, 0};
    jobs[9] = TJob{inp(F, I_SWG) + (size_t)l * 1024 * 256, 0, 1, 1024, 256, (bf16*)(ws + WS_WGU) + (size_t)NEXP * 512 * 1024, 0, 1024, 2};
    jobs[10] = TJob{inp(F, I_SWU) + (size_t)l * 1024 * 256, 0, 1, 1024, 256, (bf16*)(ws + WS_WGU) + (size_t)NEXP * 512 * 1024, 0, 1024, 3};
    jobs[11] = TJob{inp(F, I_SWD) + (size_t)l * 256 * 1024, 0, 1, 256, 1024, (bf16*)(ws + WS_WD) + (size_t)NEXP * 1024 * 256, 0, 256, 0};
    int base = 0;
#pragma unroll
    for (int j = 0; j < 12; ++j) {
        const TJob jb = jobs[j];
        const int per = (jb.K / 64) * (jb.N / 32), tot = per * jb.nb;
        int first = gw - (base % NGW); if (first < 0) first += NGW;
        for (int it = first; it < tot; it += NGW) { const int b = it / per, r = it % per;
            transpose_item(jb.src + (size_t)b * jb.sstride, jb.K, jb.N, jb.dst + (size_t)b * jb.dstride, jb.ldk, jb.mode, scr, r, F.lane); }
        base += tot;
    }
}

DI void p0_adaln(Frame& F) {
    LAS float* cond = (LAS float*)(F.lds + RING_OFF);
    LAS float* red = (LAS float*)(F.lds + RING_OFF + 32768);
    const float* c = inp(F, I_C);
    for (int i = F.tid; i < NBATCH * DM; i += NTHR) cond[i] = fsilu(c[i]);
    WGBAR();
    float* MOD = (float*)(F.ws + WS_MOD);
    const int col = F.tid & 63, kc = F.tid >> 6;
    for (int u = F.vcu; u < DEPTH * 96; u += F.G) {
        const int l = u / 96, n0 = (u % 96) * 64;
        const float* W = inp(F, I_ADAW) + (size_t)l * DM * 6144 + n0 + col;
        float a[8];
#pragma unroll
        for (int b = 0; b < 8; ++b) a[b] = 0.f;
        for (int k = kc * 128; k < kc * 128 + 128; ++k) { const float w = W[(size_t)k * 6144];
#pragma unroll
            for (int b = 0; b < 8; ++b) a[b] += w * cond[b * DM + k]; }
#pragma unroll
        for (int b = 0; b < 8; ++b) red[(kc * 8 + b) * 64 + col] = a[b];
        WGBAR();
        { const int b = F.tid >> 6; float s = 0.f;
#pragma unroll
          for (int q = 0; q < 8; ++q) s += red[(q * 8 + b) * 64 + col];
          MOD[((size_t)l * 8 + b) * 6144 + n0 + col] = s + inp(F, I_ADAB)[(size_t)l * 6144 + n0 + col]; }
        WGBAR();
    }
}

DI void cis(float ang, float& c, float& s) { s = sinf(ang); c = cosf(ang); }
DI void p0_s5tab(Frame& F, int l) {
    LAS float* L = (LAS float*)(F.lds + RING_OFF);
    LAS float* AJ = L;
    LAS float* AJ1 = L + 128;
    LAS float* A63 = L + 256;
    LAS float* COEF = L + 384;
    LAS float* BB = L + 512;
    LAS float* Z = L + 512 + 2048;
    float* KTAB = (float*)(F.ws + WS_KTAB); float* A64 = (float*)(F.ws + WS_A64);
    bf16* BT1 = (bf16*)(F.ws + WS_BT1); bf16* BT2 = (bf16*)(F.ws + WS_BT2);
    const float* cre = inp(F, I_CRE) + (size_t)l * 16 * 16 * 64; const float* cim = inp(F, I_CIM) + (size_t)l * 16 * 16 * 64;
    const float* bre = inp(F, I_BRE) + (size_t)l * 16 * 64 * 16; const float* bim = inp(F, I_BIM) + (size_t)l * 16 * 64 * 16;
    for (int u = F.vcu; u < 1024; u += F.G) {
        const int g = u >> 6, j = u & 63;
        if (F.tid < 64) { const int p = F.tid;
            const float dt = expf(inp(F, I_LOGDT)[l * 16 + g]); const float lr = inp(F, I_LRE)[(l * 16 + g) * 64 + p], li = inp(F, I_LIM)[(l * 16 + g) * 64 + p];
            float cr, sr; const float mag = expf(lr * dt); cis(li * dt, cr, sr); const float ar = mag * cr, ai = mag * sr;
            const float inv = 1.0f / (lr * lr + li * li);
            COEF[2 * p] = ((ar - 1.0f) * lr + ai * li) * inv; COEF[2 * p + 1] = (ai * lr - (ar - 1.0f) * li) * inv;
            float m, c2, s2;
            m = expf((float)j * lr * dt); cis((float)j * (li * dt), c2, s2); AJ[2 * p] = m * c2; AJ[2 * p + 1] = m * s2;
            m = expf((float)(j + 1) * lr * dt); cis((float)(j + 1) * (li * dt), c2, s2); AJ1[2 * p] = m * c2; AJ1[2 * p + 1] = m * s2;
            m = expf((float)(63 - j) * lr * dt); cis((float)(63 - j) * (li * dt), c2, s2); A63[2 * p] = m * c2; A63[2 * p + 1] = m * s2;
            if (j == 0) { m = expf(64.0f * lr * dt); cis(64.0f * (li * dt), c2, s2); A64[(g * 64 + p) * 2] = m * c2; A64[(g * 64 + p) * 2 + 1] = m * s2; }
        }
        WGBAR();
        for (int e = F.tid; e < 1024; e += NTHR) { const int p = e >> 4, h = e & 15;
            const float br = bre[(g * 64 + p) * 16 + h], bi = bim[(g * 64 + p) * 16 + h], cr = COEF[2 * p], ci = COEF[2 * p + 1];
            const float xr = cr * br - ci * bi, xi = cr * bi + ci * br; BB[2 * e] = xr; BB[2 * e + 1] = xi;
            const float ar = AJ[2 * p], ai = AJ[2 * p + 1]; Z[2 * e] = ar * xr - ai * xi; Z[2 * e + 1] = ar * xi + ai * xr; }
        WGBAR();
        if (F.tid < 256) { const int hp = F.tid >> 4, h = F.tid & 15; float s = 0.f;
            for (int p = 0; p < 64; ++p) s += cre[(g * 16 + hp) * 64 + p] * Z[2 * (p * 16 + h)] - cim[(g * 16 + hp) * 64 + p] * Z[2 * (p * 16 + h) + 1];
            KTAB[((g * 64 + j) * 16 + hp) * 16 + h] = s; }
        else { const int t2 = F.tid - 256;
            for (int e = t2; e < 2048; e += 256) { const int hp = e >> 7, q = e & 127, p = q & 63;
                const float c_r = cre[(g * 16 + hp) * 64 + p], c_i = cim[(g * 16 + hp) * 64 + p], ar = AJ1[2 * p], ai = AJ1[2 * p + 1];
                const float v = (q < 64) ? (c_r * ar - c_i * ai) : -(c_r * ai + c_i * ar);
                BT2[((size_t)(g * 1024 + j * 16 + hp)) * 1152 + 1024 + q] = (bf16)f2bf(v); } }
        for (int e = F.tid; e < 2048; e += NTHR) { const int q = e >> 4, h = e & 15, p = q & 63;
            const float ar = A63[2 * p], ai = A63[2 * p + 1], xr = BB[2 * (p * 16 + h)], xi = BB[2 * (p * 16 + h) + 1];
            const float v = (q < 64) ? (ar * xr - ai * xi) : (ar * xi + ai * xr);
            BT1[((size_t)(g * 128 + q)) * 1024 + j * 16 + h] = (bf16)f2bf(v); }
        WGBAR();
    }
}
DI void p1_s5fill(Frame& F) {
    const float* KTAB = (const float*)(F.ws + WS_KTAB); bf16* BT2 = (bf16*)(F.ws + WS_BT2);
    const size_t gt = (size_t)F.vcu * NTHR + F.tid, GT = (size_t)F.G * NTHR;
    for (size_t it = gt; it < (size_t)16 * 1024 * 128; it += GT) {
        const int kc = (int)(it & 127), n = (int)((it >> 7) & 1023), g = (int)(it >> 17);
        const int tau = n >> 4, hp = n & 15, sigma = kc >> 1, h0 = (kc & 1) * 8;
        if (sigma > (tau | 15)) continue;
        u32x4 o = (u32x4){0u, 0u, 0u, 0u};
        if (sigma <= tau) { const float* s = KTAB + ((g * 64 + (tau - sigma)) * 16 + hp) * 16 + h0;
            const f32x4 a = *(const f32x4*)s, b = *(const f32x4*)(s + 4); o.x = pk2(a.x, a.y); o.y = pk2(a.z, a.w); o.z = pk2(b.x, b.y); o.w = pk2(b.z, b.w); }
        *(u32x4*)(BT2 + ((size_t)(g * 1024 + n)) * 1152 + kc * 8) = o;
    }
}

DI void norm_rows(Frame& F, const float* X, const float* gain, const float* shift, const float* scale, bf16* O) {
    const int gw = F.vcu * NWAVES + F.wave, NGW = F.G * NWAVES;
    for (int m = gw; m < T_TOK; m += NGW) {
        const int b = m >> 13;
        const GAS f32x4* xr = (const GAS f32x4*)(X + (size_t)m * DM) + F.lane;
        f32x4 v[4]; float s2 = 0.f;
#pragma unroll
        for (int j = 0; j < 4; ++j) { v[j] = xr[64 * j]; s2 += (v[j].x * v[j].x + v[j].y * v[j].y) + (v[j].z * v[j].z + v[j].w * v[j].w); }
        const float rstd = 1.0f / sqrtf(wave_sum(s2) * (1.0f / DM) + EPS);
        GAS u32x2* o8 = (GAS u32x2*)(O + (size_t)m * DM) + F.lane;
#pragma unroll
        for (int j = 0; j < 4; ++j) { const int col = 4 * F.lane + 256 * j;
            const f32x4 g = *(const f32x4*)(gain + col), sh = *(const f32x4*)(shift + b * 6144 + col), sc = *(const f32x4*)(scale + b * 6144 + col);
            const f32x4 y = v[j] * rstd * g * (sc + 1.0f) + sh;
            u32x2 w; w.x = pk2(y.x, y.y); w.y = pk2(y.z, y.w); o8[64 * j] = w; }
    }
}

typedef const f32x4 (&AccRef)[2][2][4][2];
DI void plain_avoff(int lda, const int (&R)[2], const int (&C)[2], unsigned (&v)[2][2]) {
#pragma unroll
    for (int h = 0; h < 2; ++h)
#pragma unroll
        for (int i = 0; i < 2; ++i) v[h][i] = (unsigned)(((h * 128 + R[i]) * lda + C[i]) * 2);
}
DI void acc8(AccRef acc, int ai, int bj, int m, float (&v)[8]) {
    const f32x4 a = acc[ai][bj][m][0], b = acc[ai][bj][m][1]; v[0] = a.x; v[1] = a.y; v[2] = a.z; v[3] = a.w; v[4] = b.x; v[5] = b.y; v[6] = b.z; v[7] = b.w;
}
struct PlainBase {
    static constexpr bool SEG2 = false, GATHER = false;
    const char* A; const char* B; int lda, lda2, ldb, K; pg8::TileOrder ord;
    DI void setup(const void* A_, int lda_, const void* B_, int K_, int M, int N, int G, int c) { A = (const char*)A_; B = (const char*)B_; lda = lda_; lda2 = lda_; ldb = K_; K = K_; ord.init(M, N, G, c); }
    DI bool next(int i, pg8::GU& u) const { int pm, pn; if (!ord.next(i, pm, pn)) return false;
        u.pm = pm; u.pn = pn; u.e = 0; u.A = A + (size_t)pm * 256 * lda * 2; u.A2 = u.A; u.B = B + (size_t)pn * 256 * ldb * 2; u.nt1 = u.nt = K / 64; u.kstepA = 128; u.kstepA2 = 128; u.bjump = 0; u.lda = lda; u.lda2 = lda; return true; }
};
struct PolWin : PlainBase {
    static constexpr bool PERM = true;
    unsigned char* wsb;
    DI void epi(AccRef acc, const pg8::GU& u, int wr, int wc, int fr, int fq) const {
        int pitch; int coff[2]; const bool sig = u.pn >= 8;
#pragma unroll
        for (int bj = 0; bj < 2; ++bj) { const int c0 = bj * 128 + wc * 32 + fq * 8;
            coff[bj] = (u.pn == 0) ? ((c0 >> 4) * (T_TOK * 16) + (c0 & 15)) : (u.pn < 8) ? ((u.pn - 1) * 256 + c0) : ((u.pn - 8) * 256 + c0); }
        const size_t boff = (u.pn == 0) ? WS_UG : (u.pn < 8) ? WS_PM : WS_GL; pitch = (u.pn == 0) ? 16 : (u.pn < 8) ? PMP : GLP; bf16* base = (bf16*)(wsb + boff);
#pragma unroll
        for (int ai = 0; ai < 2; ++ai)
#pragma unroll
            for (int m = 0; m < 4; ++m) { const size_t t = (size_t)(u.pm * 256 + ai * 128 + wr * 64 + m * 16 + fr);
#pragma unroll
                for (int bj = 0; bj < 2; ++bj) { float v[8]; acc8(acc, ai, bj, m, v);
                    if (sig) {
#pragma unroll
                        for (int j = 0; j < 8; ++j) v[j] = fsigmoid(v[j]); }
                    *(u32x4*)(base + t * pitch + coff[bj]) = pack8(v); }
                asm volatile("" ::: "memory"); __builtin_amdgcn_sched_barrier(0); }
    }
};
struct PolS5a {
    static constexpr bool PERM = false, SEG2 = false, GATHER = false;
    const char* UG; const char* BT1; float* SLOC; int ldb, G, c; static constexpr int lda = 1024, lda2 = 1024;
    DI bool next(int i, pg8::GU& u) const { const int L = i * G + c; if (L >= 64) return false; u.pm = L & 3; u.e = L >> 2; u.pn = 0;
        u.A = UG + ((size_t)u.e * T_TOK * 16 + (size_t)u.pm * 256 * 1024) * 2; u.A2 = u.A; u.B = BT1 + (size_t)u.e * 128 * 1024 * 2; u.nt1 = u.nt = 16; u.kstepA = 128; u.kstepA2 = 128; u.bjump = 0; u.lda = 1024; u.lda2 = 1024; return true; }
    DI void epi(AccRef acc, const pg8::GU& u, int wr, int wc, int fr, int fq) const {
#pragma unroll
        for (int ai = 0; ai < 2; ++ai)
#pragma unroll
            for (int m = 0; m < 4; ++m) { const int row = u.pm * 256 + ai * 128 + wr * 64 + m * 16 + fr;
#pragma unroll
                for (int n = 0; n < 2; ++n) *(f32x4*)(SLOC + ((size_t)row * 16 + u.e) * 128 + wc * 32 + n * 16 + fq * 4) = acc[ai][0][m][n]; }
    }
};
struct PolS5b {
    static constexpr bool PERM = true, SEG2 = true, GATHER = false;
    const char* UG; const char* S0; const char* BT2; const float* Dsk; bf16* YS5; int ldb, G, c; static constexpr int lda = 1024, lda2 = 2048;
    DI bool next(int i, pg8::GU& u) const { const int L = i * G + c; if (L >= 256) return false; u.e = L >> 4; u.pm = (L >> 2) & 3; u.pn = 3 - (L & 3);
        u.A = UG + ((size_t)u.e * T_TOK * 16 + (size_t)u.pm * 256 * 1024) * 2; u.A2 = S0 + ((size_t)u.pm * 256 * 2048 + (size_t)u.e * 128) * 2;
        u.B = BT2 + ((size_t)u.e * 1024 + (size_t)u.pn * 256) * 1152 * 2; u.nt1 = 4 * (u.pn + 1); u.nt = u.nt1 + 2; u.kstepA = 128; u.kstepA2 = 128; u.bjump = (1024 - u.nt1 * 64) * 2; u.lda = 1024; u.lda2 = 2048; return true; }
    DI void epi(AccRef acc, const pg8::GU& u, int wr, int wc, int fr, int fq) const {
        const bf16* Ug = (const bf16*)UG + (size_t)u.e * T_TOK * 16;
#pragma unroll
        for (int ai = 0; ai < 2; ++ai)
#pragma unroll
            for (int m = 0; m < 4; ++m) { const int row = u.pm * 256 + ai * 128 + wr * 64 + m * 16 + fr;
#pragma unroll
                for (int bj = 0; bj < 2; ++bj) { const int cc = u.pn * 256 + bj * 128 + wc * 32 + fq * 8, tau = cc >> 4, h0 = cc & 15; const size_t t = (size_t)row * 64 + tau;
                    float v[8], uu[8]; acc8(acc, ai, bj, m, v); unpack8(*(const u32x4*)(Ug + t * 16 + h0), uu);
                    const f32x4 d0 = *(const f32x4*)(Dsk + u.e * 16 + h0), d1 = *(const f32x4*)(Dsk + u.e * 16 + h0 + 4);
                    const float dd[8] = {d0.x, d0.y, d0.z, d0.w, d1.x, d1.y, d1.z, d1.w};
#pragma unroll
                    for (int j = 0; j < 8; ++j) v[j] = gelu_tanh(v[j] + dd[j] * uu[j]);
                    *(u32x4*)(YS5 + t * 256 + u.e * 16 + h0) = pack8(v); }
                { asm volatile("" ::: "memory"); __builtin_amdgcn_sched_barrier(0); } }
    }
};
struct PolGlu : PlainBase {
    static constexpr bool PERM = true;
    const bf16* GL; bf16* MERGED;
    DI void epi(AccRef acc, const pg8::GU& u, int wr, int wc, int fr, int fq) const {
#pragma unroll
        for (int ai = 0; ai < 2; ++ai)
#pragma unroll
            for (int m = 0; m < 4; ++m) { const size_t t = (size_t)(u.pm * 256 + ai * 128 + wr * 64 + m * 16 + fr); const int n0 = u.pn * 128 + wc * 32 + fq * 8;
                float z1[8], z2[8], g[8]; acc8(acc, ai, 0, m, z1); acc8(acc, ai, 1, m, z2); unpack8(*(const u32x4*)(GL + t * GLP + n0), g);
#pragma unroll
                for (int j = 0; j < 8; ++j) z1[j] = g[j] * z1[j] * fsigmoid(z2[j]);
                *(u32x4*)(MERGED + t * DM + n0) = pack8(z1); { asm volatile("" ::: "memory"); __builtin_amdgcn_sched_barrier(0); } }
    }
};
struct PolRmw {
    static constexpr bool PERM = true, SEG2 = false, GATHER = false;
    const char* A1; const char* A2; const char* B1; const char* B2; const bf16* GL; bf16* MERGED; int ldb; pg8::TileOrder ord; int nper;
    static constexpr int lda = 256, lda2 = 256;
    DI bool next(int i, pg8::GU& u) const { if (i >= 2 * nper) return false; const int br = (i >= nper) ? 1 : 0; int pm, pn; if (!ord.next(i - br * nper, pm, pn)) return false;
        u.pm = pm; u.pn = pn; u.e = br; u.A = A1 + (size_t)br * (size_t)(A2 - A1) + (size_t)pm * 256 * 256 * 2; u.A2 = u.A; u.B = B1 + (size_t)br * (size_t)(B2 - B1) + (size_t)pn * 256 * 256 * 2;
        u.nt = 4; u.nt1 = 4; u.kstepA = 128; u.kstepA2 = 128; u.bjump = 0; u.lda = 256; u.lda2 = 256; return true; }
    DI void epi(AccRef acc, const pg8::GU& u, int wr, int wc, int fr, int fq) const {
        const int gcol = (u.e + 1) * 1024;
#pragma unroll
        for (int ai = 0; ai < 2; ++ai)
#pragma unroll
            for (int m = 0; m < 4; ++m) { const size_t t = (size_t)(u.pm * 256 + ai * 128 + wr * 64 + m * 16 + fr);
#pragma unroll
                for (int bj = 0; bj < 2; ++bj) { const int n0 = u.pn * 256 + bj * 128 + wc * 32 + fq * 8;
                    float v[8], g[8], o[8]; acc8(acc, ai, bj, m, v); unpack8(*(const u32x4*)(GL + t * GLP + gcol + n0), g); unpack8(*(const u32x4*)(MERGED + t * DM + n0), o);
#pragma unroll
                    for (int j = 0; j < 8; ++j) o[j] += g[j] * v[j];
                    *(u32x4*)(MERGED + t * DM + n0) = pack8(o); }
                { asm volatile("" ::: "memory"); __builtin_amdgcn_sched_barrier(0); } }
    }
};
struct PolWout : PlainBase {
    static constexpr bool PERM = false;
    const float* Xin; float* X; const float* gate;
    DI void epi(AccRef acc, const pg8::GU& u, int wr, int wc, int fr, int fq) const {
        const int b = u.pm >> 5;
#pragma unroll
        for (int ai = 0; ai < 2; ++ai)
#pragma unroll
            for (int m = 0; m < 4; ++m) { const size_t t = (size_t)(u.pm * 256 + ai * 128 + wr * 64 + m * 16 + fr);
#pragma unroll
                for (int bj = 0; bj < 2; ++bj)
#pragma unroll
                    for (int n = 0; n < 2; ++n) { const int n0 = u.pn * 256 + bj * 128 + wc * 32 + n * 16 + fq * 4;
                        const f32x4 g = *(const f32x4*)(gate + b * 6144 + n0), x = *(const f32x4*)(Xin + t * DM + n0);
                        *(f32x4*)(X + t * DM + n0) = x + g * acc[ai][bj][m][n]; }
                { asm volatile("" ::: "memory"); __builtin_amdgcn_sched_barrier(0); } }
    }
};
struct PolRouter : PlainBase {
    static constexpr bool PERM = false;
    float* LOG;
    DI void epi(AccRef acc, const pg8::GU& u, int wr, int wc, int fr, int fq) const {
        if (wc < 2) {
#pragma unroll
            for (int ai = 0; ai < 2; ++ai)
#pragma unroll
                for (int m = 0; m < 4; ++m) { const size_t t = (size_t)(u.pm * 256 + ai * 128 + wr * 64 + m * 16 + fr);
#pragma unroll
                    for (int n = 0; n < 2; ++n) *(f32x4*)(LOG + t * 64 + wc * 32 + n * 16 + fq * 4) = acc[ai][0][m][n]; } }
    }
};
struct GroupSched {
    const LAS int* blkpfx; int nNt, G, c;
    DI bool pick(int i, int& rb, int& pn, int& e) const { const int total = blkpfx[NEXP1] * nNt; const int L = i * G + c; if (L >= total) return false;
        rb = L / nNt; pn = L % nNt; int ee = 0; while (rb >= blkpfx[ee + 1]) ++ee; e = __builtin_amdgcn_readfirstlane(ee); rb = __builtin_amdgcn_readfirstlane(rb); pn = __builtin_amdgcn_readfirstlane(pn); return true; }
};
struct PolGateUp {
    static constexpr bool PERM = true, SEG2 = false, GATHER = true;
    GroupSched gs; const char* H2; const char* WGU; const int* ROWTOK; const float* ROWW; bf16* HID; int ldb; static constexpr int lda = 1024, lda2 = 1024;
    DI bool next(int i, pg8::GU& u) const { int rb, pn, e; if (!gs.pick(i, rb, pn, e)) return false; u.pm = rb; u.pn = pn; u.e = e;
        u.A = H2; u.A2 = H2; u.B = WGU + ((size_t)e * 512 + (size_t)pn * 256) * 1024 * 2; u.nt1 = u.nt = 16; u.kstepA = 128; u.kstepA2 = 128; u.bjump = 0; u.lda = 1024; u.lda2 = 1024; return true; }
    DI void avoff(const pg8::GU& u, const int (&R)[2], const int (&C)[2], unsigned (&v)[2][2]) const {
#pragma unroll
        for (int h = 0; h < 2; ++h)
#pragma unroll
            for (int i = 0; i < 2; ++i) { const int tok = ROWTOK[(size_t)u.pm * 256 + h * 128 + R[i]]; v[h][i] = (unsigned)((tok * 1024 + C[i]) * 2); }
    }
    DI void epi(AccRef acc, const pg8::GU& u, int wr, int wc, int fr, int fq) const {
#pragma unroll
        for (int ai = 0; ai < 2; ++ai)
#pragma unroll
            for (int m = 0; m < 4; ++m) { const size_t row = (size_t)u.pm * 256 + ai * 128 + wr * 64 + m * 16 + fr; const float w = ROWW[row];
                float z1[8], z2[8]; acc8(acc, ai, 0, m, z1); acc8(acc, ai, 1, m, z2);
#pragma unroll
                for (int j = 0; j < 8; ++j) z1[j] = w * fsilu(z1[j]) * z2[j];
                *(u32x4*)(HID + row * 256 + u.pn * 128 + wc * 32 + fq * 8) = pack8(z1); }
    }
};
struct PolDown {
    static constexpr bool PERM = true, SEG2 = false, GATHER = false;
    GroupSched gs; const char* HIDp; const char* WD; bf16* Y; int ldb, half; static constexpr int lda = 256, lda2 = 256;
    DI bool next(int i, pg8::GU& u) const { int rb, pn, e; if (!gs.pick(i, rb, pn, e)) return false; u.pm = rb; u.pn = pn; u.e = e;
        u.A = HIDp + (size_t)rb * 256 * 256 * 2; u.A2 = u.A; u.B = WD + ((size_t)e * 1024 + (size_t)half * 512 + (size_t)pn * 256) * 256 * 2; u.nt1 = u.nt = 4; u.kstepA = 128; u.kstepA2 = 128; u.bjump = 0; u.lda = 256; u.lda2 = 256; return true; }
    DI void epi(AccRef acc, const pg8::GU& u, int wr, int wc, int fr, int fq) const {
#pragma unroll
        for (int ai = 0; ai < 2; ++ai)
#pragma unroll
            for (int m = 0; m < 4; ++m) { const size_t row = (size_t)u.pm * 256 + ai * 128 + wr * 64 + m * 16 + fr;
#pragma unroll
                for (int bj = 0; bj < 2; ++bj) { float v[8]; acc8(acc, ai, bj, m, v); *(u32x4*)(Y + row * 512 + u.pn * 256 + bj * 128 + wc * 32 + fq * 8) = pack8(v); } }
    }
};

DI void s5_carry_unit(Frame& F, int u) {
    const int b = u >> 4, g = u & 15, p = F.tid & 63, cg = F.tid >> 6;
    const float* SLOC = (const float*)(F.ws + WS_SLOC); bf16* S0 = (bf16*)(F.ws + WS_S0); const float* A64 = (const float*)(F.ws + WS_A64);
    LAS float* R15 = (LAS float*)(F.lds + RING_OFF);
    const float Ar = A64[(g * 64 + p) * 2], Ai = A64[(g * 64 + p) * 2 + 1];
    float xr[16], xi[16];
#pragma unroll
    for (int k = 0; k < 16; ++k) { const size_t base = ((size_t)(b * 128 + cg * 16 + k) * 16 + g) * 128; xr[k] = SLOC[base + p]; xi[k] = SLOC[base + 64 + p]; }
    float rr = 0.f, ri = 0.f;
#pragma unroll
    for (int k = 0; k < 16; ++k) { const float nr = Ar * rr - Ai * ri + xr[k], ni = Ar * ri + Ai * rr + xi[k]; rr = nr; ri = ni; xr[k] = rr; xi[k] = ri; }
    R15[(cg * 64 + p) * 2] = rr; R15[(cg * 64 + p) * 2 + 1] = ri;
    float A16r = Ar, A16i = Ai;
#pragma unroll
    for (int q = 0; q < 4; ++q) { const float nr = A16r * A16r - A16i * A16i, ni = 2.f * A16r * A16i; A16r = nr; A16i = ni; }
    WGBAR();
    float Gr = 0.f, Gi = 0.f;
    for (int q = 0; q < cg; ++q) { const float tr = R15[(q * 64 + p) * 2], ti = R15[(q * 64 + p) * 2 + 1]; const float nr = A16r * Gr - A16i * Gi + tr, ni = A16r * Gi + A16i * Gr + ti; Gr = nr; Gi = ni; }
    float pr = 1.f, pi = 0.f;
#pragma unroll
    for (int k = 0; k < 16; ++k) {
        float sr = pr * Gr - pi * Gi, si = pr * Gi + pi * Gr;
        if (k > 0) { sr += xr[k - 1]; si += xi[k - 1]; }
        const size_t base = ((size_t)(b * 128 + cg * 16 + k) * 16 + g) * 128;
        S0[base + p] = (bf16)f2bf(sr); S0[base + 64 + p] = (bf16)f2bf(si);
        const float nr = pr * Ar - pi * Ai, ni = pr * Ai + pi * Ar; pr = nr; pi = ni;
    }
    WGBAR();
}

constexpr int HG_FT = 0, HG_CUM = 8192, HG_SEG = 25600, HG_QT = 27648, HG_QE = 36864, HG_KT = 46080, HG_INT = 69120, HG_ST = 78336, HG_PS = 87552, HG_OUT = 105984;
constexpr int HP = 72;
constexpr int CP = 68;
DI float hg_lb(Frame& F, int l, int col) { if (l == 0) return 0.f; const float x0 = inp(F, I_LBL)[col], x1 = inp(F, I_LBL)[256 + col]; return 1.0f / (1.0f + expf(x0 - x1)); }
DI void hg_stepA(Frame& F, const bf16* PM, int tok0, int head, float lbk, float (&fv)[8], float (&cum)[8], float& last) {
    LAS bf16* FT = (LAS bf16*)(F.lds + HG_FT); LAS float* CUM = (LAS float*)(F.lds + HG_CUM); LAS float* SEG = (LAS float*)(F.lds + HG_SEG);
    { const int t = F.tid >> 3, kc = F.tid & 7; *(LAS u32x4*)(FT + t * 64 + kc * 8) = *(const u32x4*)(PM + (size_t)(tok0 + t) * PMP + 256 + head * 64 + kc * 8); }
    WGBAR();
    const int k = F.tid & 63, seg = F.tid >> 6; float run = 0.f;
#pragma unroll
    for (int j = 0; j < 8; ++j) { const float fr = bf2f(FT[(seg * 8 + j) * 64 + k]); const float f = lbk + (1.0f - lbk) * fsigmoid(fr); fv[j] = f; run += __logf(f); cum[j] = run; }
    SEG[seg * 64 + k] = run;
    WGBAR();
    float off = 0.f, tot = 0.f;
#pragma unroll
    for (int s = 0; s < 8; ++s) { const float v = SEG[s * 64 + k]; tot += v; if (s < seg) off += v; }
    last = tot;
#pragma unroll
    for (int j = 0; j < 8; ++j) { cum[j] += off; CUM[(seg * 8 + j) * CP + k] = cum[j]; }
}
DI void hg_load_inpT(Frame& F, const bf16* PM, int tok0, int head) {
    LAS bf16* INT = (LAS bf16*)(F.lds + HG_INT);
    const int s = F.tid >> 3, vc = F.tid & 7; const u32x4 w = *(const u32x4*)(PM + (size_t)(tok0 + s) * PMP + 512 + head * 64 + vc * 8);
    const unsigned ww[4] = {w.x, w.y, w.z, w.w};
#pragma unroll
    for (int j = 0; j < 4; ++j) { INT[(vc * 8 + 2 * j) * HP + s] = (bf16)(ww[j] & 0xffffu); INT[(vc * 8 + 2 * j + 1) * HP + s] = (bf16)(ww[j] >> 16); }
}
DI void hgrn_h1_unit(Frame& F, int l, int u) {
    const bf16* PM = (const bf16*)(F.ws + WS_PM); float* HST = (float*)(F.ws + WS_HST); float* HLAST = (float*)(F.ws + WS_HLAST);
    const int bh = u >> 7, c = u & 127, b = bh >> 2, head = bh & 3, tok0 = b * SEQ + c * 64;
    const int k = F.tid & 63, seg = F.tid >> 6;
    const float lbk = hg_lb(F, l, head * 64 + k);
    float fv[8], cum[8], last;
    hg_stepA(F, PM, tok0, head, lbk, fv, cum, last);
    LAS bf16* KST = (LAS bf16*)(F.lds + HG_QT);
    { float ks[8];
#pragma unroll
      for (int j = 0; j < 8; ++j) ks[j] = (1.0f - fv[j]) * fexp(last - cum[j]);
      *(LAS u32x4*)(KST + k * HP + seg * 8) = pack8(ks); }
    if (seg == 0) HLAST[(size_t)u * 64 + k] = last;
    hg_load_inpT(F, PM, tok0, head);
    WGBAR();
    { const int w = F.wave, kt = w >> 1, vts = (w & 1) * 2, row = F.lane & 15, quad = F.lane >> 4;
      const LAS bf16* INT = (const LAS bf16*)(F.lds + HG_INT);
#pragma unroll
      for (int vt = 0; vt < 2; ++vt) { f32x4 acc = (f32x4){0.f, 0.f, 0.f, 0.f};
#pragma unroll
          for (int ks = 0; ks < 2; ++ks) { const bf16x8 a = *(const LAS bf16x8*)(KST + (kt * 16 + row) * HP + ks * 32 + quad * 8), bb = *(const LAS bf16x8*)(INT + ((vts + vt) * 16 + row) * HP + ks * 32 + quad * 8);
              acc = __builtin_amdgcn_mfma_f32_16x16x32_bf16(a, bb, acc, 0, 0, 0); }
#pragma unroll
          for (int j = 0; j < 4; ++j) HST[(size_t)u * 4096 + (kt * 16 + quad * 4 + j) * 64 + (vts + vt) * 16 + row] = acc[j]; } }
    WGBAR();
}
DI void hgrn_carry_unit(Frame& F, int u) {
    float* HST = (float*)(F.ws + WS_HST); const float* HLAST = (const float*)(F.ws + WS_HLAST);
    const int bh = u >> 3, v = F.tid & 63, k = (F.tid >> 6) + 8 * (u & 7);
    float s = 0.f;
    for (int c0 = 0; c0 < 128; c0 += 8) {
        float d[8], dec[8];
#pragma unroll
        for (int j = 0; j < 8; ++j) { const size_t uu = (size_t)bh * 128 + c0 + j; d[j] = HST[uu * 4096 + k * 64 + v]; dec[j] = HLAST[uu * 64 + k]; }
#pragma unroll
        for (int j = 0; j < 8; ++j) { const size_t uu = (size_t)bh * 128 + c0 + j; HST[uu * 4096 + k * 64 + v] = s; s = fexp(dec[j]) * s + d[j]; }
    }
}
DI void hgrn_h3_unit(Frame& F, int l, int u) {
    const bf16* PM = (const bf16*)(F.ws + WS_PM); const float* HST = (const float*)(F.ws + WS_HST); bf16* OH = (bf16*)(F.ws + WS_OH);
    const int bh = u >> 7, c = u & 127, b = bh >> 2, head = bh & 3, tok0 = b * SEQ + c * 64;
    { const int k = F.tid & 63; const float lbk = hg_lb(F, l, head * 64 + k); float fv[8], cum[8], last; hg_stepA(F, PM, tok0, head, lbk, fv, cum, last); }
    hg_load_inpT(F, PM, tok0, head);
    { LAS bf16* ST = (LAS bf16*)(F.lds + HG_ST); const int k = F.tid >> 3, vc = F.tid & 7; const float* sp = HST + (size_t)u * 4096 + k * 64 + vc * 8;
      const f32x4 a = *(const f32x4*)sp, bb = *(const f32x4*)(sp + 4); const float sv[8] = {a.x, a.y, a.z, a.w, bb.x, bb.y, bb.z, bb.w};
#pragma unroll
      for (int j = 0; j < 8; ++j) ST[(vc * 8 + j) * HP + k] = (bf16)f2bf(sv[j]); }
    WGBAR();
    {
      const LAS bf16* FT = (const LAS bf16*)(F.lds + HG_FT); const LAS float* CUM = (const LAS float*)(F.lds + HG_CUM);
      LAS bf16* QT = (LAS bf16*)(F.lds + HG_QT); LAS bf16* QE = (LAS bf16*)(F.lds + HG_QE); LAS bf16* KT = (LAS bf16*)(F.lds + HG_KT);
      const int t = F.tid >> 3, kc = F.tid & 7, ib = t >> 4;
      float q[8], fr[8], cm[8], rf[8], o1[8], o2[8];
      unpack8(*(const u32x4*)(PM + (size_t)(tok0 + t) * PMP + head * 64 + kc * 8), q);
      unpack8(*(const LAS u32x4*)(FT + t * 64 + kc * 8), fr);
#pragma unroll
      for (int j = 0; j < 8; ++j) { cm[j] = CUM[t * CP + kc * 8 + j]; rf[j] = (ib > 0) ? CUM[(16 * ib - 1) * CP + kc * 8 + j] : 0.f; const float lbk = hg_lb(F, l, head * 64 + kc * 8 + j); fr[j] = 1.0f - (lbk + (1.0f - lbk) * fsigmoid(fr[j])); }
#pragma unroll
      for (int j = 0; j < 8; ++j) { o1[j] = q[j] * fexp(cm[j] - rf[j]); o2[j] = q[j] * fexp(cm[j]); }
      *(LAS u32x4*)(QT + t * HP + kc * 8) = pack8(o1); *(LAS u32x4*)(QE + t * HP + kc * 8) = pack8(o2);
      for (int i2 = ib; i2 < 4; ++i2) { const int rowoff = (i2 == 0) ? 0 : (i2 == 1) ? 16 : (i2 == 2) ? 48 : 96;
#pragma unroll
          for (int j = 0; j < 8; ++j) { const float r2 = (i2 > 0) ? CUM[(16 * i2 - 1) * CP + kc * 8 + j] : 0.f; o1[j] = fr[j] * fexp(fminf(r2 - cm[j], 80.f)); }
          *(LAS u32x4*)(KT + (rowoff + t) * HP + kc * 8) = pack8(o1); }
    }
    WGBAR();
    { const int w = F.wave, ib = w >> 1, vh = w & 1, row = F.lane & 15, quad = F.lane >> 4;
      const LAS bf16* QT = (const LAS bf16*)(F.lds + HG_QT); const LAS bf16* QE = (const LAS bf16*)(F.lds + HG_QE); const LAS bf16* KT = (const LAS bf16*)(F.lds + HG_KT);
      const LAS bf16* INT = (const LAS bf16*)(F.lds + HG_INT); const LAS bf16* ST = (const LAS bf16*)(F.lds + HG_ST);
      LAS bf16* PS = (LAS bf16*)(F.lds + HG_PS) + w * 16 * HP; LAS float* OUT = (LAS float*)(F.lds + HG_OUT);
      const int rowoff = (ib == 0) ? 0 : (ib == 1) ? 16 : (ib == 2) ? 48 : 96;
      const bf16x8 qa0 = *(const LAS bf16x8*)(QT + (16 * ib + row) * HP + quad * 8), qa1 = *(const LAS bf16x8*)(QT + (16 * ib + row) * HP + 32 + quad * 8);
      for (int st = 0; st < 4; ++st) {
          f32x4 acc = (f32x4){0.f, 0.f, 0.f, 0.f};
          if (st <= ib) { const bf16x8 b0 = *(const LAS bf16x8*)(KT + (rowoff + st * 16 + row) * HP + quad * 8), b1 = *(const LAS bf16x8*)(KT + (rowoff + st * 16 + row) * HP + 32 + quad * 8);
              acc = __builtin_amdgcn_mfma_f32_16x16x32_bf16(qa0, b0, acc, 0, 0, 0); acc = __builtin_amdgcn_mfma_f32_16x16x32_bf16(qa1, b1, acc, 0, 0, 0);
              if (st == ib) {
#pragma unroll
                  for (int j = 0; j < 4; ++j) if (row > quad * 4 + j) acc[j] = 0.f; } }
#pragma unroll
          for (int j = 0; j < 4; ++j) PS[(quad * 4 + j) * HP + st * 16 + row] = (bf16)f2bf(acc[j]);
      }
      LDS_WAIT(); asm volatile("" ::: "memory");
      const int nks = (ib >> 1) + 1;
#pragma unroll
      for (int vt = 0; vt < 2; ++vt) { f32x4 acc = (f32x4){0.f, 0.f, 0.f, 0.f}; const int vrow = (vh * 2 + vt) * 16 + row;
          for (int ks = 0; ks < nks; ++ks) { const bf16x8 a = *(const LAS bf16x8*)(PS + row * HP + ks * 32 + quad * 8), bb = *(const LAS bf16x8*)(INT + vrow * HP + ks * 32 + quad * 8);
              acc = __builtin_amdgcn_mfma_f32_16x16x32_bf16(a, bb, acc, 0, 0, 0); }
#pragma unroll
          for (int ks = 0; ks < 2; ++ks) { const bf16x8 a = *(const LAS bf16x8*)(QE + (16 * ib + row) * HP + ks * 32 + quad * 8), bb = *(const LAS bf16x8*)(ST + vrow * HP + ks * 32 + quad * 8);
              acc = __builtin_amdgcn_mfma_f32_16x16x32_bf16(a, bb, acc, 0, 0, 0); }
#pragma unroll
          for (int j = 0; j < 4; ++j) OUT[(16 * ib + quad * 4 + j) * CP + vrow] = acc[j]; }
    }
    WGBAR();
    { const LAS float* OUT = (const LAS float*)(F.lds + HG_OUT); const int t = F.tid >> 3, vc = F.tid & 7;
      float o[8], g[8]; float ss = 0.f;
#pragma unroll
      for (int j = 0; j < 8; ++j) { o[j] = OUT[t * CP + vc * 8 + j]; ss += o[j] * o[j]; }
      ss += __shfl_xor(ss, 1); ss += __shfl_xor(ss, 2); ss += __shfl_xor(ss, 4);
      const float rstd = 1.0f / sqrtf(ss * (1.0f / 64.0f) + EPS);
      unpack8(*(const u32x4*)(PM + (size_t)(tok0 + t) * PMP + 768 + head * 64 + vc * 8), g);
#pragma unroll
      for (int j = 0; j < 8; ++j) o[j] = o[j] * rstd * inp(F, I_HNG)[l * 64 + vc * 8 + j] * fsilu(g[j]);
      *(u32x4*)(OH + (size_t)(tok0 + t) * 256 + head * 64 + vc * 8) = pack8(o); }
    WGBAR();
}

DI void moba_prep_unit(Frame& F, int l, int u) {
    bf16* PM = (bf16*)(F.ws + WS_PM); float* KMEAN = (float*)(F.ws + WS_KMEAN);
    LAS float* KS = (LAS float*)(F.lds + RING_OFF);
    const int b = u >> 5, blk = u & 31, tg = F.tid >> 5, hd = (F.tid >> 3) & 3, dc = F.tid & 7;
    float qg[8], kg[8], ksum[8];
#pragma unroll
    for (int j = 0; j < 8; ++j) { qg[j] = inp(F, I_MQG)[l * 64 + dc * 8 + j] * attn_body::C2; kg[j] = inp(F, I_MKG)[l * 64 + dc * 8 + j]; ksum[j] = 0.f; }
    for (int it = 0; it < 16; ++it) {
        const size_t row = (size_t)b * SEQ + blk * 256 + it * 16 + tg;
        bf16* qp = PM + row * PMP + 1024 + hd * 64 + dc * 8; bf16* kp = PM + row * PMP + 1280 + hd * 64 + dc * 8;
        float q[8], k[8]; unpack8(*(const u32x4*)qp, q); unpack8(*(const u32x4*)kp, k);
        float sq = 0.f, sk = 0.f;
#pragma unroll
        for (int j = 0; j < 8; ++j) { sq += q[j] * q[j]; sk += k[j] * k[j]; }
        sq += __shfl_xor(sq, 1); sq += __shfl_xor(sq, 2); sq += __shfl_xor(sq, 4); sk += __shfl_xor(sk, 1); sk += __shfl_xor(sk, 2); sk += __shfl_xor(sk, 4);
        const float rq = 1.0f / sqrtf(sq * (1.0f / 64.0f) + EPS), rk = 1.0f / sqrtf(sk * (1.0f / 64.0f) + EPS);
#pragma unroll
        for (int j = 0; j < 8; ++j) { q[j] = q[j] * rq * qg[j]; k[j] = k[j] * rk * kg[j]; ksum[j] += k[j]; }
        *(u32x4*)qp = pack8(q); *(u32x4*)kp = pack8(k);
    }
#pragma unroll
    for (int j = 0; j < 8; ++j) KS[tg * 256 + hd * 64 + dc * 8 + j] = ksum[j];
    WGBAR();
    if (F.tid < 256) { float s = 0.f;
#pragma unroll
        for (int q = 0; q < 16; ++q) s += KS[q * 256 + F.tid];
        KMEAN[((size_t)(b * 4 + (F.tid >> 6)) * 32 + blk) * 64 + (F.tid & 63)] = s * (1.0f / 256.0f); }
    WGBAR();
}
DI void moba_select_unit(Frame& F, int u) {
    const bf16* PM = (const bf16*)(F.ws + WS_PM); const float* KMEAN = (const float*)(F.ws + WS_KMEAN); unsigned* SEL = (unsigned*)(F.ws + WS_SEL);
    LAS float* KM = (LAS float*)(F.lds + RING_OFF);
    const int b = u >> 5, blk = u & 31;
    for (int i = F.tid; i < 4 * 32 * 64 / 4; i += NTHR) ((LAS f32x4*)KM)[i] = ((const f32x4*)(KMEAN + (size_t)b * 4 * 32 * 64))[i];
    WGBAR();
    for (int r = 0; r < 2; ++r) {
        const int p = F.tid + NTHR * r, tokl = p & 255, hd = __builtin_amdgcn_readfirstlane(p >> 8);
        const size_t row = (size_t)b * SEQ + blk * 256 + tokl;
        float q[64];
#pragma unroll
        for (int c8 = 0; c8 < 8; ++c8) { float t8[8]; unpack8(*(const u32x4*)(PM + row * PMP + 1024 + hd * 64 + c8 * 8), t8);
#pragma unroll
            for (int j = 0; j < 8; ++j) q[c8 * 8 + j] = t8[j]; }
        float v0 = -INFINITY, v1 = -INFINITY, v2 = -INFINITY; int i0 = -1, i1 = -1, i2 = -1;
        for (int j = 0; j < blk; ++j) { const LAS f32x4* km = (const LAS f32x4*)(KM + (hd * 32 + j) * 64); float g = 0.f;
#pragma unroll
            for (int d4 = 0; d4 < 16; ++d4) { const f32x4 kk = km[d4]; g += q[d4 * 4] * kk.x + q[d4 * 4 + 1] * kk.y + q[d4 * 4 + 2] * kk.z + q[d4 * 4 + 3] * kk.w; }
            if (g > v0) { v2 = v1; i2 = i1; v1 = v0; i1 = i0; v0 = g; i0 = j; } else if (g > v1) { v2 = v1; i2 = i1; v1 = g; i1 = j; } else if (g > v2) { v2 = g; i2 = j; } }
        unsigned m = 1u << blk; if (i0 >= 0) m |= 1u << i0; if (i1 >= 0) m |= 1u << i1; if (i2 >= 0) m |= 1u << i2;
        SEL[row * 4 + hd] = m;
    }
    WGBAR();
}

DI void moe_route_unit(Frame& F, int l, int u) {
    const float* LOG = (const float*)(F.ws + WS_LOGITS); int* TOPI = (int*)(F.ws + WS_TOPI); float* TOPW = (float*)(F.ws + WS_TOPW);
    int* hist = (int*)(F.ldsg + RING_OFF); LAS float* biasl = (LAS float*)(F.lds + RING_OFF + 512);
    if (F.tid < 64) { hist[F.tid] = 0; biasl[F.tid] = inp(F, I_RB)[l * 64 + F.tid]; }
    WGBAR();
    const size_t t = (size_t)u * 512 + F.tid;
    float key[64];
#pragma unroll
    for (int c4 = 0; c4 < 16; ++c4) { const f32x4 v = *(const f32x4*)(LOG + t * 64 + c4 * 4);
        key[c4 * 4] = fsigmoid(v.x) + biasl[c4 * 4]; key[c4 * 4 + 1] = fsigmoid(v.y) + biasl[c4 * 4 + 1]; key[c4 * 4 + 2] = fsigmoid(v.z) + biasl[c4 * 4 + 2]; key[c4 * 4 + 3] = fsigmoid(v.w) + biasl[c4 * 4 + 3]; }
    int idx[6]; float sc[6]; float sum = 0.f;
#pragma unroll
    for (int k = 0; k < 6; ++k) { float best = -INFINITY; int bi = 0;
#pragma unroll
        for (int e = 0; e < 64; ++e) if (key[e] > best) { best = key[e]; bi = e; }
#pragma unroll
        for (int e = 0; e < 64; ++e) if (e == bi) key[e] = -INFINITY;
        idx[k] = bi; sc[k] = best - biasl[bi]; sum += sc[k]; }
    const float inv = 2.5f / sum;
#pragma unroll
    for (int k = 0; k < 6; ++k) { TOPI[t * 6 + k] = idx[k]; TOPW[t * 6 + k] = sc[k] * inv; atomicAdd(&hist[idx[k]], 1); }
    WGBAR();
    if (F.tid < 64) atomicAdd((unsigned*)(F.ctl + CW_CNT + l * 64 + F.tid), (unsigned)hist[F.tid]);
    WGBAR();
}
DI void moe_tables(Frame& F, int l, LAS int* blkpfx, LAS int* rowpfx) {
    LAS int* cn = rowpfx + 80;
    if (F.tid < NEXP) cn[F.tid] = (int)__hip_atomic_load(F.ctl + CW_CNT + l * 64 + F.tid, RLX_AGENT);
    WGBAR();
    if (F.tid == 0) { int acc = 0;
        for (int e = 0; e < NEXP; ++e) { const int cnt = cn[e]; blkpfx[e] = acc; rowpfx[e] = acc * 256; acc += (cnt + 255) >> 8; }
        blkpfx[NEXP] = acc; rowpfx[NEXP] = acc * 256; blkpfx[NEXP1] = acc + T_TOK / 256; rowpfx[NEXP1] = (acc + T_TOK / 256) * 256; }
    WGBAR();
}
DI void moe_scatter_unit(Frame& F, int l, int u, const LAS int* rowpfx) {
    const int* TOPI = (const int*)(F.ws + WS_TOPI); const float* TOPW = (const float*)(F.ws + WS_TOPW); int* POS = (int*)(F.ws + WS_POS); int* ROWTOK = (int*)(F.ws + WS_ROWTOK); float* ROWW = (float*)(F.ws + WS_ROWW);
    int* hist = (int*)(F.ldsg + RING_OFF); LAS int* basel = (LAS int*)(F.lds + RING_OFF + 512);
    if (F.tid < 64) hist[F.tid] = 0;
    WGBAR();
    const size_t t = (size_t)u * 512 + F.tid; int e[6], r[6];
#pragma unroll
    for (int k = 0; k < 6; ++k) { e[k] = TOPI[t * 6 + k]; r[k] = atomicAdd(&hist[e[k]], 1); }
    WGBAR();
    if (F.tid < 64) basel[F.tid] = (int)atomicAdd((unsigned*)(F.ctl + CW_CUR + l * 64 + F.tid), (unsigned)hist[F.tid]);
    WGBAR();
#pragma unroll
    for (int k = 0; k < 6; ++k) { const int pos = rowpfx[e[k]] + basel[e[k]] + r[k]; POS[t * 6 + k] = pos; ROWTOK[pos] = (int)t; ROWW[pos] = TOPW[t * 6 + k]; }
    WGBAR();
}
DI void moe_fill_rows(Frame& F, int l, const LAS int* rowpfx) {
    int* ROWTOK = (int*)(F.ws + WS_ROWTOK); float* ROWW = (float*)(F.ws + WS_ROWW);
    for (int e = F.vcu; e < NEXP; e += F.G) { const int cnt = (int)__hip_atomic_load(F.ctl + CW_CNT + l * 64 + e, RLX_AGENT); const int lo = rowpfx[e] + cnt, hi = rowpfx[e + 1];
        for (int i = lo + F.tid; i < hi; i += NTHR) { ROWTOK[i] = 0; ROWW[i] = 0.f; } }
    const int sh0 = rowpfx[NEXP];
    for (int t = F.vcu * NTHR + F.tid; t < T_TOK; t += F.G * NTHR) { ROWTOK[sh0 + t] = t; ROWW[sh0 + t] = 1.0f; }
}
DI void moe_combine(Frame& F, int half, const float* gate, float* X, const LAS int* rowpfx) {
    const int* POS = (const int*)(F.ws + WS_POS); const bf16* Y = (const bf16*)(F.ws + WS_Y);
    const int gw = F.vcu * NWAVES + F.wave, NGW = F.G * NWAVES; const int sh0 = rowpfx[NEXP];
    for (int t = gw; t < T_TOK; t += NGW) {
        const int b = t >> 13; int myp = (F.lane < 6) ? POS[(size_t)t * 6 + F.lane] : 0;
        float a[8];
#pragma unroll
        for (int j = 0; j < 8; ++j) a[j] = 0.f;
#pragma unroll
        for (int k = 0; k < 7; ++k) { const int row = (k < 6) ? __shfl(myp, k) : (sh0 + t); float v[8]; unpack8(*(const u32x4*)(Y + (size_t)row * 512 + F.lane * 8), v);
#pragma unroll
            for (int j = 0; j < 8; ++j) a[j] += v[j]; }
        const int col = half * 512 + F.lane * 8; float* xp = X + (size_t)t * DM + col; const float* gp = gate + b * 6144 + col;
        f32x4 x0 = *(const f32x4*)xp, x1 = *(const f32x4*)(xp + 4); const f32x4 g0 = *(const f32x4*)gp, g1 = *(const f32x4*)(gp + 4);
        x0 += g0 * (f32x4){a[0], a[1], a[2], a[3]}; x1 += g1 * (f32x4){a[4], a[5], a[6], a[7]};
        *(f32x4*)xp = x0; *(f32x4*)(xp + 4) = x1;
    }
}

#ifndef ONLY
#define ONLY -1
#endif
#define PH(n) (ONLY < 0 || ONLY == (n))
#ifndef ONLY5
#define ONLY5 -1
#endif
#define PH5(n) (ONLY5 < 0 || ONLY5 == (n))
#define GRID_BAR() do { XcdBarrier _b = bar; GAS unsigned* _p = (GAS unsigned*)_b.bar; asm volatile("" : "+s"(_p)); _b.bar = (unsigned*)_p; unsigned _x = _b.x; asm volatile("" : "+s"(_x)); _b.x = _x; xcd_barrier(_b); } while (0)
#define PHASE_BEGIN() do { int _t = threadIdx.x; asm volatile("" : "+v"(_t)); F.tid = _t; F.lane = _t & 63; F.wave = __builtin_amdgcn_readfirstlane(_t >> 6); GAS unsigned char* _w = (GAS unsigned char*)ws0; asm volatile("" : "+s"(_w)); F.ws = (unsigned char*)_w; ws = F.ws; F.ctl = (gu32*)(F.ws + WS_CTL); MOD = (float*)(ws + WS_MOD); modl = MOD + (size_t)l * 8 * 6144; } while (0)
template <int l> DI void run_layer(Frame& F, const XcdBarrier& bar, unsigned char* ws0, unsigned char* lds, LAS int* blkpfx, LAS int* rowpfx, int bx) {
    unsigned char* ws = ws0; float* MOD = (float*)(ws + WS_MOD);
        const float* Xin = (l == 0) ? inp(F, I_X) : (const float*)F.out;
        const float* modl = MOD + (size_t)l * 8 * 6144;
        if (PH(0)) { PHASE_BEGIN();
        if (l == 0) p0_adaln(F);
        p0_s5tab(F, l);
        p0_convert(F, l);
        }
        GRID_BAR();
        if (PH(1)) { PHASE_BEGIN();
        norm_rows(F, Xin, inp(F, I_N1G) + l * DM, modl + 0, modl + 1024, (bf16*)(ws + WS_H));
        p1_s5fill(F);
        }
        GRID_BAR();
        if (PH(2)) { PHASE_BEGIN();
        { PolWin P; P.setup(ws + WS_H, DM, ws + WS_WIN, DM, T_TOK, D_IN, F.G, bx); P.wsb = ws;
          pg8::gemm_phase(F.lds + RING_OFF, P); }
        }
        GRID_BAR();
        if (PH(3)) { PHASE_BEGIN();
        { PolS5a P; P.UG = (const char*)(ws + WS_UG); P.BT1 = (const char*)(ws + WS_BT1); P.SLOC = (float*)(ws + WS_SLOC); P.ldb = 1024; P.G = F.G; P.c = F.vcu;
          pg8::gemm_phase(F.lds + RING_OFF, P); }
        for (int u = F.vcu; u < 4096; u += F.G) hgrn_h1_unit(F, l, u);
        for (int u = F.vcu; u < 256; u += F.G) moba_prep_unit(F, l, u);
        }
        GRID_BAR();
        if (PH(4)) { PHASE_BEGIN();
        for (int u = F.vcu; u < 128; u += F.G) s5_carry_unit(F, u);
        for (int u = F.vcu; u < 256; u += F.G) hgrn_carry_unit(F, u);
        for (int u = F.vcu; u < 256; u += F.G) moba_select_unit(F, u);
        }
        GRID_BAR();
        if (PH(5)) { PHASE_BEGIN();
        if (PH5(0)) { PolS5b P; P.UG = (const char*)(ws + WS_UG); P.S0 = (const char*)(ws + WS_S0); P.BT2 = (const char*)(ws + WS_BT2); P.Dsk = inp(F, I_SSMD) + l * 256; P.YS5 = (bf16*)(ws + WS_YS5); P.ldb = 1152; P.G = F.G; P.c = F.vcu;
          pg8::gemm_phase(F.lds + RING_OFF, P); }
        if (PH5(1)) for (int u = F.vcu; u < 4096; u += F.G) hgrn_h3_unit(F, l, u);
        if (PH5(2)) { const attn_body::bf16* pm = (const attn_body::bf16*)(ws + WS_PM);
          const attn_body::AttnTensors AT{pm + 1024, pm + 1280, pm + 1536, (attn_body::bf16*)(ws + WS_OM), (const unsigned*)(ws + WS_SEL)};
          const attn_body::StaticOrder S((int)F.G, bx);
          attn_body::attn_phase<attn_body::StaticOrder>((char*)lds + RING_OFF, AT, S); }
        }
        GRID_BAR();
        if (PH(6)) { PHASE_BEGIN();
        { PolGlu P; P.setup(ws + WS_YS5, 256, ws + WS_WGLU, 256, T_TOK, 2048, F.G, bx); P.GL = (const bf16*)(ws + WS_GL); P.MERGED = (bf16*)(ws + WS_MERGED);
          pg8::gemm_phase(F.lds + RING_OFF, P); }
        }
        GRID_BAR();
        if (PH(7)) { PHASE_BEGIN();
        { PolRmw P; P.A1 = (const char*)(ws + WS_OH); P.A2 = (const char*)(ws + WS_OM); P.B1 = (const char*)(ws + WS_WHO); P.B2 = (const char*)(ws + WS_WMO);
          P.GL = (const bf16*)(ws + WS_GL); P.MERGED = (bf16*)(ws + WS_MERGED); P.ldb = 256; P.ord.init(T_TOK, DM, F.G, bx); P.nper = (P.ord.nwg > P.ord.c) ? (P.ord.nwg - P.ord.c + P.ord.G - 1) / P.ord.G : 0;
          pg8::gemm_phase(F.lds + RING_OFF, P); }
        }
        GRID_BAR();
        if (PH(9)) { PHASE_BEGIN();
        { PolWout P; P.setup(ws + WS_MERGED, DM, ws + WS_WOUT, DM, T_TOK, DM, F.G, bx); P.Xin = Xin; P.X = F.out; P.gate = modl + 2048;
          pg8::gemm_phase(F.lds + RING_OFF, P); }
        }
        GRID_BAR();
        if (PH(10)) { PHASE_BEGIN();
        norm_rows(F, F.out, inp(F, I_N2G) + l * DM, modl + 3072, modl + 4096, (bf16*)(ws + WS_H2));
        }
        GRID_BAR();
        if (PH(11)) { PHASE_BEGIN();
        { PolRouter P; P.setup(ws + WS_H2, DM, ws + WS_WR, DM, T_TOK, 256, F.G, bx); P.LOG = (float*)(ws + WS_LOGITS);
          pg8::gemm_phase(F.lds + RING_OFF, P); }
        }
        GRID_BAR();
        if (PH(12)) { PHASE_BEGIN();
        for (int u = F.vcu; u < T_TOK / 512; u += F.G) moe_route_unit(F, l, u);
        }
        GRID_BAR();
        if (PH(13)) { PHASE_BEGIN();
        moe_tables(F, l, blkpfx, rowpfx);
        for (int u = F.vcu; u < T_TOK / 512; u += F.G) moe_scatter_unit(F, l, u, rowpfx);
        moe_fill_rows(F, l, rowpfx);
        }
        GRID_BAR();
        if (PH(14)) { PHASE_BEGIN();
        { PolGateUp P; P.gs.blkpfx = blkpfx; P.gs.nNt = 2; P.gs.G = F.G; P.gs.c = bx; P.H2 = (const char*)(ws + WS_H2); P.WGU = (const char*)(ws + WS_WGU);
          P.ROWTOK = (const int*)(ws + WS_ROWTOK); P.ROWW = (const float*)(ws + WS_ROWW); P.HID = (bf16*)(ws + WS_HID); P.ldb = 1024;
          pg8::gemm_phase(F.lds + RING_OFF, P); }
        }
        GRID_BAR();
        if (PH(15)) { PHASE_BEGIN();
        for (int half = 0; half < 2; ++half) {
            { PolDown P; P.gs.blkpfx = blkpfx; P.gs.nNt = 2; P.gs.G = F.G; P.gs.c = bx; P.HIDp = (const char*)(ws + WS_HID); P.WD = (const char*)(ws + WS_WD); P.Y = (bf16*)(ws + WS_Y); P.ldb = 256; P.half = half;
              pg8::gemm_phase(F.lds + RING_OFF, P); }
            GRID_BAR();
            moe_combine(F, half, modl + 5120, F.out, rowpfx);
            GRID_BAR();
        }
        }
}
struct Args { const float* in[31]; float* out; unsigned char* ws; int pad0, pad1; };
__global__ void __launch_bounds__(NTHR, 2) fwd_kernel(Args args) {
    extern __shared__ __attribute__((aligned(16))) unsigned char lds[];
    Frame F;
    F.lds = (LAS unsigned char*)lds; F.ldsg = lds;
    F.MISC = (volatile LAS unsigned*)(F.lds + MISC_OFF);
    F.tid = threadIdx.x; F.lane = F.tid & 63; F.wave = __builtin_amdgcn_readfirstlane(F.tid >> 6);
    F.G = gridDim.x; { const int bx = blockIdx.x; F.vcu = (F.G % 8 == 0) ? (bx % 8) * (F.G / 8) + bx / 8 : bx; }
    F.ws = args.ws; F.ctl = (gu32*)(args.ws + WS_CTL); F.out = args.out;
    for (int u = F.tid; u < (LDS_BYTES - LDSCTL_OFF) / 4; u += NTHR) ((LAS unsigned*)(F.lds + LDSCTL_OFF))[u] = 0u;
    __syncthreads();
    if (F.tid < 31) ((LAS unsigned long long*)(F.lds + PTR_OFF))[F.tid] = (unsigned long long)args.in[F.tid];
    __syncthreads();
    XcdBarrier bar = xcd_barrier_post((unsigned*)(F.ctl + CW_BAR), F.MISC + 8);
    unsigned char* ws = F.ws;
    LAS int* blkpfx = (LAS int*)(F.lds + LDSCTL_OFF); LAS int* rowpfx = (LAS int*)(F.lds + LDSCTL_OFF + 320);
    float* MOD = (float*)(ws + WS_MOD);
    const int bx = (int)blockIdx.x;
    run_layer<0>(F, bar, args.ws, lds, blkpfx, rowpfx, bx);
    run_layer<1>(F, bar, args.ws, lds, blkpfx, rowpfx, bx);
}

extern "C" void kernel_launch(void* const* d_in, const int* in_sizes, int n_in, void* d_out, int out_size, void* d_ws, size_t ws_size, hipStream_t stream) {
    static int grid = 0;
    if (grid == 0) {
        if (n_in != 31 || in_sizes[0] != T_TOK * DM || out_size != T_TOK * DM || ws_size < WS_END) {
            fprintf(stderr, "kernel_launch: unexpected shapes (n_in %d, in0 %d, out %d, ws %zu, need %zu); nothing launched\n", n_in, n_in > 0 ? in_sizes[0] : -1, out_size, ws_size, (size_t)WS_END); grid = -1; return; }
        int dev = 0, cus = 0, per_cu = 0;
        if (hipGetDevice(&dev) != hipSuccess || hipDeviceGetAttribute(&cus, hipDeviceAttributeMultiprocessorCount, dev) != hipSuccess) { grid = -1; return; }
        if (hipFuncSetAttribute((const void*)fwd_kernel, hipFuncAttributeMaxDynamicSharedMemorySize, LDS_BYTES) != hipSuccess) { fprintf(stderr, "kernel_launch: hipFuncSetAttribute failed\n"); grid = -1; return; }
        if (hipOccupancyMaxActiveBlocksPerMultiprocessor(&per_cu, (const void*)fwd_kernel, NTHR, LDS_BYTES) != hipSuccess || per_cu < 1) { fprintf(stderr, "kernel_launch: occupancy query says %d\n", per_cu); }
        (void)hipGetLastError();
        grid = cus;
    }
    if (grid < 0) return;
    if (hipMemsetAsync((char*)d_ws + WS_CTL, 0, CTL_ZERO_BYTES, stream) != hipSuccess) return;
    Args a{};
    for (int i = 0; i < 31; ++i) a.in[i] = (const float*)d_in[i];
    a.out = (float*)d_out; a.ws = (unsigned char*)d_ws; a.pad0 = 0; a.pad1 = 0;
    hipLaunchKernelGGL(fwd_kernel, dim3(grid), dim3(NTHR), LDS_BYTES, stream, a);
}
```

```cpp
#include <hip/hip_runtime.h>
#include <cstdio>
#include <cstdint>

#define GAS __attribute__((address_space(1)))
#define LAS __attribute__((address_space(3)))
typedef unsigned short bf16;
typedef short bf16x8 __attribute__((ext_vector_type(8)));
typedef float f32x4 __attribute__((ext_vector_type(4)));
typedef float f32x2 __attribute__((ext_vector_type(2)));
typedef unsigned u32x4 __attribute__((ext_vector_type(4)));
typedef unsigned u32x2 __attribute__((ext_vector_type(2)));
typedef GAS unsigned gu32;
#define RLX_AGENT __ATOMIC_RELAXED, __HIP_MEMORY_SCOPE_AGENT
#define LDS_WAIT() asm volatile("s_waitcnt lgkmcnt(0)" ::: "memory")
#define VM_WAIT() asm volatile("s_waitcnt vmcnt(0)" ::: "memory")
#define DI __device__ __forceinline__

DI unsigned f2bf(float f) { unsigned u = __builtin_bit_cast(unsigned, f); return (u + 0x7fffu + ((u >> 16) & 1u)) >> 16; }
DI unsigned pk2(float lo, float hi) { return f2bf(lo) | (f2bf(hi) << 16); }
DI float bflo(unsigned w) { return __builtin_bit_cast(float, w << 16); }
DI float bfhi(unsigned w) { return __builtin_bit_cast(float, w & 0xffff0000u); }
DI float bf2f(bf16 b) { return __builtin_bit_cast(float, ((unsigned)b) << 16); }
DI unsigned cvt_pk_bf16(float lo, float hi) { unsigned r; asm volatile("v_cvt_pk_bf16_f32 %0, %1, %2" : "=v"(r) : "v"(lo), "v"(hi)); return r; }
DI float fsigmoid(float x) { return __builtin_amdgcn_rcpf(1.0f + __builtin_amdgcn_exp2f(-1.4426950408889634f * x)); }
DI float fsilu(float x) { return x * fsigmoid(x); }
DI float fexp(float x) { return __builtin_amdgcn_exp2f(1.4426950408889634f * x); }
DI float gelu_tanh(float y) { const float z = 1.5957691216057308f * (y + 0.044715f * y * y * y); return y * fsigmoid(z); }
DI void unpack8(const u32x4 w, float (&o)[8]) { o[0] = bflo(w.x); o[1] = bfhi(w.x); o[2] = bflo(w.y); o[3] = bfhi(w.y); o[4] = bflo(w.z); o[5] = bfhi(w.z); o[6] = bflo(w.w); o[7] = bfhi(w.w); }
DI u32x4 pack8(const float (&v)[8]) { u32x4 w; w.x = cvt_pk_bf16(v[0], v[1]); w.y = cvt_pk_bf16(v[2], v[3]); w.z = cvt_pk_bf16(v[4], v[5]); w.w = cvt_pk_bf16(v[6], v[7]); return w; }

namespace pg8 {
constexpr int BM = 256, BK = 64, HALF = 128, HTB = HALF * BK * 2, STAGE_BYTES = 8 * HTB, NXCD = 8, WGM = 8;
__host__ __device__ __forceinline__ int lds_byte(int r, int c) { const int st = (r >> 4) * 2 + (c >> 5), rr = r & 15, cc = c & 31, ob = rr * 64 + cc * 2; return st * 1024 + (ob ^ (((ob >> 9) & 1) << 5)); }
__host__ __device__ __forceinline__ void stage_rc(int b, int& R, int& C) { const int st = b / 1024, sb = b % 1024, swz = sb ^ (((sb >> 9) & 1) << 5); R = (st >> 1) * 16 + swz / 64; C = (st & 1) * 32 + (swz % 64) / 2; }
__host__ __device__ __forceinline__ int perm32(int rho) { const int n = rho >> 4, i = rho & 15; return 8 * (i >> 2) + 4 * n + (i & 3); }

struct GU { const char* A; const char* A2; const char* B; int nt1, nt, kstepA, kstepA2, bjump, pm, pn, e, lda, lda2; };

struct TileOrder {
    int nM, nN, nwg, G, c;
    DI void init(int M, int N, int G_, int c_) { nM = M / BM; nN = N / BM; nwg = nM * nN; G = G_; c = c_; }
    DI bool next(int i, int& pm, int& pn) const {
        const long L = (long)i * G + c; if (L >= nwg) return false;
        int wgid = (int)L; { const int q = nwg / NXCD, r = nwg % NXCD, xcd = wgid % NXCD, off = wgid / NXCD; wgid = (xcd < r ? xcd * (q + 1) : r * (q + 1) + (xcd - r) * q) + off; }
        const int nig = WGM * nN, gid = wgid / nig, fm = gid * WGM, gsz = (nM - fm) < WGM ? (nM - fm) : WGM;
        pm = fm + ((wgid % nig) % gsz); pn = (wgid % nig) / gsz; return true;
    }
};

template <class P>
__device__ __forceinline__ void gemm_phase(LAS unsigned char* lds, const P& S) {
    int tid = threadIdx.x; asm volatile("" : "+v"(tid));
    const int wid = __builtin_amdgcn_readfirstlane(tid >> 6), lane = tid & 63, wr = wid >> 2, wc = wid & 3, fr = lane & 15, fq = lane >> 4;
    int R[2], C[2]; unsigned voffB[2], voffA1[2], voffA2[2];
#pragma unroll
    for (int i = 0; i < 2; ++i) { stage_rc(tid * 16 + i * 8192, R[i], C[i]); const int Rb = P::PERM ? ((R[i] & ~31) + perm32(R[i] & 31)) : R[i]; voffB[i] = (unsigned)(Rb * S.ldb + C[i]) * 2u;
        voffA1[i] = (unsigned)(R[i] * S.lda + C[i]) * 2u; voffA2[i] = (unsigned)(R[i] * (S.lda2 - S.lda)) * 2u; }
    const unsigned hstepB = (unsigned)HALF * (unsigned)S.ldb * 2u;
    const unsigned ldsw = (unsigned)wid * 1024u;
    const int aoff = lds_byte(wr * 64 + fr, fq * 8), boff = lds_byte(wc * 32 + fr, fq * 8);
#define PG8_SA(b, h) (((b) * 2 + (h)) * HTB)
#define PG8_SB(b, h) ((4 + (b) * 2 + (h)) * HTB)
#define PG8_STAGE_A(bufoff, h, U, V, t) do { const int _t = (t); const bool _s2 = P::SEG2 && (_t >= (U).nt1); \
        const char* _gb = (_s2 ? (U).A2 + (size_t)(_t - (U).nt1) * (size_t)(U).kstepA2 : (U).A + (size_t)_t * (size_t)(U).kstepA) + (P::GATHER ? (size_t)0 : (size_t)(h) * (size_t)(128 * 2) * (size_t)(_s2 ? S.lda2 : S.lda)); \
        _Pragma("unroll") for (int _i = 0; _i < 2; ++_i) { const unsigned _o = P::GATHER ? (V)[h][_i] : (P::SEG2 ? (voffA1[_i] + (voffA2[_i] & (0u - (unsigned)_s2))) : voffA1[_i]); \
        __builtin_amdgcn_global_load_lds((const unsigned*)(_gb + _o), (LAS unsigned*)(lds + (bufoff) + ldsw + _i * 8192), 16, 0, 0); } } while (0)
#define PG8_STAGE_B(bufoff, h, U, t) do { const int _t = (t); const char* _gb = (U).B + (size_t)(h) * hstepB + (size_t)_t * 128u + ((P::SEG2 && _t >= (U).nt1) ? (size_t)(U).bjump : (size_t)0); \
        _Pragma("unroll") for (int _i = 0; _i < 2; ++_i) __builtin_amdgcn_global_load_lds((const unsigned*)(_gb + voffB[_i]), (LAS unsigned*)(lds + (bufoff) + ldsw + _i * 8192), 16, 0, 0); } while (0)
#define PG8_LDA(dst, b, h) do { _Pragma("unroll") for (int m = 0; m < 4; ++m) _Pragma("unroll") for (int k = 0; k < 2; ++k) dst[m][k] = *(const LAS bf16x8*)(lds + PG8_SA(b, h) + aoff + m * 2048 + k * 1024); } while (0)
#define PG8_LDB(dst, b, h) do { _Pragma("unroll") for (int n = 0; n < 2; ++n) _Pragma("unroll") for (int k = 0; k < 2; ++k) dst[n][k] = *(const LAS bf16x8*)(lds + PG8_SB(b, h) + boff + n * 2048 + k * 1024); } while (0)
#define PG8_MMA(ai, bj, At, Bt) do { __builtin_amdgcn_s_setprio(1); _Pragma("unroll") for (int m = 0; m < 4; ++m) _Pragma("unroll") for (int n = 0; n < 2; ++n) _Pragma("unroll") for (int k = 0; k < 2; ++k) \
        acc[ai][bj][m][n] = __builtin_amdgcn_mfma_f32_16x16x32_bf16(Bt[n][k], At[m][k], acc[ai][bj][m][n], 0, 0, 0); __builtin_amdgcn_s_setprio(0); } while (0)
#define PG8_WAIT_V(n) asm volatile("s_waitcnt vmcnt(" #n ")" ::: "memory")
#define PG8_WAIT_L(n) asm volatile("s_waitcnt lgkmcnt(" #n ")" ::: "memory")
#define PG8_BAR __builtin_amdgcn_s_barrier()
#define PG8_SCHED __builtin_amdgcn_sched_barrier(0)
    GU cur, nxt; int ui = 0;
    if (!S.next(0, cur)) return;
    unsigned vAc[2][2], vAn[2][2];
    if constexpr (P::GATHER) S.avoff(cur, R, C, vAc); else { vAc[0][0] = vAc[0][1] = vAc[1][0] = vAc[1][1] = 0u; }
    f32x4 acc[2][2][4][2];
#pragma unroll
    for (int a = 0; a < 2; ++a)
#pragma unroll
        for (int b = 0; b < 2; ++b)
#pragma unroll
            for (int m = 0; m < 4; ++m)
#pragma unroll
                for (int n = 0; n < 2; ++n) acc[a][b][m][n] = (f32x4){0.f, 0.f, 0.f, 0.f};
    bf16x8 At[4][2], B0[2][2], B1[2][2];
    PG8_STAGE_B(PG8_SB(0, 0), 0, cur, 0); PG8_STAGE_B(PG8_SB(0, 1), 1, cur, 0); PG8_STAGE_A(PG8_SA(0, 0), 0, cur, vAc, 0); PG8_STAGE_A(PG8_SA(0, 1), 1, cur, vAc, 0);
    if (wr == 1) PG8_BAR;
    PG8_WAIT_V(2); PG8_BAR;
    PG8_STAGE_B(PG8_SB(1, 0), 0, cur, 1); PG8_STAGE_A(PG8_SA(1, 0), 0, cur, vAc, 1); PG8_STAGE_B(PG8_SB(1, 1), 1, cur, 1);
    PG8_WAIT_V(6); PG8_BAR;
    for (;;) {
        const bool has_next = S.next(ui + 1, nxt);
        if (!has_next) nxt = cur;
        if constexpr (P::GATHER) { if (has_next) S.avoff(nxt, R, C, vAn); else {
#pragma unroll
            for (int h = 0; h < 2; ++h)
#pragma unroll
                for (int i = 0; i < 2; ++i) vAn[h][i] = vAc[h][i]; } }
        else { vAn[0][0] = vAn[0][1] = vAn[1][0] = vAn[1][1] = 0u; }
        const int nt = cur.nt;
        for (int t = 0; t < nt; t += 2) {
            const bool last = (t == nt - 2);
            GU U2 = cur; unsigned V2a[2][2]; int t2 = t + 2;
#pragma unroll
            for (int h = 0; h < 2; ++h)
#pragma unroll
                for (int i = 0; i < 2; ++i) V2a[h][i] = (P::GATHER && last) ? vAn[h][i] : vAc[h][i];
            if (last) { U2 = nxt; t2 = 0; }
            const int t3 = t2 + 1;
            PG8_LDB(B0, 0, 0); PG8_LDB(B1, 0, 1); PG8_SCHED; PG8_LDA(At, 0, 0); PG8_STAGE_A(PG8_SA(1, 1), 1, cur, vAc, t + 1);
            PG8_WAIT_V(8); PG8_WAIT_L(0); PG8_BAR; PG8_MMA(0, 0, At, B0); PG8_MMA(0, 1, At, B1); PG8_BAR; PG8_SCHED;
            PG8_LDA(At, 0, 1); PG8_STAGE_B(PG8_SB(0, 0), 0, U2, t2); PG8_STAGE_B(PG8_SB(0, 1), 1, U2, t2); PG8_STAGE_A(PG8_SA(0, 0), 0, U2, V2a, t2);
            PG8_WAIT_V(8); PG8_WAIT_L(0); PG8_BAR; PG8_MMA(1, 0, At, B0); PG8_MMA(1, 1, At, B1); PG8_BAR; PG8_SCHED;
            PG8_LDB(B0, 1, 0); PG8_LDB(B1, 1, 1); PG8_SCHED; PG8_LDA(At, 1, 0); PG8_STAGE_A(PG8_SA(0, 1), 1, U2, V2a, t2);
            PG8_WAIT_V(8); PG8_WAIT_L(0); PG8_BAR; PG8_MMA(0, 0, At, B0); PG8_MMA(0, 1, At, B1); PG8_BAR; PG8_SCHED;
            PG8_LDA(At, 1, 1); PG8_STAGE_B(PG8_SB(1, 0), 0, U2, t3); PG8_STAGE_B(PG8_SB(1, 1), 1, U2, t3); PG8_STAGE_A(PG8_SA(1, 0), 0, U2, V2a, t3);
            PG8_WAIT_V(8); PG8_WAIT_L(0); PG8_BAR; PG8_MMA(1, 0, At, B0); PG8_MMA(1, 1, At, B1); PG8_BAR; PG8_SCHED;
        }
        if (wr == 0) PG8_BAR;
        S.epi(acc, cur, wr, wc, fr, fq);
        if (!has_next) break;
#pragma unroll
        for (int a = 0; a < 2; ++a)
#pragma unroll
            for (int b = 0; b < 2; ++b)
#pragma unroll
                for (int m = 0; m < 4; ++m)
#pragma unroll
                    for (int n = 0; n < 2; ++n) acc[a][b][m][n] = (f32x4){0.f, 0.f, 0.f, 0.f};
        cur = nxt;
#pragma unroll
        for (int h = 0; h < 2; ++h)
#pragma unroll
            for (int i = 0; i < 2; ++i) vAc[h][i] = vAn[h][i];
        ++ui;
        if (wr == 1) PG8_BAR;
    }
    PG8_WAIT_V(0);
    PG8_BAR;
#undef PG8_SA
#undef PG8_SB
#undef PG8_STAGE_A
#undef PG8_STAGE_B
#undef PG8_LDA
#undef PG8_LDB
#undef PG8_MMA
#undef PG8_WAIT_V
#undef PG8_WAIT_L
#undef PG8_BAR
#undef PG8_SCHED
}
}
#include <hip/hip_bf16.h>
#include <cmath>
namespace attn_body {
using bf16=__hip_bfloat16;
using bf16x8=__attribute__((ext_vector_type(8)))short;
using s16x4=__attribute__((ext_vector_type(4)))short;
using f32x16=__attribute__((ext_vector_type(16)))float;
using u32x4=__attribute__((ext_vector_type(4)))unsigned;
constexpr int BATCH=8,NHEAD=4,SEQ=8192,D=64,DM=1792;
constexpr int NW=8,QBLK=32,QB=QBLK*NW,KVBLK=64,NQB=SEQ/QB;
constexpr int ATTN_PITCH=DM, ATTN_UNIT_ROWS=QB, OPITCH=256;
__device__ __forceinline__ int crow(int r,int hi){return (r&3)+8*(r>>2)+4*hi;}
#define SBAR() __builtin_amdgcn_sched_barrier(0)
__device__ __forceinline__ void cmask(f32x16&p0,f32x16&p1,int jb,int qrel,int hi){
  const float NEG=-INFINITY; int kb=64*jb+4*hi;
  #pragma unroll
  for(int r=0;r<16;++r){int kv=kb+(r&3)+8*(r>>2); if(kv>qrel)p0[r]=NEG; if(kv+32>qrel)p1[r]=NEG;}
}

__device__ __forceinline__ void bmask(f32x16&p0,f32x16&p1,bool keep){ if(!keep){
  #pragma unroll
  for(int r=0;r<16;++r){p0[r]=-120.f;p1[r]=-120.f;} } }
constexpr int NSLOT=3, SLOTB=8192;
constexpr int LDS_K=0, LDS_V=NSLOT*SLOTB, LDS_WS=2*NSLOT*SLOTB, LDS_OST=LDS_WS+NW*64*4, LDS_BYTES=LDS_OST+NW*4096;
constexpr float C2=0.125f*1.4426950408889634f;
__device__ __forceinline__ void glds16(const void*gsrc,unsigned lds_dst){unsigned keep;
  asm volatile("s_mov_b32 %0, m0\n\ts_mov_b32 m0, %2\n\ts_nop 0\n\tglobal_load_lds_dwordx4 %1, off\n\ts_mov_b32 m0, %0":"=&s"(keep):"v"(gsrc),"s"(lds_dst):"memory");}
__device__ __forceinline__ float max3f(float a,float b,float c){float r;asm("v_max3_f32 %0, %1, %2, %3":"=v"(r):"v"(a),"v"(b),"v"(c));return r;}
__device__ __forceinline__ float max2f(float a,float b){float r;asm("v_max_f32_e32 %0, %1, %2":"=v"(r):"v"(a),"v"(b));return r;}
__device__ __forceinline__ float fadd_s(float a,float b){float r;asm("v_add_f32_e32 %0, %1, %2":"=v"(r):"v"(a),"v"(b));return r;}
__device__ __forceinline__ float fsub_s(float a,float b){float r;asm("v_sub_f32_e32 %0, %1, %2":"=v"(r):"v"(a),"v"(b));return r;}
typedef float f32x2_t __attribute__((ext_vector_type(2))); typedef __bf16 bf16x2_t __attribute__((ext_vector_type(2)));
__device__ __forceinline__ unsigned cvtpk_s(float lo,float hi){f32x2_t v={lo,hi};bf16x2_t b=__builtin_convertvector(v,bf16x2_t);return __builtin_bit_cast(unsigned,b);}
#define WAIT_BAR(N) asm volatile("s_waitcnt vmcnt(" #N ") lgkmcnt(0)\n\ts_barrier":::"memory")

__device__ __forceinline__ void qkt(f32x16&p0,f32x16&p1,const char*Kslot,const bf16x8*qr,const f32x16&negm,int r32,int hi){
  const char*kb=Kslot+hi*1024+r32*16;
  #pragma unroll
  for(int d0=0;d0<4;++d0){
    const bf16x8 b0=*reinterpret_cast<const bf16x8*>(kb+d0*2048);
    const bf16x8 b1=*reinterpret_cast<const bf16x8*>(kb+d0*2048+512);
    if(d0==0){p0=__builtin_amdgcn_mfma_f32_32x32x16_bf16(b0,qr[0],negm,0,0,0);p1=__builtin_amdgcn_mfma_f32_32x32x16_bf16(b1,qr[0],negm,0,0,0);}
    else{p0=__builtin_amdgcn_mfma_f32_32x32x16_bf16(b0,qr[d0],p0,0,0,0);p1=__builtin_amdgcn_mfma_f32_32x32x16_bf16(b1,qr[d0],p1,0,0,0);}}
}
typedef __attribute__((address_space(3))) const char* lds_cptr;
typedef short v4i16_t __attribute__((ext_vector_type(4)));
__device__ __forceinline__ void kload8(bf16x8*kf,lds_cptr kp){
  kf[0]=*(const __attribute__((address_space(3))) bf16x8*)(kp);      kf[1]=*(const __attribute__((address_space(3))) bf16x8*)(kp+512);
  kf[2]=*(const __attribute__((address_space(3))) bf16x8*)(kp+2048); kf[3]=*(const __attribute__((address_space(3))) bf16x8*)(kp+2560);
  kf[4]=*(const __attribute__((address_space(3))) bf16x8*)(kp+4096); kf[5]=*(const __attribute__((address_space(3))) bf16x8*)(kp+4608);
  kf[6]=*(const __attribute__((address_space(3))) bf16x8*)(kp+6144); kf[7]=*(const __attribute__((address_space(3))) bf16x8*)(kp+6656);
}
__device__ __forceinline__ void kload2(bf16x8*kf,lds_cptr kp,int j){ kf[2*j]=*(const __attribute__((address_space(3))) bf16x8*)(kp+j*2048); kf[2*j+1]=*(const __attribute__((address_space(3))) bf16x8*)(kp+j*2048+512); }
__device__ __forceinline__ s16x4 vtr(lds_cptr p){ return __builtin_bit_cast(s16x4,__builtin_amdgcn_ds_read_tr16_b64_v4i16((__attribute__((address_space(3))) v4i16_t*)p)); }
__device__ __forceinline__ float rowmax(const f32x16&p0,const f32x16&p1){
  float a=max3f(p0[0],p0[1],p1[0]),b=max3f(p0[2],p0[3],p1[1]);a=max3f(a,p1[2],p1[3]);
  #pragma unroll
  for(int r=4;r<16;r+=4){a=max3f(a,p0[r],p0[r+1]);b=max3f(b,p0[r+2],p0[r+3]);a=max3f(a,p1[r],p1[r+1]);b=max3f(b,p1[r+2],p1[r+3]);}
  const float m=max2f(a,b);
  auto rr=__builtin_amdgcn_permlane32_swap(__float_as_uint(m),__float_as_uint(m),false,false);
  return max2f(__uint_as_float(rr[0]),__uint_as_float(rr[1]));
}
__device__ __forceinline__ void pv(f32x16*o,int vb,bf16x8 pa0,bf16x8 pa1,bf16x8 pa2,bf16x8 pa3){
  #pragma unroll
  for(int d0=0;d0<2;++d0){s16x4 lo[4],hi[4];
    #pragma unroll
    for(int ks=0;ks<4;++ks){
      asm volatile("ds_read_b64_tr_b16 %0,%1 offset:%c2":"=&v"(lo[ks]):"v"(vb),"i"(d0*4096+ks*1024):"memory");
      asm volatile("ds_read_b64_tr_b16 %0,%1 offset:%c2":"=&v"(hi[ks]):"v"(vb),"i"(d0*4096+ks*1024+512):"memory");}
    asm volatile("s_waitcnt lgkmcnt(0)":::"memory");SBAR();
    #define PK(k) (bf16x8){lo[k][0],lo[k][1],lo[k][2],lo[k][3],hi[k][0],hi[k][1],hi[k][2],hi[k][3]}
    o[d0]=__builtin_amdgcn_mfma_f32_32x32x16_bf16(pa0,PK(0),o[d0],0,0,0);
    o[d0]=__builtin_amdgcn_mfma_f32_32x32x16_bf16(pa1,PK(1),o[d0],0,0,0);
    o[d0]=__builtin_amdgcn_mfma_f32_32x32x16_bf16(pa2,PK(2),o[d0],0,0,0);
    o[d0]=__builtin_amdgcn_mfma_f32_32x32x16_bf16(pa3,PK(3),o[d0],0,0,0);
    #undef PK
  }
}

#ifndef ATTN_STORE16
#define ATTN_STORE16(p,v) (*(u32x4*)(p)=(v))
#endif
template<int THRL> __device__ __forceinline__ void attn_unit(int b,int h,int qb,const bf16*Q,const bf16*__restrict__ K,const bf16*__restrict__ V,bf16*O,const unsigned*SELM,char*shm){
  int tid_=threadIdx.x; asm volatile("":"+v"(tid_)); const int tid=tid_,lane=tid&63,r32=lane&31,hi=lane>>5; const int wid=__builtin_amdgcn_readfirstlane(tid>>6);
  const long rowbase=(long)b*SEQ; const int q0=qb*QB;
  const bf16*Qw=Q+(rowbase+q0+wid*QBLK)*DM+h*D;
  const bf16*Kh=K+rowbase*DM+h*D,*Vh=V+rowbase*DM+h*D;
  const unsigned lds0=(unsigned)(uintptr_t)shm;
  float*wsf=(float*)(shm+LDS_WS)+wid*64;
  const bf16*ksrc=Kh+(long)lane*DM+wid*8;
  const bf16*vsrc=Vh+(long)(16*(wid&3)+(lane>>2))*DM+(wid>>2)*32+(lane&3)*8;
  const unsigned kdst=lds0+LDS_K+wid*1024, vdst=lds0+LDS_V+wid*1024;
  #define DMA_K(t,slot) glds16(ksrc+(long)(t)*KVBLK*DM,(unsigned)__builtin_amdgcn_readfirstlane(kdst+(slot)))
  #define DMA_V(t,slot) glds16(vsrc+(long)(t)*KVBLK*DM,(unsigned)__builtin_amdgcn_readfirstlane(vdst+(slot)))
  const int vb0=(int)(lds0+LDS_V)+((lane>>4)&1)*32+(lane&3)*8+(4*hi+((lane&15)>>2))*64;
  const char*Kbase=shm+LDS_K; bf16x8 kf[8];
  const lds_cptr shm3=(lds_cptr)shm; const lds_cptr kp0=shm3+LDS_K+hi*1024+r32*16; const lds_cptr vp0=shm3+LDS_V+((lane>>4)&1)*32+(lane&3)*8+(4*hi+((lane&15)>>2))*64;
  const int NT=(q0+QB)/KVBLK;
  DMA_K(0,0);DMA_V(0,0);DMA_K(1,SLOTB);
  bf16x8 qr[4];
  #pragma unroll
  for(int d0=0;d0<4;++d0)qr[d0]=*reinterpret_cast<const bf16x8*>(&Qw[(long)r32*DM+d0*16+hi*8]);
  float mhat=0.f,l_reg=0.f;f32x16 o[2];o[0]=f32x16{};o[1]=f32x16{};f32x16 negm=f32x16{};asm volatile("":"+v"(negm));
  const int qrel=wid*QBLK+r32;
  const unsigned selm=SELM[(rowbase+q0+qrel)*NHEAD+h];
  #define CMASK(P0,P1,t) do{int jb_=(t)-(NT-4); if(jb_>=0)cmask(P0,P1,jb_,qrel,hi); else bmask(P0,P1,((selm>>((t)>>2))&1u)!=0u);}while(0)
  bool resc=false;
  #define START(P0,P1) do{ const float rm=rowmax(P0,P1); resc=false; \
    { const float dl=__builtin_fmaxf(rm,-60.f); mhat=fadd_s(mhat,dl); \
      _Pragma("unroll") for(int r=0;r<16;++r){P0[r]=fsub_s(P0[r],dl);P1[r]=fsub_s(P1[r],dl);} \
      _Pragma("unroll") for(int r=0;r<16;++r)negm[r]=-mhat; asm volatile("":"+v"(negm)); } \
    _Pragma("unroll") for(int r=0;r<16;++r)P0[r]=__builtin_amdgcn_exp2f(P0[r]); }while(0)
  #define RESC() do{ if(resc){ asm volatile("s_waitcnt lgkmcnt(0)":::"memory"); \
      _Pragma("unroll") for(int d_=0;d_<2;++d_) _Pragma("unroll") for(int r=0;r<16;++r)o[d_][r]*=wsf[crow(r,hi)]; } }while(0)
  f32x16 pA0,pA1,pB0,pB1;
  int sl_prev=0,sl_cur=0,sl_next=SLOTB;
  #define ROT() do{sl_prev=sl_cur;sl_cur=sl_next;sl_next=(sl_next==(NSLOT-1)*SLOTB)?0:sl_next+SLOTB;}while(0)
  DMA_K(2,2*SLOTB);
  WAIT_BAR(3);
  qkt(pA0,pA1,Kbase,qr,negm,r32,hi);asm volatile("s_nop 15\n\ts_nop 7":"+v"(pA0),"+v"(pA1));CMASK(pA0,pA1,0);
  START(pA0,pA1);
  _Pragma("unroll") for(int r=0;r<16;++r)pA1[r]=__builtin_amdgcn_exp2f(pA1[r]);
  WAIT_BAR(0);
  DMA_K(3,0);DMA_V(1,SLOTB);
  ROT();
  kload8(kf,kp0+sl_cur);
  WAIT_BAR(2);
  s16x4 vlo[8],vhi[8]; u32x4 pw0,pw1,pw2,pw3;
  #define PKW(P,B) cvtpk_s(P[B],P[B+1])
  #define PAF(k) __builtin_bit_cast(bf16x8,pw##k)
  #define VFR(i) (bf16x8){vlo[i][0],vlo[i][1],vlo[i][2],vlo[i][3],vhi[i][0],vhi[i][1],vhi[i][2],vhi[i][3]}
  #define PIN(x) asm volatile("":"+v"(x))
  #define MX3(a,b,c) __builtin_fmaxf(__builtin_fmaxf((a),(b)),(c))
  #define GAPA(MF,A0,A1,A2,A3,W0,W1,PW) do{ MF; sacc+=A0; sacc+=A1; sacc+=A2; sacc+=A3; PIN(sacc); W0; W1; PIN(PW); SBAR(); }while(0)
  #define EX(v) __builtin_amdgcn_exp2f(v)
  #define GAPB(MF,X,B) do{ MF; X[B]=EX(X[B]); X[B+1]=EX(X[B+1]); X[B+2]=EX(X[B+2]); X[B+3]=EX(X[B+3]); PIN(X); SBAR(); }while(0)
  #define VRD(i) do{ vlo[i]=vtr(vp_+(((i)>>2)*4096+((i)&3)*1024)); vhi[i]=vtr(vp_+(((i)>>2)*4096+((i)&3)*1024+512)); }while(0)
  #define KRD(G,j) do{ if(G){ kload2(kf,kp0+sl_next,j); SBAR(); } }while(0)
  #define STEP(C0,C1,P0,P1,t,GK,GV,GL) do{ SBAR(); \
    const lds_cptr vp_=vp0+sl_prev; \
    VRD(0); SBAR(); float sacc=(P0[0]+P0[1]); \
    GAPA(C0=__builtin_amdgcn_mfma_f32_32x32x16_bf16(kf[0],qr[0],negm,0,0,0), P0[2],P0[3],P0[4],P0[5],     pw0[0]=PKW(P0,0), pw0[1]=PKW(P0,2), pw0); \
    VRD(4); SBAR(); GAPA(C1=__builtin_amdgcn_mfma_f32_32x32x16_bf16(kf[1],qr[0],negm,0,0,0), P0[6],P0[7],P0[8],P0[9],     pw0[2]=PKW(P0,4), pw0[3]=PKW(P0,6), pw0); \
    VRD(1); SBAR(); GAPA(C0=__builtin_amdgcn_mfma_f32_32x32x16_bf16(kf[2],qr[1],C0,0,0,0),   P0[10],P0[11],P0[12],P0[13], pw1[0]=PKW(P0,8), pw1[1]=PKW(P0,10), pw1); \
    VRD(5); SBAR(); GAPA(C1=__builtin_amdgcn_mfma_f32_32x32x16_bf16(kf[3],qr[1],C1,0,0,0),   P0[14],P0[15],P1[0],P1[1],   pw1[2]=PKW(P0,12),pw1[3]=PKW(P0,14), pw1); \
    VRD(2); SBAR(); GAPA(C0=__builtin_amdgcn_mfma_f32_32x32x16_bf16(kf[4],qr[2],C0,0,0,0),   P1[2],P1[3],P1[4],P1[5],     pw2[0]=PKW(P1,0), pw2[1]=PKW(P1,2), pw2); \
    VRD(6); SBAR(); GAPA(C1=__builtin_amdgcn_mfma_f32_32x32x16_bf16(kf[5],qr[2],C1,0,0,0),   P1[6],P1[7],P1[8],P1[9],     pw2[2]=PKW(P1,4), pw2[3]=PKW(P1,6), pw2); \
    VRD(3); SBAR(); GAPA(C0=__builtin_amdgcn_mfma_f32_32x32x16_bf16(kf[6],qr[3],C0,0,0,0),   P1[10],P1[11],P1[12],P1[13], pw3[0]=PKW(P1,8), pw3[1]=PKW(P1,10), pw3); \
    VRD(7); SBAR(); GAPA(C1=__builtin_amdgcn_mfma_f32_32x32x16_bf16(kf[7],qr[3],C1,0,0,0),   P1[14],P1[15],0.f,0.f,       pw3[2]=PKW(P1,12),pw3[3]=PKW(P1,14), pw3); \
    l_reg+=sacc; \
    if(GK){DMA_K((t)+3,sl_cur);} if(GV){DMA_V((t)+1,sl_next);} \
    CMASK(C0,C1,t); \
    { float a=MX3(C0[0],C0[1],C1[0]),b=MX3(C0[2],C0[3],C1[1]); a=MX3(a,C1[2],C1[3]); \
      _Pragma("unroll") for(int r=4;r<16;r+=4){a=MX3(a,C0[r],C0[r+1]);b=MX3(b,C0[r+2],C0[r+3]);a=MX3(a,C1[r],C1[r+1]);b=MX3(b,C1[r+2],C1[r+3]);} \
      float rm=__builtin_fmaxf(a,b); { auto rr=__builtin_amdgcn_permlane32_swap(__float_as_uint(rm),__float_as_uint(rm),false,false); rm=__builtin_fmaxf(__uint_as_float(rr[0]),__uint_as_float(rr[1])); } \
      resc=false; \
      if(__builtin_expect(__any(rm>(float)THRL),0)){ const float dl=__builtin_fmaxf(rm,0.f); mhat+=dl; \
        _Pragma("unroll") for(int r=0;r<16;++r){C0[r]-=dl;C1[r]-=dl;} \
        _Pragma("unroll") for(int r=0;r<16;++r)negm[r]=-mhat; asm volatile("":"+v"(negm)); \
        const float f=__builtin_amdgcn_exp2f(-dl); l_reg*=f; if(hi==0)wsf[r32]=f; resc=true; } } \
    SBAR(); \
    GAPB(o[0]=__builtin_amdgcn_mfma_f32_32x32x16_bf16(PAF(0),VFR(0),o[0],0,0,0), C0,0); \
    GAPB(o[1]=__builtin_amdgcn_mfma_f32_32x32x16_bf16(PAF(0),VFR(4),o[1],0,0,0), C0,4); \
    KRD(GL,0); GAPB(o[0]=__builtin_amdgcn_mfma_f32_32x32x16_bf16(PAF(1),VFR(1),o[0],0,0,0), C0,8); \
    KRD(GL,1); GAPB(o[1]=__builtin_amdgcn_mfma_f32_32x32x16_bf16(PAF(1),VFR(5),o[1],0,0,0), C0,12); \
    KRD(GL,2); GAPB(o[0]=__builtin_amdgcn_mfma_f32_32x32x16_bf16(PAF(2),VFR(2),o[0],0,0,0), C1,0); \
    KRD(GL,3); GAPB(o[1]=__builtin_amdgcn_mfma_f32_32x32x16_bf16(PAF(2),VFR(6),o[1],0,0,0), C1,4); \
    GAPB(o[0]=__builtin_amdgcn_mfma_f32_32x32x16_bf16(PAF(3),VFR(3),o[0],0,0,0), C1,8); \
    GAPB(o[1]=__builtin_amdgcn_mfma_f32_32x32x16_bf16(PAF(3),VFR(7),o[1],0,0,0), C1,12); \
    }while(0)
  int t=1;
  #undef CMASK
  #define CMASK(P0,P1,t) do{ bmask(P0,P1,((selm>>((t)>>2))&1u)!=0u); }while(0)
  for(;t+5<NT;t+=2){
    STEP(pB0,pB1,pA0,pA1,t,true,true,true);     WAIT_BAR(2); RESC(); ROT();
    STEP(pA0,pA1,pB0,pB1,t+1,true,true,true);   WAIT_BAR(2); RESC(); ROT();
  }
  #undef CMASK
  #define CMASK(P0,P1,t) do{int jb_=(t)-(NT-4); if(jb_>=0)cmask(P0,P1,jb_,qrel,hi); else bmask(P0,P1,((selm>>((t)>>2))&1u)!=0u);}while(0)
  #define ENDW(tt) do{ if((tt)+3<NT){WAIT_BAR(2);} else if((tt)+2<NT){WAIT_BAR(1);} else {WAIT_BAR(0);} }while(0)
  for(;t+1<NT;t+=2){
    STEP(pB0,pB1,pA0,pA1,t,(t+3<NT),(t+1<NT),(t+1<NT));       ENDW(t);   RESC(); ROT();
    STEP(pA0,pA1,pB0,pB1,t+1,(t+4<NT),(t+2<NT),(t+2<NT));     ENDW(t+1); RESC(); ROT();
  }
  STEP(pB0,pB1,pA0,pA1,NT-1,false,false,false); RESC();
  { float sacc=pB0[0]+pB0[1]; _Pragma("unroll") for(int r=2;r<16;++r)sacc+=pB0[r]; _Pragma("unroll") for(int r=0;r<16;++r)sacc+=pB1[r]; l_reg+=sacc;
    pw0=(u32x4){PKW(pB0,0),PKW(pB0,2),PKW(pB0,4),PKW(pB0,6)};pw1=(u32x4){PKW(pB0,8),PKW(pB0,10),PKW(pB0,12),PKW(pB0,14)};pw2=(u32x4){PKW(pB1,0),PKW(pB1,2),PKW(pB1,4),PKW(pB1,6)};pw3=(u32x4){PKW(pB1,8),PKW(pB1,10),PKW(pB1,12),PKW(pB1,14)};
    SBAR(); pv(o,vb0+sl_cur,PAF(0),PAF(1),PAF(2),PAF(3)); }
  #undef PKW
  #undef PAF
  #undef VFR
  #undef PIN
  #undef MX3
  #undef GAPA
  #undef GAPB
  #undef EX
  #undef VRD
  #undef KRD
  #undef STEP
  #undef ENDW
  {auto rr=__builtin_amdgcn_permlane32_swap(__float_as_uint(l_reg),__float_as_uint(l_reg),false,false);l_reg=__uint_as_float(rr[0])+__uint_as_float(rr[1]);}
  if(hi==0)wsf[32+r32]=l_reg;asm volatile("s_waitcnt lgkmcnt(0)":::"memory");
  float rli[16];
  #pragma unroll
  for(int r=0;r<16;++r)rli[r]=__builtin_amdgcn_rcpf(wsf[32+crow(r,hi)]);
  bf16*Ow=O+(rowbase+q0+wid*QBLK)*OPITCH+h*D;
  { bf16*stg=(bf16*)(shm+LDS_OST)+wid*2048;
    #pragma unroll
    for(int r=0;r<16;++r){const int orow=crow(r,hi);
      #pragma unroll
      for(int d0=0;d0<2;++d0)stg[orow*64+d0*32+r32]=__float2bfloat16(o[d0][r]*rli[r]);}
    asm volatile("s_waitcnt lgkmcnt(0)":::"memory");
    #pragma unroll
    for(int i=0;i<4;++i){const int row=i*8+(lane>>3),ch=lane&7; const u32x4 v=*(const u32x4*)(stg+row*64+ch*8); ATTN_STORE16(Ow+(long)row*OPITCH+ch*8,v);} }
  asm volatile("s_waitcnt lgkmcnt(0)\n\ts_barrier":::"memory");
  #undef DMA_K
  #undef DMA_V
  #undef CMASK
  #undef START
  #undef RESC
  #undef ROT
}
constexpr int ATTN_LDS_BYTES=LDS_BYTES;
struct AttnTensors { const bf16* Q; const bf16* K; const bf16* V; bf16* O; const unsigned* SELM; };
struct AttnUnit { int bh; int qb; };
struct StaticOrder {
  int vcu, G;
  __device__ __forceinline__ explicit StaticOrder(int grid,int block):vcu((grid%8==0)?((block%8)*(grid/8)+block/8):block),G(grid){}
  __device__ __forceinline__ bool next(int i,AttnUnit&u)const{
    if(G==256){ if(i>=4)return false; const int s=vcu&7; u.bh=vcu>>3; u.qb=(i==0)?s:(i==1)?15-s:(i==2)?16+s:31-s; return true; }
    const int L=i*G+vcu; if(L>=BATCH*NHEAD*NQB)return false; u.bh=L/NQB; u.qb=NQB-1-(L%NQB); return true; }
  __device__ __forceinline__ void a_ready(const AttnUnit&)const{}
  __device__ __forceinline__ void done(const AttnUnit&)const{}
};
template<class Sched,int THRL=8> __device__ __forceinline__ void attn_phase(char*lds,const AttnTensors&T,const Sched&S){
  AttnUnit u;
  for(int i=0;S.next(i,u);++i){ S.a_ready(u); attn_unit<THRL>(u.bh/NHEAD,u.bh%NHEAD,u.qb,T.Q,T.K,T.V,T.O,T.SELM,lds); S.done(u); }
}
#undef SBAR
#undef WAIT_BAR
}

constexpr int NWAVES = 8, NTHR = 512;
constexpr int T_TOK = 65536, SEQ = 8192, NBATCH = 8, DM = 1024, DEPTH = 2;
constexpr int PMP = 1792;
constexpr int GLP = 3072;
constexpr int D_IN = 5120, NEXP = 64, NEXP1 = 65, TOPK = 6, DEXP = 256;
constexpr float EPS = 1e-6f;
constexpr int MAXROWS = 1600 * 256 + T_TOK;
constexpr size_t MiB = 1u << 20;
constexpr size_t WS_CTL = 0, CTL_ZERO_BYTES = 1 * MiB;
constexpr size_t WS_MOD = 1 * MiB;
constexpr size_t WS_KTAB = 2 * MiB;
constexpr size_t WS_A64 = 3 * MiB;
constexpr size_t WS_KMEAN = 4 * MiB;
constexpr size_t WS_WGU = 16 * MiB;
constexpr size_t WS_WD = 81 * MiB;
constexpr size_t WS_WR = WS_WD + (size_t)NEXP1 * 1024 * 256 * 2;
constexpr size_t WS_WIN = 114 * MiB;
constexpr size_t WS_WGLU = 124 * MiB;
constexpr size_t WS_WHO = 125 * MiB;
constexpr size_t WS_WMO = WS_WHO + 512 * 1024;
constexpr size_t WS_WOUT = 126 * MiB;
constexpr size_t WS_BT1 = 128 * MiB;
constexpr size_t WS_BT2 = 132 * MiB;
constexpr size_t WS_GL = 168 * MiB;
constexpr size_t WS_PM = 552 * MiB;
constexpr size_t WS_UG = 776 * MiB;
constexpr size_t WS_SLOC = 808 * MiB;
constexpr size_t WS_S0 = 816 * MiB;
constexpr size_t WS_HST = 820 * MiB;
constexpr size_t WS_HLAST = 884 * MiB;
constexpr size_t WS_SEL = 885 * MiB;
constexpr size_t WS_H = 896 * MiB;
constexpr size_t WS_YS5 = 904 * MiB;
constexpr size_t WS_OH = 936 * MiB;
constexpr size_t WS_OM = 968 * MiB;
constexpr size_t WS_MERGED = 776 * MiB;
constexpr size_t WS_H2 = 114 * MiB;
constexpr size_t WS_LOGITS = 242 * MiB;
constexpr size_t WS_TOPI = 258 * MiB;
constexpr size_t WS_TOPW = WS_TOPI + (size_t)T_TOK * 6 * 4;
constexpr size_t WS_POS = WS_TOPW + (size_t)T_TOK * 6 * 4;
constexpr size_t WS_ROWTOK = WS_POS + (size_t)T_TOK * 6 * 4;
constexpr size_t WS_ROWW = WS_ROWTOK + (size_t)MAXROWS * 4;
constexpr size_t WS_HID = 268 * MiB;
constexpr size_t WS_Y = 500 * MiB;
constexpr size_t WS_END = WS_Y + (size_t)MAXROWS * 1024;
static_assert(WS_ROWW + (size_t)MAXROWS * 4 <= WS_HID && WS_HID + (size_t)MAXROWS * 256 * 2 <= WS_Y && WS_END <= 1024 * MiB, "ws map");
static_assert(WS_WR + 256 * 1024 * 2 <= WS_WIN && WS_BT2 + (size_t)16 * 1024 * 1152 * 2 <= WS_GL, "ws map 2");
constexpr int CW_TMO = 0;
constexpr int CW_CNT = 1024;
constexpr int CW_CUR = 1280;
constexpr int CW_BAR = 4096;
constexpr int RING_OFF = 0, RING_BYTES = 131072;
constexpr int LDSCTL_OFF = RING_BYTES, MISC_OFF = LDSCTL_OFF + 1024;
constexpr int LDS_BYTES = 147456;

#define XB_TMO      128
#define XB_XCNT(j)  (256  + 64 * (j))
#define XB_XSUB(j)  (1280 + 64 * (j))
#define XB_XGEN(j)  (2304 + 64 * (j))
#define XB_TOP      3328
#define XB_TOPGEN   3392
#define XCD_BAR_WORDS 3456
#define XB_SPIN_CAP (1u << 18)

__device__ __forceinline__ unsigned xb_ld(unsigned* p)              { return __hip_atomic_load(p, __ATOMIC_RELAXED, __HIP_MEMORY_SCOPE_AGENT); }
__device__ __forceinline__ unsigned xb_add(unsigned* p, unsigned v) { return __hip_atomic_fetch_add(p, v, __ATOMIC_RELAXED, __HIP_MEMORY_SCOPE_AGENT); }
__device__ __forceinline__ unsigned xb_xcc_id() { return (unsigned)__builtin_amdgcn_s_getreg((3 << 11) | 20) & 0xFu; }
#define XB_SPIN(cond, bar) do { unsigned _sp = 0; while (cond) { __builtin_amdgcn_s_sleep(1); \
    if ((++_sp & 255u) == 0u) { if (xb_ld(&(bar)[XB_TMO])) break; if (_sp > XB_SPIN_CAP) { atomicAdd(&(bar)[XB_TMO], 1u); break; } } } } while (0)

struct XcdBarrier {
    unsigned* bar; unsigned x;
    volatile LAS unsigned* st;
};

__device__ __forceinline__ XcdBarrier xcd_barrier_post(unsigned* bar, volatile LAS unsigned* st) {
    XcdBarrier b; b.bar = bar; b.x = xb_xcc_id(); b.st = st;
    if (threadIdx.x == 0) (void)xb_add(&bar[XB_XCNT(b.x)], 1u);
    return b;
}
__device__ __forceinline__ void xcd_barrier_complete(unsigned* bar, unsigned x, unsigned& nloc, unsigned& nx) {
    const unsigned G = gridDim.x * gridDim.y * gridDim.z;
    unsigned sum, cnt, mine, sp = 0u;
    for (;;) {
        sum = 0u; cnt = 0u; mine = 0u;
#pragma unroll
        for (unsigned j = 0; j < 16; ++j) { const unsigned c = xb_ld(&bar[XB_XCNT(j)]); sum += c; cnt += (c > 0u) ? 1u : 0u; mine = (j == x) ? c : mine; }
        if (sum == G) break;
        __builtin_amdgcn_s_sleep(1);
        if ((++sp & 255u) == 0u) { if (xb_ld(&bar[XB_TMO])) break; if (sp > XB_SPIN_CAP) { atomicAdd(&bar[XB_TMO], 1u); break; } }
    }
    nloc = mine > 0u ? mine : 1u; nx = cnt > 0u ? cnt : 1u;
}

__device__ __forceinline__ void xcd_barrier(const XcdBarrier& b) {
    asm volatile("s_waitcnt vmcnt(0)" ::: "memory");
    __syncthreads();
    if (threadIdx.x == 0) {
        unsigned* bar = b.bar;
        __builtin_amdgcn_s_waitcnt(0);
        unsigned nloc = b.st[0], nx = b.st[1];
        if (nloc == 0u) { xcd_barrier_complete(bar, b.x, nloc, nx); b.st[0] = nloc; b.st[1] = nx; }
        const unsigned old = xb_add(&bar[XB_XSUB(b.x)], 1u);
        const unsigned gen = old / nloc;
        if (old + 1u == (gen + 1u) * nloc) {
            __builtin_amdgcn_fence(__ATOMIC_RELEASE, "agent");
            asm volatile("s_waitcnt vmcnt(0)" ::: "memory");
            const unsigned og = xb_add(&bar[XB_TOP], 1u);
            const unsigned tg = og / nx;
            if (og + 1u == (tg + 1u) * nx) xb_add(&bar[XB_TOPGEN], 1u);
            else XB_SPIN(xb_ld(&bar[XB_TOPGEN]) == tg, bar);
            __builtin_amdgcn_fence(__ATOMIC_ACQUIRE, "agent");
            xb_add(&bar[XB_XGEN(b.x)], 1u);
            asm volatile("s_waitcnt vmcnt(0)" ::: "memory");
        } else {
            XB_SPIN(xb_ld(&bar[XB_XGEN(b.x)]) == gen, bar);
            __builtin_amdgcn_fence(__ATOMIC_ACQUIRE, "agent");
            asm volatile("s_waitcnt vmcnt(0)" ::: "memory");
        }
    }
    __syncthreads();
}


struct Frame {
    LAS unsigned char* lds; unsigned char* ldsg;
    volatile LAS unsigned* MISC;
    gu32* ctl;
    unsigned char* ws;
    int tid, lane, wave, vcu, G;
    float* out;
};
constexpr int PTR_OFF = 131072 + 2048;
DI const float* inp(const Frame& F, int i) { const LAS unsigned* p = (const LAS unsigned*)(F.lds + PTR_OFF) + 2 * i; const unsigned lo = __builtin_amdgcn_readfirstlane(p[0]), hi = __builtin_amdgcn_readfirstlane(p[1]); return (const float*)(GAS const float*)(((unsigned long long)hi << 32) | lo); }
DI float wave_sum(float v) {
#pragma unroll
    for (int o = 1; o < 64; o <<= 1) v += __shfl_xor(v, o);
    return v;
}
#define WGBAR() do { asm volatile("s_waitcnt vmcnt(0) lgkmcnt(0)" ::: "memory"); __builtin_amdgcn_s_barrier(); asm volatile("" ::: "memory"); } while (0)

enum { I_X = 0, I_C, I_ADAW, I_ADAB, I_N1G, I_WIN, I_LOGDT, I_LRE, I_LIM, I_BRE, I_BIM, I_CRE, I_CIM, I_SSMD, I_WGLU, I_LBL, I_HNG, I_HWO, I_MQG, I_MKG, I_MWO, I_WOUT, I_N2G,
       I_RW, I_RB, I_EWG, I_EWU, I_EWD, I_SWG, I_SWU, I_SWD };

DI int rowmap(int mode, int n) {
    if (mode == 0) return n;
    if (mode == 1) return (n < 1024) ? ((n >> 7) * 256 + (n & 127)) : (((n - 1024) >> 7) * 256 + 128 + ((n - 1024) & 127));
    if (mode == 2) return (n >> 7) * 256 + (n & 127);
    return (n >> 7) * 256 + 128 + (n & 127);
}
DI void transpose_item(const float* W, int K, int N, bf16* WT, int ldk, int mode, LAS float* scr, int item, int lane) {
    const int nblk = N / 32, kb = item / nblk, nb = item % nblk, k0 = 64 * kb, n0 = 32 * nb;
#pragma unroll 8
    for (int i = 0; i < 32; ++i) { const int kk = 2 * i + (lane >> 5); scr[kk * 33 + (lane & 31)] = W[(size_t)(k0 + kk) * N + n0 + (lane & 31)]; }
    LDS_WAIT(); asm volatile("" ::: "memory");
    const int c = lane & 7;
#pragma unroll
    for (int j = 0; j < 4; ++j) { const int n = (lane >> 3) + 8 * j; const LAS float* s = scr + (8 * c) * 33 + n;
        u32x4 o; o.x = pk2(s[0 * 33], s[1 * 33]); o.y = pk2(s[2 * 33], s[3 * 33]); o.z = pk2(s[4 * 33], s[5 * 33]); o.w = pk2(s[6 * 33], s[7 * 33]);
        *(GAS u32x4*)(WT + (size_t)rowmap(mode, n0 + n) * ldk + k0 + 8 * c) = o; }
    LDS_WAIT(); asm volatile("" ::: "memory");
}
struct TJob { const float* src; size_t sstride; int nb, K, N; bf16* dst; size_t dstride; int ldk, mode; };
DI void p0_convert(Frame& F, int l) {
    LAS float* scr = (LAS float*)(F.lds + RING_OFF + F.wave * 16384);
    const int gw = F.vcu * NWAVES + F.wave, NGW = F.G * NWAVES;
    unsigned char* ws = F.ws;
    TJob jobs[12];
    jobs[0] = TJob{inp(F, I_WIN) + (size_t)l * 1024 * D_IN, 0, 1, 1024, D_IN, (bf16*)(ws + WS_WIN), 0, 1024, 0};
    jobs[1] = TJob{inp(F, I_WGLU) + (size_t)l * 256 * 2048, 0, 1, 256, 2048, (bf16*)(ws + WS_WGLU), 0, 256, 1};
    jobs[2] = TJob{inp(F, I_HWO) + (size_t)l * 256 * 1024, 0, 1, 256, 1024, (bf16*)(ws + WS_WHO), 0, 256, 0};
    jobs[3] = TJob{inp(F, I_MWO) + (size_t)l * 256 * 1024, 0, 1, 256, 1024, (bf16*)(ws + WS_WMO), 0, 256, 0};
    jobs[4] = TJob{inp(F, I_WOUT) + (size_t)l * 1024 * 1024, 0, 1, 1024, 1024, (bf16*)(ws + WS_WOUT), 0, 1024, 0};
    jobs[5] = TJob{inp(F, I_RW) + (size_t)l * 1024 * 64, 0, 1, 1024, 64, (bf16*)(ws + WS_WR), 0, 1024, 0};
    jobs[6] = TJob{inp(F, I_EWG) + (size_t)l * NEXP * 1024 * 256, (size_t)1024 * 256, NEXP, 1024, 256, (bf16*)(ws + WS_WGU), (size_t)512 * 1024, 1024, 2};
    jobs[7] = TJob{inp(F, I_EWU) + (size_t)l * NEXP * 1024 * 256, (size_t)1024 * 256, NEXP, 1024, 256, (bf16*)(ws + WS_WGU), (size_t)512 * 1024, 1024, 3};
    jobs[8] = TJob{inp(F, I_EWD) + (size_t)l * NEXP * 256 * 1024, (size_t)256 * 1024, NEXP, 256, 1024, (bf16*)(ws + WS_WD), (size_t)1024 * 256, 256, 0};
    jobs[9] = TJob{inp(F, I_SWG) + (size_t)l * 1024 * 256, 0, 1, 1024, 256, (bf16*)(ws + WS_WGU) + (size_t)NEXP * 512 * 1024, 0, 1024, 2};
    jobs[10] = TJob{inp(F, I_SWU) + (size_t)l * 1024 * 256, 0, 1, 1024, 256, (bf16*)(ws + WS_WGU) + (size_t)NEXP * 512 * 1024, 0, 1024, 3};
    jobs[11] = TJob{inp(F, I_SWD) + (size_t)l * 256 * 1024, 0, 1, 256, 1024, (bf16*)(ws + WS_WD) + (size_t)NEXP * 1024 * 256, 0, 256, 0};
    int base = 0;
#pragma unroll
    for (int j = 0; j < 12; ++j) {
        const TJob jb = jobs[j];
        const int per = (jb.K / 64) * (jb.N / 32), tot = per * jb.nb;
        int first = gw - (base % NGW); if (first < 0) first += NGW;
        for (int it = first; it < tot; it += NGW) { const int b = it / per, r = it % per;
            transpose_item(jb.src + (size_t)b * jb.sstride, jb.K, jb.N, jb.dst + (size_t)b * jb.dstride, jb.ldk, jb.mode, scr, r, F.lane); }
        base += tot;
    }
}

DI void p0_adaln(Frame& F) {
    LAS float* cond = (LAS float*)(F.lds + RING_OFF);
    LAS float* red = (LAS float*)(F.lds + RING_OFF + 32768);
    const float* c = inp(F, I_C);
    for (int i = F.tid; i < NBATCH * DM; i += NTHR) cond[i] = fsilu(c[i]);
    WGBAR();
    float* MOD = (float*)(F.ws + WS_MOD);
    const int col = F.tid & 63, kc = F.tid >> 6;
    for (int u = F.vcu; u < DEPTH * 96; u += F.G) {
        const int l = u / 96, n0 = (u % 96) * 64;
        const float* W = inp(F, I_ADAW) + (size_t)l * DM * 6144 + n0 + col;
        float a[8];
#pragma unroll
        for (int b = 0; b < 8; ++b) a[b] = 0.f;
        for (int k = kc * 128; k < kc * 128 + 128; ++k) { const float w = W[(size_t)k * 6144];
#pragma unroll
            for (int b = 0; b < 8; ++b) a[b] += w * cond[b * DM + k]; }
#pragma unroll
        for (int b = 0; b < 8; ++b) red[(kc * 8 + b) * 64 + col] = a[b];
        WGBAR();
        { const int b = F.tid >> 6; float s = 0.f;
#pragma unroll
          for (int q = 0; q < 8; ++q) s += red[(q * 8 + b) * 64 + col];
          MOD[((size_t)l * 8 + b) * 6144 + n0 + col] = s + inp(F, I_ADAB)[(size_t)l * 6144 + n0 + col]; }
        WGBAR();
    }
}

DI void cis(float ang, float& c, float& s) { s = sinf(ang); c = cosf(ang); }
DI void p0_s5tab(Frame& F, int l) {
    LAS float* L = (LAS float*)(F.lds + RING_OFF);
    LAS float* AJ = L;
    LAS float* AJ1 = L + 128;
    LAS float* A63 = L + 256;
    LAS float* COEF = L + 384;
    LAS float* BB = L + 512;
    LAS float* Z = L + 512 + 2048;
    float* KTAB = (float*)(F.ws + WS_KTAB); float* A64 = (float*)(F.ws + WS_A64);
    bf16* BT1 = (bf16*)(F.ws + WS_BT1); bf16* BT2 = (bf16*)(F.ws + WS_BT2);
    const float* cre = inp(F, I_CRE) + (size_t)l * 16 * 16 * 64; const float* cim = inp(F, I_CIM) + (size_t)l * 16 * 16 * 64;
    const float* bre = inp(F, I_BRE) + (size_t)l * 16 * 64 * 16; const float* bim = inp(F, I_BIM) + (size_t)l * 16 * 64 * 16;
    for (int u = F.vcu; u < 1024; u += F.G) {
        const int g = u >> 6, j = u & 63;
        if (F.tid < 64) { const int p = F.tid;
            const float dt = expf(inp(F, I_LOGDT)[l * 16 + g]); const float lr = inp(F, I_LRE)[(l * 16 + g) * 64 + p], li = inp(F, I_LIM)[(l * 16 + g) * 64 + p];
            float cr, sr; const float mag = expf(lr * dt); cis(li * dt, cr, sr); const float ar = mag * cr, ai = mag * sr;
            const float inv = 1.0f / (lr * lr + li * li);
            COEF[2 * p] = ((ar - 1.0f) * lr + ai * li) * inv; COEF[2 * p + 1] = (ai * lr - (ar - 1.0f) * li) * inv;
            float m, c2, s2;
            m = expf((float)j * lr * dt); cis((float)j * (li * dt), c2, s2); AJ[2 * p] = m * c2; AJ[2 * p + 1] = m * s2;
            m = expf((float)(j + 1) * lr * dt); cis((float)(j + 1) * (li * dt), c2, s2); AJ1[2 * p] = m * c2; AJ1[2 * p + 1] = m * s2;
            m = expf((float)(63 - j) * lr * dt); cis((float)(63 - j) * (li * dt), c2, s2); A63[2 * p] = m * c2; A63[2 * p + 1] = m * s2;
            if (j == 0) { m = expf(64.0f * lr * dt); cis(64.0f * (li * dt), c2, s2); A64[(g * 64 + p) * 2] = m * c2; A64[(g * 64 + p) * 2 + 1] = m * s2; }
        }
        WGBAR();
        for (int e = F.tid; e < 1024; e += NTHR) { const int p = e >> 4, h = e & 15;
            const float br = bre[(g * 64 + p) * 16 + h], bi = bim[(g * 64 + p) * 16 + h], cr = COEF[2 * p], ci = COEF[2 * p + 1];
            const float xr = cr * br - ci * bi, xi = cr * bi + ci * br; BB[2 * e] = xr; BB[2 * e + 1] = xi;
            const float ar = AJ[2 * p], ai = AJ[2 * p + 1]; Z[2 * e] = ar * xr - ai * xi; Z[2 * e + 1] = ar * xi + ai * xr; }
        WGBAR();
        if (F.tid < 256) { const int hp = F.tid >> 4, h = F.tid & 15; float s = 0.f;
            for (int p = 0; p < 64; ++p) s += cre[(g * 16 + hp) * 64 + p] * Z[2 * (p * 16 + h)] - cim[(g * 16 + hp) * 64 + p] * Z[2 * (p * 16 + h) + 1];
            KTAB[((g * 64 + j) * 16 + hp) * 16 + h] = s; }
        else { const int t2 = F.tid - 256;
            for (int e = t2; e < 2048; e += 256) { const int hp = e >> 7, q = e & 127, p = q & 63;
                const float c_r = cre[(g * 16 + hp) * 64 + p], c_i = cim[(g * 16 + hp) * 64 + p], ar = AJ1[2 * p], ai = AJ1[2 * p + 1];
                const float v = (q < 64) ? (c_r * ar - c_i * ai) : -(c_r * ai + c_i * ar);
                BT2[((size_t)(g * 1024 + j * 16 + hp)) * 1152 + 1024 + q] = (bf16)f2bf(v); } }
        for (int e = F.tid; e < 2048; e += NTHR) { const int q = e >> 4, h = e & 15, p = q & 63;
            const float ar = A63[2 * p], ai = A63[2 * p + 1], xr = BB[2 * (p * 16 + h)], xi = BB[2 * (p * 16 + h) + 1];
            const float v = (q < 64) ? (ar * xr - ai * xi) : (ar * xi + ai * xr);
            BT1[((size_t)(g * 128 + q)) * 1024 + j * 16 + h] = (bf16)f2bf(v); }
        WGBAR();
    }
}
DI void p1_s5fill(Frame& F) {
    const float* KTAB = (const float*)(F.ws + WS_KTAB); bf16* BT2 = (bf16*)(F.ws + WS_BT2);
    const size_t gt = (size_t)F.vcu * NTHR + F.tid, GT = (size_t)F.G * NTHR;
    for (size_t it = gt; it < (size_t)16 * 1024 * 128; it += GT) {
        const int kc = (int)(it & 127), n = (int)((it >> 7) & 1023), g = (int)(it >> 17);
        const int tau = n >> 4, hp = n & 15, sigma = kc >> 1, h0 = (kc & 1) * 8;
        if (sigma > (tau | 15)) continue;
        u32x4 o = (u32x4){0u, 0u, 0u, 0u};
        if (sigma <= tau) { const float* s = KTAB + ((g * 64 + (tau - sigma)) * 16 + hp) * 16 + h0;
            const f32x4 a = *(const f32x4*)s, b = *(const f32x4*)(s + 4); o.x = pk2(a.x, a.y); o.y = pk2(a.z, a.w); o.z = pk2(b.x, b.y); o.w = pk2(b.z, b.w); }
        *(u32x4*)(BT2 + ((size_t)(g * 1024 + n)) * 1152 + kc * 8) = o;
    }
}

DI void norm_rows(Frame& F, const float* X, const float* gain, const float* shift, const float* scale, bf16* O) {
    const int gw = F.vcu * NWAVES + F.wave, NGW = F.G * NWAVES;
    for (int m = gw; m < T_TOK; m += NGW) {
        const int b = m >> 13;
        const GAS f32x4* xr = (const GAS f32x4*)(X + (size_t)m * DM) + F.lane;
        f32x4 v[4]; float s2 = 0.f;
#pragma unroll
        for (int j = 0; j < 4; ++j) { v[j] = xr[64 * j]; s2 += (v[j].x * v[j].x + v[j].y * v[j].y) + (v[j].z * v[j].z + v[j].w * v[j].w); }
        const float rstd = 1.0f / sqrtf(wave_sum(s2) * (1.0f / DM) + EPS);
        GAS u32x2* o8 = (GAS u32x2*)(O + (size_t)m * DM) + F.lane;
#pragma unroll
        for (int j = 0; j < 4; ++j) { const int col = 4 * F.lane + 256 * j;
            const f32x4 g = *(const f32x4*)(gain + col), sh = *(const f32x4*)(shift + b * 6144 + col), sc = *(const f32x4*)(scale + b * 6144 + col);
            const f32x4 y = v[j] * rstd * g * (sc + 1.0f) + sh;
            u32x2 w; w.x = pk2(y.x, y.y); w.y = pk2(y.z, y.w); o8[64 * j] = w; }
    }
}

typedef const f32x4 (&AccRef)[2][2][4][2];
DI void plain_avoff(int lda, const int (&R)[2], const int (&C)[2], unsigned (&v)[2][2]) {
#pragma unroll
    for (int h = 0; h < 2; ++h)
#pragma unroll
        for (int i = 0; i < 2; ++i) v[h][i] = (unsigned)(((h * 128 + R[i]) * lda + C[i]) * 2);
}
DI void acc8(AccRef acc, int ai, int bj, int m, float (&v)[8]) {
    const f32x4 a = acc[ai][bj][m][0], b = acc[ai][bj][m][1]; v[0] = a.x; v[1] = a.y; v[2] = a.z; v[3] = a.w; v[4] = b.x; v[5] = b.y; v[6] = b.z; v[7] = b.w;
}
struct PlainBase {
    static constexpr bool SEG2 = false, GATHER = false;
    const char* A; const char* B; int lda, lda2, ldb, K; pg8::TileOrder ord;
    DI void setup(const void* A_, int lda_, const void* B_, int K_, int M, int N, int G, int c) { A = (const char*)A_; B = (const char*)B_; lda = lda_; lda2 = lda_; ldb = K_; K = K_; ord.init(M, N, G, c); }
    DI bool next(int i, pg8::GU& u) const { int pm, pn; if (!ord.next(i, pm, pn)) return false;
        u.pm = pm; u.pn = pn; u.e = 0; u.A = A + (size_t)pm * 256 * lda * 2; u.A2 = u.A; u.B = B + (size_t)pn * 256 * ldb * 2; u.nt1 = u.nt = K / 64; u.kstepA = 128; u.kstepA2 = 128; u.bjump = 0; u.lda = lda; u.lda2 = lda; return true; }
};
struct PolWin : PlainBase {
    static constexpr bool PERM = true;
    unsigned char* wsb;
    DI void epi(AccRef acc, const pg8::GU& u, int wr, int wc, int fr, int fq) const {
        int pitch; int coff[2]; const bool sig = u.pn >= 8;
#pragma unroll
        for (int bj = 0; bj < 2; ++bj) { const int c0 = bj * 128 + wc * 32 + fq * 8;
            coff[bj] = (u.pn == 0) ? ((c0 >> 4) * (T_TOK * 16) + (c0 & 15)) : (u.pn < 8) ? ((u.pn - 1) * 256 + c0) : ((u.pn - 8) * 256 + c0); }
        const size_t boff = (u.pn == 0) ? WS_UG : (u.pn < 8) ? WS_PM : WS_GL; pitch = (u.pn == 0) ? 16 : (u.pn < 8) ? PMP : GLP; bf16* base = (bf16*)(wsb + boff);
#pragma unroll
        for (int ai = 0; ai < 2; ++ai)
#pragma unroll
            for (int m = 0; m < 4; ++m) { const size_t t = (size_t)(u.pm * 256 + ai * 128 + wr * 64 + m * 16 + fr);
#pragma unroll
                for (int bj = 0; bj < 2; ++bj) { float v[8]; acc8(acc, ai, bj, m, v);
                    if (sig) {
#pragma unroll
                        for (int j = 0; j < 8; ++j) v[j] = fsigmoid(v[j]); }
                    *(u32x4*)(base + t * pitch + coff[bj]) = pack8(v); }
                asm volatile("" ::: "memory"); __builtin_amdgcn_sched_barrier(0); }
    }
};
struct PolS5a {
    static constexpr bool PERM = false, SEG2 = false, GATHER = false;
    const char* UG; const char* BT1; float* SLOC; int ldb, G, c; static constexpr int lda = 1024, lda2 = 1024;
    DI bool next(int i, pg8::GU& u) const { const int L = i * G + c; if (L >= 64) return false; u.pm = L & 3; u.e = L >> 2; u.pn = 0;
        u.A = UG + ((size_t)u.e * T_TOK * 16 + (size_t)u.pm * 256 * 1024) * 2; u.A2 = u.A; u.B = BT1 + (size_t)u.e * 128 * 1024 * 2; u.nt1 = u.nt = 16; u.kstepA = 128; u.kstepA2 = 128; u.bjump = 0; u.lda = 1024; u.lda2 = 1024; return true; }
    DI void epi(AccRef acc, const pg8::GU& u, int wr, int wc, int fr, int fq) const {
#pragma unroll
        for (int ai = 0; ai < 2; ++ai)
#pragma unroll
            for (int m = 0; m < 4; ++m) { const int row = u.pm * 256 + ai * 128 + wr * 64 + m * 16 + fr;
#pragma unroll
                for (int n = 0; n < 2; ++n) *(f32x4*)(SLOC + ((size_t)row * 16 + u.e) * 128 + wc * 32 + n * 16 + fq * 4) = acc[ai][0][m][n]; }
    }
};
struct PolS5b {
    static constexpr bool PERM = true, SEG2 = true, GATHER = false;
    const char* UG; const char* S0; const char* BT2; const float* Dsk; bf16* YS5; int ldb, G, c; static constexpr int lda = 1024, lda2 = 2048;
    DI bool next(int i, pg8::GU& u) const { const int L = i * G + c; if (L >= 256) return false; u.e = L >> 4; u.pm = (L >> 2) & 3; u.pn = 3 - (L & 3);
        u.A = UG + ((size_t)u.e * T_TOK * 16 + (size_t)u.pm * 256 * 1024) * 2; u.A2 = S0 + ((size_t)u.pm * 256 * 2048 + (size_t)u.e * 128) * 2;
        u.B = BT2 + ((size_t)u.e * 1024 + (size_t)u.pn * 256) * 1152 * 2; u.nt1 = 4 * (u.pn + 1); u.nt = u.nt1 + 2; u.kstepA = 128; u.kstepA2 = 128; u.bjump = (1024 - u.nt1 * 64) * 2; u.lda = 1024; u.lda2 = 2048; return true; }
    DI void epi(AccRef acc, const pg8::GU& u, int wr, int wc, int fr, int fq) const {
        const bf16* Ug = (const bf16*)UG + (size_t)u.e * T_TOK * 16;
#pragma unroll
        for (int ai = 0; ai < 2; ++ai)
#pragma unroll
            for (int m = 0; m < 4; ++m) { const int row = u.pm * 256 + ai * 128 + wr * 64 + m * 16 + fr;
#pragma unroll
                for (int bj = 0; bj < 2; ++bj) { const int cc = u.pn * 256 + bj * 128 + wc * 32 + fq * 8, tau = cc >> 4, h0 = cc & 15; const size_t t = (size_t)row * 64 + tau;
                    float v[8], uu[8]; acc8(acc, ai, bj, m, v); unpack8(*(const u32x4*)(Ug + t * 16 + h0), uu);
                    const f32x4 d0 = *(const f32x4*)(Dsk + u.e * 16 + h0), d1 = *(const f32x4*)(Dsk + u.e * 16 + h0 + 4);
                    const float dd[8] = {d0.x, d0.y, d0.z, d0.w, d1.x, d1.y, d1.z, d1.w};
#pragma unroll
                    for (int j = 0; j < 8; ++j) v[j] = gelu_tanh(v[j] + dd[j] * uu[j]);
                    *(u32x4*)(YS5 + t * 256 + u.e * 16 + h0) = pack8(v); }
                { asm volatile("" ::: "memory"); __builtin_amdgcn_sched_barrier(0); } }
    }
};
struct PolGlu : PlainBase {
    static constexpr bool PERM = true;
    const bf16* GL; bf16* MERGED;
    DI void epi(AccRef acc, const pg8::GU& u, int wr, int wc, int fr, int fq) const {
#pragma unroll
        for (int ai = 0; ai < 2; ++ai)
#pragma unroll
            for (int m = 0; m < 4; ++m) { const size_t t = (size_t)(u.pm * 256 + ai * 128 + wr * 64 + m * 16 + fr); const int n0 = u.pn * 128 + wc * 32 + fq * 8;
                float z1[8], z2[8], g[8]; acc8(acc, ai, 0, m, z1); acc8(acc, ai, 1, m, z2); unpack8(*(const u32x4*)(GL + t * GLP + n0), g);
#pragma unroll
                for (int j = 0; j < 8; ++j) z1[j] = g[j] * z1[j] * fsigmoid(z2[j]);
                *(u32x4*)(MERGED + t * DM + n0) = pack8(z1); { asm volatile("" ::: "memory"); __builtin_amdgcn_sched_barrier(0); } }
    }
};
struct PolRmw {
    static constexpr bool PERM = true, SEG2 = false, GATHER = false;
    const char* A1; const char* A2; const char* B1; const char* B2; const bf16* GL; bf16* MERGED; int ldb; pg8::TileOrder ord; int nper;
    static constexpr int lda = 256, lda2 = 256;
    DI bool next(int i, pg8::GU& u) const { if (i >= 2 * nper) return false; const int br = (i >= nper) ? 1 : 0; int pm, pn; if (!ord.next(i - br * nper, pm, pn)) return false;
        u.pm = pm; u.pn = pn; u.e = br; u.A = A1 + (size_t)br * (size_t)(A2 - A1) + (size_t)pm * 256 * 256 * 2; u.A2 = u.A; u.B = B1 + (size_t)br * (size_t)(B2 - B1) + (size_t)pn * 256 * 256 * 2;
        u.nt = 4; u.nt1 = 4; u.kstepA = 128; u.kstepA2 = 128; u.bjump = 0; u.lda = 256; u.lda2 = 256; return true; }
    DI void epi(AccRef acc, const pg8::GU& u, int wr, int wc, int fr, int fq) const {
        const int gcol = (u.e + 1) * 1024;
#pragma unroll
        for (int ai = 0; ai < 2; ++ai)
#pragma unroll
            for (int m = 0; m < 4; ++m) { const size_t t = (size_t)(u.pm * 256 + ai * 128 + wr * 64 + m * 16 + fr);
#pragma unroll
                for (int bj = 0; bj < 2; ++bj) { const int n0 = u.pn * 256 + bj * 128 + wc * 32 + fq * 8;
                    float v[8], g[8], o[8]; acc8(acc, ai, bj, m, v); unpack8(*(const u32x4*)(GL + t * GLP + gcol + n0), g); unpack8(*(const u32x4*)(MERGED + t * DM + n0), o);
#pragma unroll
                    for (int j = 0; j < 8; ++j) o[j] += g[j] * v[j];
                    *(u32x4*)(MERGED + t * DM + n0) = pack8(o); }
                { asm volatile("" ::: "memory"); __builtin_amdgcn_sched_barrier(0); } }
    }
};
struct PolWout : PlainBase {
    static constexpr bool PERM = false;
    const float* Xin; float* X; const float* gate;
    DI void epi(AccRef acc, const pg8::GU& u, int wr, int wc, int fr, int fq) const {
        const int b = u.pm >> 5;
#pragma unroll
        for (int ai = 0; ai < 2; ++ai)
#pragma unroll
            for (int m = 0; m < 4; ++m) { const size_t t = (size_t)(u.pm * 256 + ai * 128 + wr * 64 + m * 16 + fr);
#pragma unroll
                for (int bj = 0; bj < 2; ++bj)
#pragma unroll
                    for (int n = 0; n < 2; ++n) { const int n0 = u.pn * 256 + bj * 128 + wc * 32 + n * 16 + fq * 4;
                        const f32x4 g = *(const f32x4*)(gate + b * 6144 + n0), x = *(const f32x4*)(Xin + t * DM + n0);
                        *(f32x4*)(X + t * DM + n0) = x + g * acc[ai][bj][m][n]; }
                { asm volatile("" ::: "memory"); __builtin_amdgcn_sched_barrier(0); } }
    }
};
struct PolRouter : PlainBase {
    static constexpr bool PERM = false;
    float* LOG;
    DI void epi(AccRef acc, const pg8::GU& u, int wr, int wc, int fr, int fq) const {
        if (wc < 2) {
#pragma unroll
            for (int ai = 0; ai < 2; ++ai)
#pragma unroll
                for (int m = 0; m < 4; ++m) { const size_t t = (size_t)(u.pm * 256 + ai * 128 + wr * 64 + m * 16 + fr);
#pragma unroll
                    for (int n = 0; n < 2; ++n) *(f32x4*)(LOG + t * 64 + wc * 32 + n * 16 + fq * 4) = acc[ai][0][m][n]; } }
    }
};
struct GroupSched {
    const LAS int* blkpfx; int nNt, G, c;
    DI bool pick(int i, int& rb, int& pn, int& e) const { const int total = blkpfx[NEXP1] * nNt; const int L = i * G + c; if (L >= total) return false;
        rb = L / nNt; pn = L % nNt; int ee = 0; while (rb >= blkpfx[ee + 1]) ++ee; e = __builtin_amdgcn_readfirstlane(ee); rb = __builtin_amdgcn_readfirstlane(rb); pn = __builtin_amdgcn_readfirstlane(pn); return true; }
};
struct PolGateUp {
    static constexpr bool PERM = true, SEG2 = false, GATHER = true;
    GroupSched gs; const char* H2; const char* WGU; const int* ROWTOK; const float* ROWW; bf16* HID; int ldb; static constexpr int lda = 1024, lda2 = 1024;
    DI bool next(int i, pg8::GU& u) const { int rb, pn, e; if (!gs.pick(i, rb, pn, e)) return false; u.pm = rb; u.pn = pn; u.e = e;
        u.A = H2; u.A2 = H2; u.B = WGU + ((size_t)e * 512 + (size_t)pn * 256) * 1024 * 2; u.nt1 = u.nt = 16; u.kstepA = 128; u.kstepA2 = 128; u.bjump = 0; u.lda = 1024; u.lda2 = 1024; return true; }
    DI void avoff(const pg8::GU& u, const int (&R)[2], const int (&C)[2], unsigned (&v)[2][2]) const {
#pragma unroll
        for (int h = 0; h < 2; ++h)
#pragma unroll
            for (int i = 0; i < 2; ++i) { const int tok = ROWTOK[(size_t)u.pm * 256 + h * 128 + R[i]]; v[h][i] = (unsigned)((tok * 1024 + C[i]) * 2); }
    }
    DI void epi(AccRef acc, const pg8::GU& u, int wr, int wc, int fr, int fq) const {
#pragma unroll
        for (int ai = 0; ai < 2; ++ai)
#pragma unroll
            for (int m = 0; m < 4; ++m) { const size_t row = (size_t)u.pm * 256 + ai * 128 + wr * 64 + m * 16 + fr; const float w = ROWW[row];
                float z1[8], z2[8]; acc8(acc, ai, 0, m, z1); acc8(acc, ai, 1, m, z2);
#pragma unroll
                for (int j = 0; j < 8; ++j) z1[j] = w * fsilu(z1[j]) * z2[j];
                *(u32x4*)(HID + row * 256 + u.pn * 128 + wc * 32 + fq * 8) = pack8(z1); }
    }
};
constexpr float Y8_SCALE = 16.0f;
struct PolDown {
    static constexpr bool PERM = true, SEG2 = false, GATHER = false;
    GroupSched gs; const char* HIDp; const char* WD; unsigned char* Y8; int ldb; static constexpr int lda = 256, lda2 = 256;
    DI bool next(int i, pg8::GU& u) const { int rb, pn, e; if (!gs.pick(i, rb, pn, e)) return false; u.pm = rb; u.pn = pn; u.e = e;
        u.A = HIDp + (size_t)rb * 256 * 256 * 2; u.A2 = u.A; u.B = WD + ((size_t)e * 1024 + (size_t)pn * 256) * 256 * 2; u.nt1 = u.nt = 4; u.kstepA = 128; u.kstepA2 = 128; u.bjump = 0; u.lda = 256; u.lda2 = 256; return true; }
    DI void epi(AccRef acc, const pg8::GU& u, int wr, int wc, int fr, int fq) const {
#pragma unroll
        for (int ai = 0; ai < 2; ++ai)
#pragma unroll
            for (int m = 0; m < 4; ++m) { const size_t row = (size_t)u.pm * 256 + ai * 128 + wr * 64 + m * 16 + fr;
#pragma unroll
                for (int bj = 0; bj < 2; ++bj) { float v[8]; acc8(acc, ai, bj, m, v);
                    int w0 = 0, w1 = 0;
                    w0 = __builtin_amdgcn_cvt_pk_fp8_f32(v[0] * Y8_SCALE, v[1] * Y8_SCALE, w0, false); w0 = __builtin_amdgcn_cvt_pk_fp8_f32(v[2] * Y8_SCALE, v[3] * Y8_SCALE, w0, true);
                    w1 = __builtin_amdgcn_cvt_pk_fp8_f32(v[4] * Y8_SCALE, v[5] * Y8_SCALE, w1, false); w1 = __builtin_amdgcn_cvt_pk_fp8_f32(v[6] * Y8_SCALE, v[7] * Y8_SCALE, w1, true);
                    *(u32x2*)(Y8 + row * 1024 + u.pn * 256 + bj * 128 + wc * 32 + fq * 8) = (u32x2){(unsigned)w0, (unsigned)w1}; } }
    }
};

DI void s5_carry_unit(Frame& F, int u) {
    const int b = u >> 4, g = u & 15, p = F.tid & 63, cg = F.tid >> 6;
    const float* SLOC = (const float*)(F.ws + WS_SLOC); bf16* S0 = (bf16*)(F.ws + WS_S0); const float* A64 = (const float*)(F.ws + WS_A64);
    LAS float* R15 = (LAS float*)(F.lds + RING_OFF);
    const float Ar = A64[(g * 64 + p) * 2], Ai = A64[(g * 64 + p) * 2 + 1];
    float xr[16], xi[16];
#pragma unroll
    for (int k = 0; k < 16; ++k) { const size_t base = ((size_t)(b * 128 + cg * 16 + k) * 16 + g) * 128; xr[k] = SLOC[base + p]; xi[k] = SLOC[base + 64 + p]; }
    float rr = 0.f, ri = 0.f;
#pragma unroll
    for (int k = 0; k < 16; ++k) { const float nr = Ar * rr - Ai * ri + xr[k], ni = Ar * ri + Ai * rr + xi[k]; rr = nr; ri = ni; xr[k] = rr; xi[k] = ri; }
    R15[(cg * 64 + p) * 2] = rr; R15[(cg * 64 + p) * 2 + 1] = ri;
    float A16r = Ar, A16i = Ai;
#pragma unroll
    for (int q = 0; q < 4; ++q) { const float nr = A16r * A16r - A16i * A16i, ni = 2.f * A16r * A16i; A16r = nr; A16i = ni; }
    WGBAR();
    float Gr = 0.f, Gi = 0.f;
    for (int q = 0; q < cg; ++q) { const float tr = R15[(q * 64 + p) * 2], ti = R15[(q * 64 + p) * 2 + 1]; const float nr = A16r * Gr - A16i * Gi + tr, ni = A16r * Gi + A16i * Gr + ti; Gr = nr; Gi = ni; }
    float pr = 1.f, pi = 0.f;
#pragma unroll
    for (int k = 0; k < 16; ++k) {
        float sr = pr * Gr - pi * Gi, si = pr * Gi + pi * Gr;
        if (k > 0) { sr += xr[k - 1]; si += xi[k - 1]; }
        const size_t base = ((size_t)(b * 128 + cg * 16 + k) * 16 + g) * 128;
        S0[base + p] = (bf16)f2bf(sr); S0[base + 64 + p] = (bf16)f2bf(si);
        const float nr = pr * Ar - pi * Ai, ni = pr * Ai + pi * Ar; pr = nr; pi = ni;
    }
    WGBAR();
}

constexpr int HG_FT = 0, HG_CUM = 8192, HG_SEG = 25600, HG_QT = 27648, HG_QE = 36864, HG_KT = 46080, HG_INT = 69120, HG_ST = 78336, HG_PS = 87552, HG_OUT = 105984;
constexpr int HP = 72;
constexpr int CP = 68;
DI float hg_lb(Frame& F, int l, int col) { if (l == 0) return 0.f; const float x0 = inp(F, I_LBL)[col], x1 = inp(F, I_LBL)[256 + col]; return 1.0f / (1.0f + expf(x0 - x1)); }
DI void hg_stepA(Frame& F, const bf16* PM, int tok0, int head, float lbk, float (&fv)[8], float (&cum)[8], float& last) {
    LAS bf16* FT = (LAS bf16*)(F.lds + HG_FT); LAS float* CUM = (LAS float*)(F.lds + HG_CUM); LAS float* SEG = (LAS float*)(F.lds + HG_SEG);
    { const int t = F.tid >> 3, kc = F.tid & 7; *(LAS u32x4*)(FT + t * 64 + kc * 8) = *(const u32x4*)(PM + (size_t)(tok0 + t) * PMP + 256 + head * 64 + kc * 8); }
    WGBAR();
    const int k = F.tid & 63, seg = F.tid >> 6; float run = 0.f;
#pragma unroll
    for (int j = 0; j < 8; ++j) { const float fr = bf2f(FT[(seg * 8 + j) * 64 + k]); const float f = lbk + (1.0f - lbk) * fsigmoid(fr); fv[j] = f; run += __logf(f); cum[j] = run; }
    SEG[seg * 64 + k] = run;
    WGBAR();
    float off = 0.f, tot = 0.f;
#pragma unroll
    for (int s = 0; s < 8; ++s) { const float v = SEG[s * 64 + k]; tot += v; if (s < seg) off += v; }
    last = tot;
#pragma unroll
    for (int j = 0; j < 8; ++j) { cum[j] += off; CUM[(seg * 8 + j) * CP + k] = cum[j]; }
}
DI void hg_load_inpT(Frame& F, const bf16* PM, int tok0, int head) {
    LAS bf16* INT = (LAS bf16*)(F.lds + HG_INT);
    const int s = F.tid >> 3, vc = F.tid & 7; const u32x4 w = *(const u32x4*)(PM + (size_t)(tok0 + s) * PMP + 512 + head * 64 + vc * 8);
    const unsigned ww[4] = {w.x, w.y, w.z, w.w};
#pragma unroll
    for (int j = 0; j < 4; ++j) { INT[(vc * 8 + 2 * j) * HP + s] = (bf16)(ww[j] & 0xffffu); INT[(vc * 8 + 2 * j + 1) * HP + s] = (bf16)(ww[j] >> 16); }
}
DI void hgrn_h1_unit(Frame& F, int l, int u) {
    const bf16* PM = (const bf16*)(F.ws + WS_PM); float* HST = (float*)(F.ws + WS_HST); float* HLAST = (float*)(F.ws + WS_HLAST);
    const int bh = u >> 7, c = u & 127, b = bh >> 2, head = bh & 3, tok0 = b * SEQ + c * 64;
    const int k = F.tid & 63, seg = F.tid >> 6;
    const float lbk = hg_lb(F, l, head * 64 + k);
    float fv[8], cum[8], last;
    hg_stepA(F, PM, tok0, head, lbk, fv, cum, last);
    LAS bf16* KST = (LAS bf16*)(F.lds + HG_QT);
    { float ks[8];
#pragma unroll
      for (int j = 0; j < 8; ++j) ks[j] = (1.0f - fv[j]) * fexp(last - cum[j]);
      *(LAS u32x4*)(KST + k * HP + seg * 8) = pack8(ks); }
    if (seg == 0) HLAST[(size_t)u * 64 + k] = last;
    hg_load_inpT(F, PM, tok0, head);
    WGBAR();
    { const int w = F.wave, kt = w >> 1, vts = (w & 1) * 2, row = F.lane & 15, quad = F.lane >> 4;
      const LAS bf16* INT = (const LAS bf16*)(F.lds + HG_INT);
#pragma unroll
      for (int vt = 0; vt < 2; ++vt) { f32x4 acc = (f32x4){0.f, 0.f, 0.f, 0.f};
#pragma unroll
          for (int ks = 0; ks < 2; ++ks) { const bf16x8 a = *(const LAS bf16x8*)(KST + (kt * 16 + row) * HP + ks * 32 + quad * 8), bb = *(const LAS bf16x8*)(INT + ((vts + vt) * 16 + row) * HP + ks * 32 + quad * 8);
              acc = __builtin_amdgcn_mfma_f32_16x16x32_bf16(a, bb, acc, 0, 0, 0); }
#pragma unroll
          for (int j = 0; j < 4; ++j) HST[(size_t)u * 4096 + (kt * 16 + quad * 4 + j) * 64 + (vts + vt) * 16 + row] = acc[j]; } }
    WGBAR();
}
DI void hgrn_carry_unit(Frame& F, int u) {
    float* HST = (float*)(F.ws + WS_HST); const float* HLAST = (const float*)(F.ws + WS_HLAST);
    const int bh = u >> 3, v = F.tid & 63, k = (F.tid >> 6) + 8 * (u & 7);
    float s = 0.f;
    for (int c0 = 0; c0 < 128; c0 += 8) {
        float d[8], dec[8];
#pragma unroll
        for (int j = 0; j < 8; ++j) { const size_t uu = (size_t)bh * 128 + c0 + j; d[j] = HST[uu * 4096 + k * 64 + v]; dec[j] = HLAST[uu * 64 + k]; }
#pragma unroll
        for (int j = 0; j < 8; ++j) { const size_t uu = (size_t)bh * 128 + c0 + j; HST[uu * 4096 + k * 64 + v] = s; s = fexp(dec[j]) * s + d[j]; }
    }
}
DI void hgrn_h3_unit(Frame& F, int l, int u) {
    const bf16* PM = (const bf16*)(F.ws + WS_PM); const float* HST = (const float*)(F.ws + WS_HST); bf16* OH = (bf16*)(F.ws + WS_OH);
    const int bh = u >> 7, c = u & 127, b = bh >> 2, head = bh & 3, tok0 = b * SEQ + c * 64;
    { const int k = F.tid & 63; const float lbk = hg_lb(F, l, head * 64 + k); float fv[8], cum[8], last; hg_stepA(F, PM, tok0, head, lbk, fv, cum, last); }
    hg_load_inpT(F, PM, tok0, head);
    { LAS bf16* ST = (LAS bf16*)(F.lds + HG_ST); const int k = F.tid >> 3, vc = F.tid & 7; const float* sp = HST + (size_t)u * 4096 + k * 64 + vc * 8;
      const f32x4 a = *(const f32x4*)sp, bb = *(const f32x4*)(sp + 4); const float sv[8] = {a.x, a.y, a.z, a.w, bb.x, bb.y, bb.z, bb.w};
#pragma unroll
      for (int j = 0; j < 8; ++j) ST[(vc * 8 + j) * HP + k] = (bf16)f2bf(sv[j]); }
    WGBAR();
    {
      const LAS bf16* FT = (const LAS bf16*)(F.lds + HG_FT); const LAS float* CUM = (const LAS float*)(F.lds + HG_CUM);
      LAS bf16* QT = (LAS bf16*)(F.lds + HG_QT); LAS bf16* QE = (LAS bf16*)(F.lds + HG_QE); LAS bf16* KT = (LAS bf16*)(F.lds + HG_KT);
      const int t = F.tid >> 3, kc = F.tid & 7, ib = t >> 4;
      float q[8], fr[8], cm[8], rf[8], o1[8], o2[8];
      unpack8(*(const u32x4*)(PM + (size_t)(tok0 + t) * PMP + head * 64 + kc * 8), q);
      unpack8(*(const LAS u32x4*)(FT + t * 64 + kc * 8), fr);
#pragma unroll
      for (int j = 0; j < 8; ++j) { cm[j] = CUM[t * CP + kc * 8 + j]; rf[j] = (ib > 0) ? CUM[(16 * ib - 1) * CP + kc * 8 + j] : 0.f; const float lbk = hg_lb(F, l, head * 64 + kc * 8 + j); fr[j] = 1.0f - (lbk + (1.0f - lbk) * fsigmoid(fr[j])); }
#pragma unroll
      for (int j = 0; j < 8; ++j) { o1[j] = q[j] * fexp(cm[j] - rf[j]); o2[j] = q[j] * fexp(cm[j]); }
      *(LAS u32x4*)(QT + t * HP + kc * 8) = pack8(o1); *(LAS u32x4*)(QE + t * HP + kc * 8) = pack8(o2);
      for (int i2 = ib; i2 < 4; ++i2) { const int rowoff = (i2 == 0) ? 0 : (i2 == 1) ? 16 : (i2 == 2) ? 48 : 96;
#pragma unroll
          for (int j = 0; j < 8; ++j) { const float r2 = (i2 > 0) ? CUM[(16 * i2 - 1) * CP + kc * 8 + j] : 0.f; o1[j] = fr[j] * fexp(fminf(r2 - cm[j], 80.f)); }
          *(LAS u32x4*)(KT + (rowoff + t) * HP + kc * 8) = pack8(o1); }
    }
    WGBAR();
    { const int w = F.wave, ib = w >> 1, vh = w & 1, row = F.lane & 15, quad = F.lane >> 4;
      const LAS bf16* QT = (const LAS bf16*)(F.lds + HG_QT); const LAS bf16* QE = (const LAS bf16*)(F.lds + HG_QE); const LAS bf16* KT = (const LAS bf16*)(F.lds + HG_KT);
      const LAS bf16* INT = (const LAS bf16*)(F.lds + HG_INT); const LAS bf16* ST = (const LAS bf16*)(F.lds + HG_ST);
      LAS bf16* PS = (LAS bf16*)(F.lds + HG_PS) + w * 16 * HP; LAS float* OUT = (LAS float*)(F.lds + HG_OUT);
      const int rowoff = (ib == 0) ? 0 : (ib == 1) ? 16 : (ib == 2) ? 48 : 96;
      const bf16x8 qa0 = *(const LAS bf16x8*)(QT + (16 * ib + row) * HP + quad * 8), qa1 = *(const LAS bf16x8*)(QT + (16 * ib + row) * HP + 32 + quad * 8);
      for (int st = 0; st < 4; ++st) {
          f32x4 acc = (f32x4){0.f, 0.f, 0.f, 0.f};
          if (st <= ib) { const bf16x8 b0 = *(const LAS bf16x8*)(KT + (rowoff + st * 16 + row) * HP + quad * 8), b1 = *(const LAS bf16x8*)(KT + (rowoff + st * 16 + row) * HP + 32 + quad * 8);
              acc = __builtin_amdgcn_mfma_f32_16x16x32_bf16(qa0, b0, acc, 0, 0, 0); acc = __builtin_amdgcn_mfma_f32_16x16x32_bf16(qa1, b1, acc, 0, 0, 0);
              if (st == ib) {
#pragma unroll
                  for (int j = 0; j < 4; ++j) if (row > quad * 4 + j) acc[j] = 0.f; } }
#pragma unroll
          for (int j = 0; j < 4; ++j) PS[(quad * 4 + j) * HP + st * 16 + row] = (bf16)f2bf(acc[j]);
      }
      LDS_WAIT(); asm volatile("" ::: "memory");
      const int nks = (ib >> 1) + 1;
#pragma unroll
      for (int vt = 0; vt < 2; ++vt) { f32x4 acc = (f32x4){0.f, 0.f, 0.f, 0.f}; const int vrow = (vh * 2 + vt) * 16 + row;
          for (int ks = 0; ks < nks; ++ks) { const bf16x8 a = *(const LAS bf16x8*)(PS + row * HP + ks * 32 + quad * 8), bb = *(const LAS bf16x8*)(INT + vrow * HP + ks * 32 + quad * 8);
              acc = __builtin_amdgcn_mfma_f32_16x16x32_bf16(a, bb, acc, 0, 0, 0); }
#pragma unroll
          for (int ks = 0; ks < 2; ++ks) { const bf16x8 a = *(const LAS bf16x8*)(QE + (16 * ib + row) * HP + ks * 32 + quad * 8), bb = *(const LAS bf16x8*)(ST + vrow * HP + ks * 32 + quad * 8);
              acc = __builtin_amdgcn_mfma_f32_16x16x32_bf16(a, bb, acc, 0, 0, 0); }
#pragma unroll
          for (int j = 0; j < 4; ++j) OUT[(16 * ib + quad * 4 + j) * CP + vrow] = acc[j]; }
    }
    WGBAR();
    { const LAS float* OUT = (const LAS float*)(F.lds + HG_OUT); const int t = F.tid >> 3, vc = F.tid & 7;
      float o[8], g[8]; float ss = 0.f;
#pragma unroll
      for (int j = 0; j < 8; ++j) { o[j] = OUT[t * CP + vc * 8 + j]; ss += o[j] * o[j]; }
      ss += __shfl_xor(ss, 1); ss += __shfl_xor(ss, 2); ss += __shfl_xor(ss, 4);
      const float rstd = 1.0f / sqrtf(ss * (1.0f / 64.0f) + EPS);
      unpack8(*(const u32x4*)(PM + (size_t)(tok0 + t) * PMP + 768 + head * 64 + vc * 8), g);
#pragma unroll
      for (int j = 0; j < 8; ++j) o[j] = o[j] * rstd * inp(F, I_HNG)[l * 64 + vc * 8 + j] * fsilu(g[j]);
      *(u32x4*)(OH + (size_t)(tok0 + t) * 256 + head * 64 + vc * 8) = pack8(o); }
    WGBAR();
}

DI void moba_prep_unit(Frame& F, int l, int u) {
    bf16* PM = (bf16*)(F.ws + WS_PM); float* KMEAN = (float*)(F.ws + WS_KMEAN);
    LAS float* KS = (LAS float*)(F.lds + RING_OFF);
    const int b = u >> 5, blk = u & 31, tg = F.tid >> 5, hd = (F.tid >> 3) & 3, dc = F.tid & 7;
    float qg[8], kg[8], ksum[8];
#pragma unroll
    for (int j = 0; j < 8; ++j) { qg[j] = inp(F, I_MQG)[l * 64 + dc * 8 + j] * attn_body::C2; kg[j] = inp(F, I_MKG)[l * 64 + dc * 8 + j]; ksum[j] = 0.f; }
    for (int it = 0; it < 16; ++it) {
        const size_t row = (size_t)b * SEQ + blk * 256 + it * 16 + tg;
        bf16* qp = PM + row * PMP + 1024 + hd * 64 + dc * 8; bf16* kp = PM + row * PMP + 1280 + hd * 64 + dc * 8;
        float q[8], k[8]; unpack8(*(const u32x4*)qp, q); unpack8(*(const u32x4*)kp, k);
        float sq = 0.f, sk = 0.f;
#pragma unroll
        for (int j = 0; j < 8; ++j) { sq += q[j] * q[j]; sk += k[j] * k[j]; }
        sq += __shfl_xor(sq, 1); sq += __shfl_xor(sq, 2); sq += __shfl_xor(sq, 4); sk += __shfl_xor(sk, 1); sk += __shfl_xor(sk, 2); sk += __shfl_xor(sk, 4);
        const float rq = 1.0f / sqrtf(sq * (1.0f / 64.0f) + EPS), rk = 1.0f / sqrtf(sk * (1.0f / 64.0f) + EPS);
#pragma unroll
        for (int j = 0; j < 8; ++j) { q[j] = q[j] * rq * qg[j]; k[j] = k[j] * rk * kg[j]; ksum[j] += k[j]; }
        *(u32x4*)qp = pack8(q); *(u32x4*)kp = pack8(k);
    }
#pragma unroll
    for (int j = 0; j < 8; ++j) KS[tg * 256 + hd * 64 + dc * 8 + j] = ksum[j];
    WGBAR();
    if (F.tid < 256) { float s = 0.f;
#pragma unroll
        for (int q = 0; q < 16; ++q) s += KS[q * 256 + F.tid];
        KMEAN[((size_t)(b * 4 + (F.tid >> 6)) * 32 + blk) * 64 + (F.tid & 63)] = s * (1.0f / 256.0f); }
    WGBAR();
}
DI void moba_select_unit(Frame& F, int u) {
    const bf16* PM = (const bf16*)(F.ws + WS_PM); const float* KMEAN = (const float*)(F.ws + WS_KMEAN); unsigned* SEL = (unsigned*)(F.ws + WS_SEL);
    LAS float* KM = (LAS float*)(F.lds + RING_OFF);
    const int b = u >> 5, blk = u & 31;
    for (int i = F.tid; i < 4 * 32 * 64 / 4; i += NTHR) ((LAS f32x4*)KM)[i] = ((const f32x4*)(KMEAN + (size_t)b * 4 * 32 * 64))[i];
    WGBAR();
    for (int r = 0; r < 2; ++r) {
        const int p = F.tid + NTHR * r, tokl = p & 255, hd = __builtin_amdgcn_readfirstlane(p >> 8);
        const size_t row = (size_t)b * SEQ + blk * 256 + tokl;
        float q[64];
#pragma unroll
        for (int c8 = 0; c8 < 8; ++c8) { float t8[8]; unpack8(*(const u32x4*)(PM + row * PMP + 1024 + hd * 64 + c8 * 8), t8);
#pragma unroll
            for (int j = 0; j < 8; ++j) q[c8 * 8 + j] = t8[j]; }
        float v0 = -INFINITY, v1 = -INFINITY, v2 = -INFINITY; int i0 = -1, i1 = -1, i2 = -1;
        for (int j = 0; j < blk; ++j) { const LAS f32x4* km = (const LAS f32x4*)(KM + (hd * 32 + j) * 64); float g = 0.f;
#pragma unroll
            for (int d4 = 0; d4 < 16; ++d4) { const f32x4 kk = km[d4]; g += q[d4 * 4] * kk.x + q[d4 * 4 + 1] * kk.y + q[d4 * 4 + 2] * kk.z + q[d4 * 4 + 3] * kk.w; }
            if (g > v0) { v2 = v1; i2 = i1; v1 = v0; i1 = i0; v0 = g; i0 = j; } else if (g > v1) { v2 = v1; i2 = i1; v1 = g; i1 = j; } else if (g > v2) { v2 = g; i2 = j; } }
        unsigned m = 1u << blk; if (i0 >= 0) m |= 1u << i0; if (i1 >= 0) m |= 1u << i1; if (i2 >= 0) m |= 1u << i2;
        SEL[row * 4 + hd] = m;
    }
    WGBAR();
}

DI void moe_route_unit(Frame& F, int l, int u) {
    const float* LOG = (const float*)(F.ws + WS_LOGITS); int* TOPI = (int*)(F.ws + WS_TOPI); float* TOPW = (float*)(F.ws + WS_TOPW);
    int* hist = (int*)(F.ldsg + RING_OFF); LAS float* biasl = (LAS float*)(F.lds + RING_OFF + 512);
    if (F.tid < 64) { hist[F.tid] = 0; biasl[F.tid] = inp(F, I_RB)[l * 64 + F.tid]; }
    WGBAR();
    const size_t t = (size_t)u * 512 + F.tid;
    float key[64];
#pragma unroll
    for (int c4 = 0; c4 < 16; ++c4) { const f32x4 v = *(const f32x4*)(LOG + t * 64 + c4 * 4);
        key[c4 * 4] = fsigmoid(v.x) + biasl[c4 * 4]; key[c4 * 4 + 1] = fsigmoid(v.y) + biasl[c4 * 4 + 1]; key[c4 * 4 + 2] = fsigmoid(v.z) + biasl[c4 * 4 + 2]; key[c4 * 4 + 3] = fsigmoid(v.w) + biasl[c4 * 4 + 3]; }
    int idx[6]; float sc[6]; float sum = 0.f;
#pragma unroll
    for (int k = 0; k < 6; ++k) { float best = -INFINITY; int bi = 0;
#pragma unroll
        for (int e = 0; e < 64; ++e) if (key[e] > best) { best = key[e]; bi = e; }
#pragma unroll
        for (int e = 0; e < 64; ++e) if (e == bi) key[e] = -INFINITY;
        idx[k] = bi; sc[k] = best - biasl[bi]; sum += sc[k]; }
    const float inv = 2.5f / sum;
#pragma unroll
    for (int k = 0; k < 6; ++k) { TOPI[t * 6 + k] = idx[k]; TOPW[t * 6 + k] = sc[k] * inv; atomicAdd(&hist[idx[k]], 1); }
    WGBAR();
    if (F.tid < 64) atomicAdd((unsigned*)(F.ctl + CW_CNT + l * 64 + F.tid), (unsigned)hist[F.tid]);
    WGBAR();
}
DI void moe_tables(Frame& F, int l, LAS int* blkpfx, LAS int* rowpfx) {
    LAS int* cn = rowpfx + 80;
    if (F.tid < NEXP) cn[F.tid] = (int)__hip_atomic_load(F.ctl + CW_CNT + l * 64 + F.tid, RLX_AGENT);
    WGBAR();
    if (F.tid == 0) { int acc = 0;
        for (int e = 0; e < NEXP; ++e) { const int cnt = cn[e]; blkpfx[e] = acc; rowpfx[e] = acc * 256; acc += (cnt + 255) >> 8; }
        blkpfx[NEXP] = acc; rowpfx[NEXP] = acc * 256; blkpfx[NEXP1] = acc + T_TOK / 256; rowpfx[NEXP1] = (acc + T_TOK / 256) * 256; }
    WGBAR();
}
DI void moe_scatter_unit(Frame& F, int l, int u, const LAS int* rowpfx) {
    const int* TOPI = (const int*)(F.ws + WS_TOPI); const float* TOPW = (const float*)(F.ws + WS_TOPW); int* POS = (int*)(F.ws + WS_POS); int* ROWTOK = (int*)(F.ws + WS_ROWTOK); float* ROWW = (float*)(F.ws + WS_ROWW);
    int* hist = (int*)(F.ldsg + RING_OFF); LAS int* basel = (LAS int*)(F.lds + RING_OFF + 512);
    if (F.tid < 64) hist[F.tid] = 0;
    WGBAR();
    const size_t t = (size_t)u * 512 + F.tid; int e[6], r[6];
#pragma unroll
    for (int k = 0; k < 6; ++k) { e[k] = TOPI[t * 6 + k]; r[k] = atomicAdd(&hist[e[k]], 1); }
    WGBAR();
    if (F.tid < 64) basel[F.tid] = (int)atomicAdd((unsigned*)(F.ctl + CW_CUR + l * 64 + F.tid), (unsigned)hist[F.tid]);
    WGBAR();
#pragma unroll
    for (int k = 0; k < 6; ++k) { const int pos = rowpfx[e[k]] + basel[e[k]] + r[k]; POS[t * 6 + k] = pos; ROWTOK[pos] = (int)t; ROWW[pos] = TOPW[t * 6 + k]; }
    WGBAR();
}
DI void moe_fill_rows(Frame& F, int l, const LAS int* rowpfx) {
    int* ROWTOK = (int*)(F.ws + WS_ROWTOK); float* ROWW = (float*)(F.ws + WS_ROWW);
    for (int e = F.vcu; e < NEXP; e += F.G) { const int cnt = (int)__hip_atomic_load(F.ctl + CW_CNT + l * 64 + e, RLX_AGENT); const int lo = rowpfx[e] + cnt, hi = rowpfx[e + 1];
        for (int i = lo + F.tid; i < hi; i += NTHR) { ROWTOK[i] = 0; ROWW[i] = 0.f; } }
    const int sh0 = rowpfx[NEXP];
    for (int t = F.vcu * NTHR + F.tid; t < T_TOK; t += F.G * NTHR) { ROWTOK[sh0 + t] = t; ROWW[sh0 + t] = 1.0f; }
}
DI void moe_combine(Frame& F, const float* gate, float* X, const LAS int* rowpfx) {
    const int* POS = (const int*)(F.ws + WS_POS); const unsigned char* Y8 = (const unsigned char*)(F.ws + WS_Y);
    const int gw = F.vcu * NWAVES + F.wave, NGW = F.G * NWAVES; const int sh0 = rowpfx[NEXP];
    for (int t = gw; t < T_TOK; t += NGW) {
        const int b = t >> 13; int myp = (F.lane < 6) ? POS[(size_t)t * 6 + F.lane] : 0;
        u32x4 w[7];
#pragma unroll
        for (int k = 0; k < 7; ++k) { const int row = (k < 6) ? __shfl(myp, k) : (sh0 + t); w[k] = *(const u32x4*)(Y8 + (size_t)row * 1024 + F.lane * 16); }
        float* xp = X + (size_t)t * DM + F.lane * 16; const float* gp = gate + b * 6144 + F.lane * 16;
#pragma unroll
        for (int q = 0; q < 4; ++q) { f32x4 a = (f32x4){0.f, 0.f, 0.f, 0.f};
#pragma unroll
            for (int k = 0; k < 7; ++k) { const unsigned ww = (q == 0) ? w[k].x : (q == 1) ? w[k].y : (q == 2) ? w[k].z : w[k].w;
                const f32x2 lo = __builtin_amdgcn_cvt_pk_f32_fp8((int)ww, false), hi = __builtin_amdgcn_cvt_pk_f32_fp8((int)ww, true); a.x += lo.x; a.y += lo.y; a.z += hi.x; a.w += hi.y; }
            const f32x4 x = *(const f32x4*)(xp + q * 4), g = *(const f32x4*)(gp + q * 4);
            *(f32x4*)(xp + q * 4) = x + g * a * (1.0f / Y8_SCALE); }
    }
}

#ifndef ONLY
#define ONLY -1
#endif
#define PH(n) (ONLY < 0 || ONLY == (n))
#ifndef ONLY5
#define ONLY5 -1
#endif
#define PH5(n) (ONLY5 < 0 || ONLY5 == (n))
#define GRID_BAR() do { XcdBarrier _b = bar; GAS unsigned* _p = (GAS unsigned*)_b.bar; asm volatile("" : "+s"(_p)); _b.bar = (unsigned*)_p; unsigned _x = _b.x; asm volatile("" : "+s"(_x)); _b.x = _x; xcd_barrier(_b); } while (0)
#define PHASE_BEGIN() do { int _t = threadIdx.x; asm volatile("" : "+v"(_t)); F.tid = _t; F.lane = _t & 63; F.wave = __builtin_amdgcn_readfirstlane(_t >> 6); GAS unsigned char* _w = (GAS unsigned char*)ws0; asm volatile("" : "+s"(_w)); F.ws = (unsigned char*)_w; ws = F.ws; F.ctl = (gu32*)(F.ws + WS_CTL); MOD = (float*)(ws + WS_MOD); modl = MOD + (size_t)l * 8 * 6144; } while (0)
template <int l> DI void run_layer(Frame& F, const XcdBarrier& bar, unsigned char* ws0, unsigned char* lds, LAS int* blkpfx, LAS int* rowpfx, int bx) {
    unsigned char* ws = ws0; float* MOD = (float*)(ws + WS_MOD);
        const float* Xin = (l == 0) ? inp(F, I_X) : (const float*)F.out;
        const float* modl = MOD + (size_t)l * 8 * 6144;
        if (PH(0)) { PHASE_BEGIN();
        if (l == 0) p0_adaln(F);
        p0_s5tab(F, l);
        p0_convert(F, l);
        }
        GRID_BAR();
        if (PH(1)) { PHASE_BEGIN();
        norm_rows(F, Xin, inp(F, I_N1G) + l * DM, modl + 0, modl + 1024, (bf16*)(ws + WS_H));
        p1_s5fill(F);
        }
        GRID_BAR();
        if (PH(2)) { PHASE_BEGIN();
        { PolWin P; P.setup(ws + WS_H, DM, ws + WS_WIN, DM, T_TOK, D_IN, F.G, bx); P.wsb = ws;
          pg8::gemm_phase(F.lds + RING_OFF, P); }
        }
        GRID_BAR();
        if (PH(3)) { PHASE_BEGIN();
        { PolS5a P; P.UG = (const char*)(ws + WS_UG); P.BT1 = (const char*)(ws + WS_BT1); P.SLOC = (float*)(ws + WS_SLOC); P.ldb = 1024; P.G = F.G; P.c = F.vcu;
          pg8::gemm_phase(F.lds + RING_OFF, P); }
        for (int u = F.vcu; u < 4096; u += F.G) hgrn_h1_unit(F, l, u);
        for (int u = F.vcu; u < 256; u += F.G) moba_prep_unit(F, l, u);
        }
        GRID_BAR();
        if (PH(4)) { PHASE_BEGIN();
        for (int u = F.vcu; u < 128; u += F.G) s5_carry_unit(F, u);
        for (int u = F.vcu; u < 256; u += F.G) hgrn_carry_unit(F, u);
        for (int u = F.vcu; u < 256; u += F.G) moba_select_unit(F, u);
        }
        GRID_BAR();
        if (PH(5)) { PHASE_BEGIN();
        if (PH5(0)) { PolS5b P; P.UG = (const char*)(ws + WS_UG); P.S0 = (const char*)(ws + WS_S0); P.BT2 = (const char*)(ws + WS_BT2); P.Dsk = inp(F, I_SSMD) + l * 256; P.YS5 = (bf16*)(ws + WS_YS5); P.ldb = 1152; P.G = F.G; P.c = F.vcu;
          pg8::gemm_phase(F.lds + RING_OFF, P); }
        if (PH5(1)) for (int u = F.vcu; u < 4096; u += F.G) hgrn_h3_unit(F, l, u);
        if (PH5(2)) { const attn_body::bf16* pm = (const attn_body::bf16*)(ws + WS_PM);
          const attn_body::AttnTensors AT{pm + 1024, pm + 1280, pm + 1536, (attn_body::bf16*)(ws + WS_OM), (const unsigned*)(ws + WS_SEL)};
          const attn_body::StaticOrder S((int)F.G, bx);
          attn_body::attn_phase<attn_body::StaticOrder>((char*)lds + RING_OFF, AT, S); }
        }
        GRID_BAR();
        if (PH(6)) { PHASE_BEGIN();
        { PolGlu P; P.setup(ws + WS_YS5, 256, ws + WS_WGLU, 256, T_TOK, 2048, F.G, bx); P.GL = (const bf16*)(ws + WS_GL); P.MERGED = (bf16*)(ws + WS_MERGED);
          pg8::gemm_phase(F.lds + RING_OFF, P); }
        }
        GRID_BAR();
        if (PH(7)) { PHASE_BEGIN();
        { PolRmw P; P.A1 = (const char*)(ws + WS_OH); P.A2 = (const char*)(ws + WS_OM); P.B1 = (const char*)(ws + WS_WHO); P.B2 = (const char*)(ws + WS_WMO);
          P.GL = (const bf16*)(ws + WS_GL); P.MERGED = (bf16*)(ws + WS_MERGED); P.ldb = 256; P.ord.init(T_TOK, DM, F.G, bx); P.nper = (P.ord.nwg > P.ord.c) ? (P.ord.nwg - P.ord.c + P.ord.G - 1) / P.ord.G : 0;
          pg8::gemm_phase(F.lds + RING_OFF, P); }
        }
        GRID_BAR();
        if (PH(9)) { PHASE_BEGIN();
        { PolWout P; P.setup(ws + WS_MERGED, DM, ws + WS_WOUT, DM, T_TOK, DM, F.G, bx); P.Xin = Xin; P.X = F.out; P.gate = modl + 2048;
          pg8::gemm_phase(F.lds + RING_OFF, P); }
        }
        GRID_BAR();
        if (PH(10)) { PHASE_BEGIN();
        norm_rows(F, F.out, inp(F, I_N2G) + l * DM, modl + 3072, modl + 4096, (bf16*)(ws + WS_H2));
        }
        GRID_BAR();
        if (PH(11)) { PHASE_BEGIN();
        { PolRouter P; P.setup(ws + WS_H2, DM, ws + WS_WR, DM, T_TOK, 256, F.G, bx); P.LOG = (float*)(ws + WS_LOGITS);
          pg8::gemm_phase(F.lds + RING_OFF, P); }
        }
        GRID_BAR();
        if (PH(12)) { PHASE_BEGIN();
        for (int u = F.vcu; u < T_TOK / 512; u += F.G) moe_route_unit(F, l, u);
        }
        GRID_BAR();
        if (PH(13)) { PHASE_BEGIN();
        moe_tables(F, l, blkpfx, rowpfx);
        for (int u = F.vcu; u < T_TOK / 512; u += F.G) moe_scatter_unit(F, l, u, rowpfx);
        moe_fill_rows(F, l, rowpfx);
        }
        GRID_BAR();
        if (PH(14)) { PHASE_BEGIN();
        { PolGateUp P; P.gs.blkpfx = blkpfx; P.gs.nNt = 2; P.gs.G = F.G; P.gs.c = bx; P.H2 = (const char*)(ws + WS_H2); P.WGU = (const char*)(ws + WS_WGU);
          P.ROWTOK = (const int*)(ws + WS_ROWTOK); P.ROWW = (const float*)(ws + WS_ROWW); P.HID = (bf16*)(ws + WS_HID); P.ldb = 1024;
          pg8::gemm_phase(F.lds + RING_OFF, P); }
        }
        GRID_BAR();
        if (PH(15)) { PHASE_BEGIN();
        { PolDown P; P.gs.blkpfx = blkpfx; P.gs.nNt = 4; P.gs.G = F.G; P.gs.c = bx; P.HIDp = (const char*)(ws + WS_HID); P.WD = (const char*)(ws + WS_WD); P.Y8 = (unsigned char*)(ws + WS_Y); P.ldb = 256;
          pg8::gemm_phase(F.lds + RING_OFF, P); }
        }
        GRID_BAR();
        if (PH(16)) { PHASE_BEGIN();
        moe_combine(F, modl + 5120, F.out, rowpfx);
        }
        GRID_BAR();
}
struct Args { const float* in[31]; float* out; unsigned char* ws; int pad0, pad1; };
__global__ void __launch_bounds__(NTHR, 2) fwd_kernel(Args args) {
    extern __shared__ __attribute__((aligned(16))) unsigned char lds[];
    Frame F;
    F.lds = (LAS unsigned char*)lds; F.ldsg = lds;
    F.MISC = (volatile LAS unsigned*)(F.lds + MISC_OFF);
    F.tid = threadIdx.x; F.lane = F.tid & 63; F.wave = __builtin_amdgcn_readfirstlane(F.tid >> 6);
    F.G = gridDim.x; { const int bx = blockIdx.x; F.vcu = (F.G % 8 == 0) ? (bx % 8) * (F.G / 8) + bx / 8 : bx; }
    F.ws = args.ws; F.ctl = (gu32*)(args.ws + WS_CTL); F.out = args.out;
    for (int u = F.tid; u < (LDS_BYTES - LDSCTL_OFF) / 4; u += NTHR) ((LAS unsigned*)(F.lds + LDSCTL_OFF))[u] = 0u;
    __syncthreads();
    if (F.tid < 31) ((LAS unsigned long long*)(F.lds + PTR_OFF))[F.tid] = (unsigned long long)args.in[F.tid];
    __syncthreads();
    XcdBarrier bar = xcd_barrier_post((unsigned*)(F.ctl + CW_BAR), F.MISC + 8);
    unsigned char* ws = F.ws;
    LAS int* blkpfx = (LAS int*)(F.lds + LDSCTL_OFF); LAS int* rowpfx = (LAS int*)(F.lds + LDSCTL_OFF + 320);
    float* MOD = (float*)(ws + WS_MOD);
    const int bx = (int)blockIdx.x;
    run_layer<0>(F, bar, args.ws, lds, blkpfx, rowpfx, bx);
    run_layer<1>(F, bar, args.ws, lds, blkpfx, rowpfx, bx);
}

extern "C" void kernel_launch(void* const* d_in, const int* in_sizes, int n_in, void* d_out, int out_size, void* d_ws, size_t ws_size, hipStream_t stream) {
    static int grid = 0;
    if (grid == 0) {
        if (n_in != 31 || in_sizes[0] != T_TOK * DM || out_size != T_TOK * DM || ws_size < WS_END) {
            fprintf(stderr, "kernel_launch: unexpected shapes (n_in %d, in0 %d, out %d, ws %zu, need %zu); nothing launched\n", n_in, n_in > 0 ? in_sizes[0] : -1, out_size, ws_size, (size_t)WS_END); grid = -1; return; }
        int dev = 0, cus = 0, per_cu = 0;
        if (hipGetDevice(&dev) != hipSuccess || hipDeviceGetAttribute(&cus, hipDeviceAttributeMultiprocessorCount, dev) != hipSuccess) { grid = -1; return; }
        if (hipFuncSetAttribute((const void*)fwd_kernel, hipFuncAttributeMaxDynamicSharedMemorySize, LDS_BYTES) != hipSuccess) { fprintf(stderr, "kernel_launch: hipFuncSetAttribute failed\n"); grid = -1; return; }
        if (hipOccupancyMaxActiveBlocksPerMultiprocessor(&per_cu, (const void*)fwd_kernel, NTHR, LDS_BYTES) != hipSuccess || per_cu < 1) { fprintf(stderr, "kernel_launch: occupancy query says %d\n", per_cu); }
        (void)hipGetLastError();
        grid = cus;
    }
    if (grid < 0) return;
    if (hipMemsetAsync((char*)d_ws + WS_CTL, 0, CTL_ZERO_BYTES, stream) != hipSuccess) return;
    Args a{};
    for (int i = 0; i < 31; ++i) a.in[i] = (const float*)d_in[i];
    a.out = (float*)d_out; a.ws = (unsigned char*)d_ws; a.pad0 = 0; a.pad1 = 0;
    hipLaunchKernelGGL(fwd_kernel, dim3(grid), dim3(NTHR), LDS_BYTES, stream, a);
}
```

```cpp
#include <hip/hip_runtime.h>
#include <cstdio>
#include <cstdint>

#define GAS __attribute__((address_space(1)))
#define LAS __attribute__((address_space(3)))
typedef unsigned short bf16;
typedef short bf16x8 __attribute__((ext_vector_type(8)));
typedef float f32x4 __attribute__((ext_vector_type(4)));
typedef float f32x2 __attribute__((ext_vector_type(2)));
typedef unsigned u32x4 __attribute__((ext_vector_type(4)));
typedef unsigned u32x2 __attribute__((ext_vector_type(2)));
typedef GAS unsigned gu32;
#define RLX_AGENT __ATOMIC_RELAXED, __HIP_MEMORY_SCOPE_AGENT
#define LDS_WAIT() asm volatile("s_waitcnt lgkmcnt(0)" ::: "memory")
#define VM_WAIT() asm volatile("s_waitcnt vmcnt(0)" ::: "memory")
#define DI __device__ __forceinline__

DI unsigned f2bf(float f) { unsigned u = __builtin_bit_cast(unsigned, f); return (u + 0x7fffu + ((u >> 16) & 1u)) >> 16; }
DI unsigned pk2(float lo, float hi) { return f2bf(lo) | (f2bf(hi) << 16); }
DI float bflo(unsigned w) { return __builtin_bit_cast(float, w << 16); }
DI float bfhi(unsigned w) { return __builtin_bit_cast(float, w & 0xffff0000u); }
DI float bf2f(bf16 b) { return __builtin_bit_cast(float, ((unsigned)b) << 16); }
DI unsigned cvt_pk_bf16(float lo, float hi) { unsigned r; asm volatile("v_cvt_pk_bf16_f32 %0, %1, %2" : "=v"(r) : "v"(lo), "v"(hi)); return r; }
DI float fsigmoid(float x) { return __builtin_amdgcn_rcpf(1.0f + __builtin_amdgcn_exp2f(-1.4426950408889634f * x)); }
DI float fsilu(float x) { return x * fsigmoid(x); }
DI float fexp(float x) { return __builtin_amdgcn_exp2f(1.4426950408889634f * x); }
DI float gelu_tanh(float y) { const float z = 1.5957691216057308f * (y + 0.044715f * y * y * y); return y * fsigmoid(z); }
DI void unpack8(const u32x4 w, float (&o)[8]) { o[0] = bflo(w.x); o[1] = bfhi(w.x); o[2] = bflo(w.y); o[3] = bfhi(w.y); o[4] = bflo(w.z); o[5] = bfhi(w.z); o[6] = bflo(w.w); o[7] = bfhi(w.w); }
DI u32x4 pack8(const float (&v)[8]) { u32x4 w; w.x = cvt_pk_bf16(v[0], v[1]); w.y = cvt_pk_bf16(v[2], v[3]); w.z = cvt_pk_bf16(v[4], v[5]); w.w = cvt_pk_bf16(v[6], v[7]); return w; }

namespace pg8 {
constexpr int BM = 256, BK = 64, HALF = 128, HTB = HALF * BK * 2, STAGE_BYTES = 8 * HTB, NXCD = 8, WGM = 8;
__host__ __device__ __forceinline__ int lds_byte(int r, int c) { const int st = (r >> 4) * 2 + (c >> 5), rr = r & 15, cc = c & 31, ob = rr * 64 + cc * 2; return st * 1024 + (ob ^ (((ob >> 9) & 1) << 5)); }
__host__ __device__ __forceinline__ void stage_rc(int b, int& R, int& C) { const int st = b / 1024, sb = b % 1024, swz = sb ^ (((sb >> 9) & 1) << 5); R = (st >> 1) * 16 + swz / 64; C = (st & 1) * 32 + (swz % 64) / 2; }
__host__ __device__ __forceinline__ int perm32(int rho) { const int n = rho >> 4, i = rho & 15; return 8 * (i >> 2) + 4 * n + (i & 3); }

typedef int v4i_t __attribute__((ext_vector_type(4))); typedef int v8i_t __attribute__((ext_vector_type(8)));
__device__ __forceinline__ v8i_t cat8(bf16x8 a, bf16x8 b) { return __builtin_shufflevector(__builtin_bit_cast(v4i_t, a), __builtin_bit_cast(v4i_t, b), 0, 1, 2, 3, 4, 5, 6, 7); }
__device__ __forceinline__ bf16x8 lo8(v8i_t a) { return __builtin_bit_cast(bf16x8, (v4i_t)__builtin_shufflevector(a, a, 0, 1, 2, 3)); }
__device__ __forceinline__ bf16x8 hi8(v8i_t a) { return __builtin_bit_cast(bf16x8, (v4i_t)__builtin_shufflevector(a, a, 4, 5, 6, 7)); }
struct GU { const char* A; const char* A2; const char* B; int nt1, nt, kstepA, kstepA2, bjump, pm, pn, e, lda, lda2; };

struct TileOrder {
    int nM, nN, nwg, G, c;
    DI void init(int M, int N, int G_, int c_) { nM = M / BM; nN = N / BM; nwg = nM * nN; G = G_; c = c_; }
    DI bool next(int i, int& pm, int& pn) const {
        const long L = (long)i * G + c; if (L >= nwg) return false;
        int wgid = (int)L; { const int q = nwg / NXCD, r = nwg % NXCD, xcd = wgid % NXCD, off = wgid / NXCD; wgid = (xcd < r ? xcd * (q + 1) : r * (q + 1) + (xcd - r) * q) + off; }
        const int nig = WGM * nN, gid = wgid / nig, fm = gid * WGM, gsz = (nM - fm) < WGM ? (nM - fm) : WGM;
        pm = fm + ((wgid % nig) % gsz); pn = (wgid % nig) / gsz; return true;
    }
};

template <class P> __device__ __forceinline__ int ldb2_of(const P& S) { if constexpr (P::MIXED) return S.ldb2; else return S.ldb; }
template <class P, class = void> struct perm16_of { static constexpr bool v = false; };
template <class P> struct perm16_of<P, decltype((void)P::PERM16)> { static constexpr bool v = P::PERM16; };
template <class P, class = void> struct pre_of { struct type {}; static constexpr bool v = false; };
template <class P> struct pre_of<P, decltype((void)sizeof(typename P::Pre))> { using type = typename P::Pre; static constexpr bool v = true; };
template <class P, class = void> struct permsw_of { static constexpr bool v = false; };
template <class P> struct permsw_of<P, decltype((void)P::PERMSW)> { static constexpr bool v = P::PERMSW; };
__host__ __device__ __forceinline__ int perm32sw(int rho) { const int n = rho >> 4, i = rho & 15, q = i >> 2; return 16 * (q & 1) + 8 * (q >> 1) + 4 * n + (i & 3); }
template <class P, class = void> struct perm16f8_of { static constexpr bool v = false; };
template <class P> struct perm16f8_of<P, decltype((void)P::PERM16F8)> { static constexpr bool v = P::PERM16F8; };
__host__ __device__ __forceinline__ int perm16(int R) { return 64 * (R >> 5) + 16 * ((R & 15) >> 2) + 4 * ((R >> 4) & 1) + (R & 3); }
template <class P>
__device__ __forceinline__ void gemm_phase(LAS unsigned char* lds, const P& S) {
    int tid = threadIdx.x; asm volatile("" : "+v"(tid));
    const int wid = __builtin_amdgcn_readfirstlane(tid >> 6), lane = tid & 63, wr = wid >> 2, wc = wid & 3, fr = lane & 15, fq = lane >> 4;
    int R[2], C[2]; unsigned voffB[2], voffB2[2], voffA1[2], voffA2[2];
#pragma unroll
    for (int i = 0; i < 2; ++i) { stage_rc(tid * 16 + i * 8192, R[i], C[i]); const int Rb = perm16_of<P>::v ? perm16(R[i]) : permsw_of<P>::v ? ((R[i] & ~31) + perm32sw(R[i] & 31)) : P::PERM ? ((R[i] & ~31) + perm32(R[i] & 31)) : R[i]; voffB[i] = (unsigned)(Rb * S.ldb + C[i]) * 2u;
        voffA1[i] = (unsigned)(R[i] * S.lda + C[i]) * 2u; voffA2[i] = (unsigned)(R[i] * (S.lda2 - S.lda)) * 2u;
        const int Rb2 = perm16f8_of<P>::v ? perm16(R[i]) : Rb; voffB2[i] = (unsigned)(Rb2 * ldb2_of(S) - Rb * S.ldb) * 2u; }
    const unsigned ldsw = (unsigned)wid * 1024u;
    const int aoff = lds_byte(wr * 64 + fr, fq * 8), boff = lds_byte(wc * 32 + fr, fq * 8);
#define PG8_SA(b, h) (((b) * 2 + (h)) * HTB)
#define PG8_SB(b, h) ((4 + (b) * 2 + (h)) * HTB)
#define PG8_STAGE_A(bufoff, h, U, V, t) do { const int _t = (t); const bool _s2 = P::SEG2 && (_t >= (U).nt1); \
        const char* _gb = (_s2 ? (U).A2 + (size_t)(_t - (U).nt1) * (size_t)(U).kstepA2 : (U).A + (size_t)_t * (size_t)(U).kstepA) + (P::GATHER ? (size_t)0 : (size_t)(h) * (size_t)(128 * 2) * (size_t)(_s2 ? S.lda2 : S.lda)); \
        _Pragma("unroll") for (int _i = 0; _i < 2; ++_i) { const unsigned _o = P::GATHER ? (V)[h][_i] : (P::SEG2 ? (voffA1[_i] + (voffA2[_i] & (0u - (unsigned)_s2))) : voffA1[_i]); \
        __builtin_amdgcn_global_load_lds((const unsigned*)(_gb + _o), (LAS unsigned*)(lds + (bufoff) + ldsw + _i * 8192), 16, 0, 0); } } while (0)
#define PG8_STAGE_B(bufoff, h, U, t) do { const int _t = (t); const bool _m8 = P::MIXED && ((U).e != 0); \
        const char* _gb = (U).B + (size_t)(h) * (size_t)(((perm16_of<P>::v || (perm16f8_of<P>::v && _m8)) ? 8 : 128) * 2) * (size_t)(_m8 ? ldb2_of(S) : S.ldb) + (size_t)_t * 128u + ((P::SEG2 && _t >= (U).nt1) ? (size_t)(U).bjump : (size_t)0); \
        _Pragma("unroll") for (int _i = 0; _i < 2; ++_i) { const unsigned _ob = P::MIXED ? (voffB[_i] + (voffB2[_i] & (0u - (unsigned)_m8))) : voffB[_i]; \
        __builtin_amdgcn_global_load_lds((const unsigned*)(_gb + _ob), (LAS unsigned*)(lds + (bufoff) + ldsw + _i * 8192), 16, 0, 0); } } while (0)
#define PG8_LDA(dst, b, h) do { _Pragma("unroll") for (int m = 0; m < 4; ++m) { if constexpr (P::MIXED) { dst##8[m] = cat8(*(const LAS bf16x8*)(lds + PG8_SA(b, h) + aoff + m * 2048), *(const LAS bf16x8*)(lds + PG8_SA(b, h) + aoff + m * 2048 + 1024)); } \
        else { _Pragma("unroll") for (int k = 0; k < 2; ++k) dst[m][k] = *(const LAS bf16x8*)(lds + PG8_SA(b, h) + aoff + m * 2048 + k * 1024); } } } while (0)
#define PG8_LDB(dst, b, h) do { _Pragma("unroll") for (int n = 0; n < 2; ++n) { if constexpr (P::MIXED) { dst##8[n] = cat8(*(const LAS bf16x8*)(lds + PG8_SB(b, h) + boff + n * 2048), *(const LAS bf16x8*)(lds + PG8_SB(b, h) + boff + n * 2048 + 1024)); } \
        else { _Pragma("unroll") for (int k = 0; k < 2; ++k) dst[n][k] = *(const LAS bf16x8*)(lds + PG8_SB(b, h) + boff + n * 2048 + k * 1024); } } } while (0)
#define PG8_MMA(ai, bj, At, Bt) PG8_MMAX(ai, bj, At, Bt, 0)
#define PG8_MMAX(ai, bj, At, Bt, F8) do { __builtin_amdgcn_s_setprio(1); \
        if constexpr (P::MIXED) { if constexpr (F8) { _Pragma("unroll") for (int m = 0; m < 4; ++m) _Pragma("unroll") for (int n = 0; n < 2; ++n) \
                asm volatile("v_mfma_f32_16x16x128_f8f6f4 %0, %1, %2, %0" : "+v"(acc[ai][bj][m][n]) : "v"(Bt##8[n]), "v"(At##8[m])); } \
            else { _Pragma("unroll") for (int m = 0; m < 4; ++m) _Pragma("unroll") for (int n = 0; n < 2; ++n) { \
                acc[ai][bj][m][n] = __builtin_amdgcn_mfma_f32_16x16x32_bf16(lo8(Bt##8[n]), lo8(At##8[m]), acc[ai][bj][m][n], 0, 0, 0); \
                acc[ai][bj][m][n] = __builtin_amdgcn_mfma_f32_16x16x32_bf16(hi8(Bt##8[n]), hi8(At##8[m]), acc[ai][bj][m][n], 0, 0, 0); } } } \
        else { _Pragma("unroll") for (int m = 0; m < 4; ++m) _Pragma("unroll") for (int n = 0; n < 2; ++n) _Pragma("unroll") for (int k = 0; k < 2; ++k) \
            acc[ai][bj][m][n] = __builtin_amdgcn_mfma_f32_16x16x32_bf16(Bt[n][k], At[m][k], acc[ai][bj][m][n], 0, 0, 0); } \
        __builtin_amdgcn_s_setprio(0); } while (0)
#define PG8_WAIT_V(n) asm volatile("s_waitcnt vmcnt(" #n ")" ::: "memory")
#define PG8_WAIT_V8R() asm volatile("s_cmp_lg_u32 %0, 0\n\ts_cbranch_scc1 1f\n\ts_cmp_eq_u32 %1, 0\n\ts_cbranch_scc1 1f\n\ts_waitcnt vmcnt(%2)\n\ts_branch 2f\n1:\n\ts_waitcnt vmcnt(8)\n2:" :: "s"(tsc), "s"(uisc), "n"(8 + (P::NST < 55 ? P::NST : 55)) : "memory", "scc")
#define PG8_WAIT_L(n) asm volatile("s_waitcnt lgkmcnt(" #n ")" ::: "memory")
#define PG8_BAR __builtin_amdgcn_s_barrier()
#define PG8_SCHED __builtin_amdgcn_sched_barrier(0)
#define PG8_KLOOP(F8) \
        for (int t = 0; t < nt; t += 2) { \
            const bool last = (t == nt - 2); const int tsc = __builtin_amdgcn_readfirstlane(t), uisc = __builtin_amdgcn_readfirstlane(ui); \
            GU U2 = cur; unsigned V2a[2][2]; int t2 = t + 2; \
_Pragma("unroll") \
            for (int h = 0; h < 2; ++h) \
_Pragma("unroll") \
                for (int i = 0; i < 2; ++i) V2a[h][i] = (P::GATHER && last) ? vAn[h][i] : vAc[h][i]; \
            if (last) { U2 = nxt; t2 = 0; } \
            const int t3 = t2 + 1; \
            PG8_LDB(B0, 0, 0); PG8_LDB(B1, 0, 1); PG8_SCHED; PG8_LDA(At, 0, 0); PG8_STAGE_A(PG8_SA(1, 1), 1, cur, vAc, t + 1); \
            PG8_WAIT_V8R(); PG8_WAIT_L(0); PG8_BAR; PG8_MMAX(0, 0, At, B0, F8); PG8_MMAX(0, 1, At, B1, F8); PG8_BAR; PG8_SCHED; \
            PG8_LDA(At, 0, 1); PG8_STAGE_B(PG8_SB(0, 0), 0, U2, t2); PG8_STAGE_B(PG8_SB(0, 1), 1, U2, t2); PG8_STAGE_A(PG8_SA(0, 0), 0, U2, V2a, t2); \
            PG8_WAIT_V8R(); PG8_WAIT_L(0); PG8_BAR; PG8_MMAX(1, 0, At, B0, F8); PG8_MMAX(1, 1, At, B1, F8); PG8_BAR; PG8_SCHED; \
            PG8_LDB(B0, 1, 0); PG8_LDB(B1, 1, 1); PG8_SCHED; PG8_LDA(At, 1, 0); PG8_STAGE_A(PG8_SA(0, 1), 1, U2, V2a, t2); \
            PG8_WAIT_V(8); PG8_WAIT_L(0); PG8_BAR; PG8_MMAX(0, 0, At, B0, F8); PG8_MMAX(0, 1, At, B1, F8); PG8_BAR; PG8_SCHED; \
            PG8_LDA(At, 1, 1); PG8_STAGE_B(PG8_SB(1, 0), 0, U2, t3); PG8_STAGE_B(PG8_SB(1, 1), 1, U2, t3); PG8_STAGE_A(PG8_SA(1, 0), 0, U2, V2a, t3); \
            PG8_WAIT_V(8); PG8_WAIT_L(0); PG8_BAR; PG8_MMAX(1, 0, At, B0, F8); PG8_MMAX(1, 1, At, B1, F8); PG8_BAR; PG8_SCHED; \
        }
    GU cur, nxt; int ui = 0;
    if (!S.next(0, cur)) return;
    unsigned vAc[2][2], vAn[2][2];
    if constexpr (P::GATHER) S.avoff(cur, R, C, vAc); else { vAc[0][0] = vAc[0][1] = vAc[1][0] = vAc[1][1] = 0u; }
    f32x4 acc[2][2][4][2];
#pragma unroll
    for (int a = 0; a < 2; ++a)
#pragma unroll
        for (int b = 0; b < 2; ++b)
#pragma unroll
            for (int m = 0; m < 4; ++m)
#pragma unroll
                for (int n = 0; n < 2; ++n) acc[a][b][m][n] = (f32x4){0.f, 0.f, 0.f, 0.f};
    bf16x8 At[4][2], B0[2][2], B1[2][2]; v8i_t At8[4], B08[2], B18[2];
    typename pre_of<P>::type pre;
    if constexpr (pre_of<P>::v) S.pre(cur, wr, fr, pre);
    PG8_STAGE_B(PG8_SB(0, 0), 0, cur, 0); PG8_STAGE_B(PG8_SB(0, 1), 1, cur, 0); PG8_STAGE_A(PG8_SA(0, 0), 0, cur, vAc, 0); PG8_STAGE_A(PG8_SA(0, 1), 1, cur, vAc, 0);
    if (wr == 1) PG8_BAR;
    PG8_WAIT_V(2); PG8_BAR;
    PG8_STAGE_B(PG8_SB(1, 0), 0, cur, 1); PG8_STAGE_A(PG8_SA(1, 0), 0, cur, vAc, 1); PG8_STAGE_B(PG8_SB(1, 1), 1, cur, 1);
    PG8_WAIT_V(6); PG8_BAR;
    bool has_next = S.next(1, nxt);
    if (!has_next) nxt = cur;
    if constexpr (P::GATHER) { if (has_next) S.avoff(nxt, R, C, vAn); else {
#pragma unroll
        for (int h = 0; h < 2; ++h)
#pragma unroll
            for (int i = 0; i < 2; ++i) vAn[h][i] = vAc[h][i]; } }
    else { vAn[0][0] = vAn[0][1] = vAn[1][0] = vAn[1][1] = 0u; }
    for (;;) {
        const int nt = cur.nt;
        if (P::MIXED && cur.e != 0) { PG8_KLOOP(1) } else { PG8_KLOOP(0) }
        if (wr == 0) PG8_BAR;
        if constexpr (P::MIXED) { PG8_SCHED; asm volatile("s_nop 15\n\ts_nop 15" ::: "memory"); PG8_SCHED; }
        GU nn; unsigned vAnn[2][2]; const bool has_nn = has_next && S.next(ui + 2, nn);
        if constexpr (P::GATHER) { if (has_nn) S.avoff(nn, R, C, vAnn); }
        if constexpr (pre_of<P>::v) S.epi(acc, cur, wr, wc, fr, fq, pre, nxt, has_next); else S.epi(acc, cur, wr, wc, fr, fq);
        if (!has_next) break;
#pragma unroll
        for (int a = 0; a < 2; ++a)
#pragma unroll
            for (int b = 0; b < 2; ++b)
#pragma unroll
                for (int m = 0; m < 4; ++m)
#pragma unroll
                    for (int n = 0; n < 2; ++n) acc[a][b][m][n] = (f32x4){0.f, 0.f, 0.f, 0.f};
        cur = nxt;
#pragma unroll
        for (int h = 0; h < 2; ++h)
#pragma unroll
            for (int i = 0; i < 2; ++i) vAc[h][i] = vAn[h][i];
        has_next = has_nn;
        if (has_nn) { nxt = nn;
            if constexpr (P::GATHER) {
#pragma unroll
                for (int h = 0; h < 2; ++h)
#pragma unroll
                    for (int i = 0; i < 2; ++i) vAn[h][i] = vAnn[h][i]; } }
        ++ui;
        if (wr == 1) PG8_BAR;
    }
    PG8_WAIT_V(0);
    PG8_BAR;
#undef PG8_SA
#undef PG8_SB
#undef PG8_STAGE_A
#undef PG8_STAGE_B
#undef PG8_LDA
#undef PG8_LDB
#undef PG8_MMA
#undef PG8_MMAX
#undef PG8_KLOOP
#undef PG8_WAIT_V
#undef PG8_WAIT_V8R
#undef PG8_WAIT_L
#undef PG8_BAR
#undef PG8_SCHED
}
}
#include <hip/hip_bf16.h>
#include <cmath>
namespace attn_body {
using bf16=__hip_bfloat16;
using bf16x8=__attribute__((ext_vector_type(8)))short;
using s16x4=__attribute__((ext_vector_type(4)))short;
using f32x16=__attribute__((ext_vector_type(16)))float;
using u32x4=__attribute__((ext_vector_type(4)))unsigned;
constexpr int BATCH=8,NHEAD=4,SEQ=8192,D=64,DM=1792;
constexpr int NW=8,QBLK=32,QB=QBLK*NW,KVBLK=64,NQB=SEQ/QB;
constexpr int ATTN_PITCH=DM, ATTN_UNIT_ROWS=QB, OPITCH=256;
__device__ __forceinline__ int crow(int r,int hi){return (r&3)+8*(r>>2)+4*hi;}
#define SBAR() __builtin_amdgcn_sched_barrier(0)
__device__ __forceinline__ void cmask(f32x16&p0,f32x16&p1,int jb,int qrel,int hi){
  const float NEG=-INFINITY; int kb=64*jb+4*hi;
  #pragma unroll
  for(int r=0;r<16;++r){int kv=kb+(r&3)+8*(r>>2); if(kv>qrel)p0[r]=NEG; if(kv+32>qrel)p1[r]=NEG;}
}

constexpr int NSLOT=3, SLOTB=8192;
constexpr int LDS_K=0, LDS_V=NSLOT*SLOTB, LDS_WS=2*NSLOT*SLOTB, LDS_OST=LDS_WS+NW*64*4, LDS_BYTES=LDS_OST+NW*4096;
constexpr float C2=0.125f*1.4426950408889634f;
__device__ __forceinline__ void glds16(const void*gsrc,unsigned lds_dst){unsigned keep;
  asm volatile("s_mov_b32 %0, m0\n\ts_mov_b32 m0, %2\n\ts_nop 0\n\tglobal_load_lds_dwordx4 %1, off\n\ts_mov_b32 m0, %0":"=&s"(keep):"v"(gsrc),"s"(lds_dst):"memory");}
__device__ __forceinline__ float max3f(float a,float b,float c){float r;asm("v_max3_f32 %0, %1, %2, %3":"=v"(r):"v"(a),"v"(b),"v"(c));return r;}
__device__ __forceinline__ float max2f(float a,float b){float r;asm("v_max_f32_e32 %0, %1, %2":"=v"(r):"v"(a),"v"(b));return r;}
__device__ __forceinline__ float fadd_s(float a,float b){float r;asm("v_add_f32_e32 %0, %1, %2":"=v"(r):"v"(a),"v"(b));return r;}
__device__ __forceinline__ float fsub_s(float a,float b){float r;asm("v_sub_f32_e32 %0, %1, %2":"=v"(r):"v"(a),"v"(b));return r;}
typedef float f32x2_t __attribute__((ext_vector_type(2))); typedef __bf16 bf16x2_t __attribute__((ext_vector_type(2)));
__device__ __forceinline__ unsigned cvtpk_s(float lo,float hi){f32x2_t v={lo,hi};bf16x2_t b=__builtin_convertvector(v,bf16x2_t);return __builtin_bit_cast(unsigned,b);}
#define WAIT_BAR(N) asm volatile("s_waitcnt vmcnt(" #N ") lgkmcnt(0)\n\ts_barrier":::"memory")

__device__ __forceinline__ void qkt(f32x16&p0,f32x16&p1,const char*Kslot,const bf16x8*qr,const f32x16&negm,int r32,int hi){
  const char*kb=Kslot+hi*1024+r32*16;
  #pragma unroll
  for(int d0=0;d0<4;++d0){
    const bf16x8 b0=*reinterpret_cast<const bf16x8*>(kb+d0*2048);
    const bf16x8 b1=*reinterpret_cast<const bf16x8*>(kb+d0*2048+512);
    if(d0==0){p0=__builtin_amdgcn_mfma_f32_32x32x16_bf16(b0,qr[0],negm,0,0,0);p1=__builtin_amdgcn_mfma_f32_32x32x16_bf16(b1,qr[0],negm,0,0,0);}
    else{p0=__builtin_amdgcn_mfma_f32_32x32x16_bf16(b0,qr[d0],p0,0,0,0);p1=__builtin_amdgcn_mfma_f32_32x32x16_bf16(b1,qr[d0],p1,0,0,0);}}
}
typedef __attribute__((address_space(3))) const char* lds_cptr;
typedef short v4i16_t __attribute__((ext_vector_type(4)));
__device__ __forceinline__ void kload8(bf16x8*kf,lds_cptr kp){
  kf[0]=*(const __attribute__((address_space(3))) bf16x8*)(kp);      kf[1]=*(const __attribute__((address_space(3))) bf16x8*)(kp+512);
  kf[2]=*(const __attribute__((address_space(3))) bf16x8*)(kp+2048); kf[3]=*(const __attribute__((address_space(3))) bf16x8*)(kp+2560);
  kf[4]=*(const __attribute__((address_space(3))) bf16x8*)(kp+4096); kf[5]=*(const __attribute__((address_space(3))) bf16x8*)(kp+4608);
  kf[6]=*(const __attribute__((address_space(3))) bf16x8*)(kp+6144); kf[7]=*(const __attribute__((address_space(3))) bf16x8*)(kp+6656);
}
__device__ __forceinline__ void kload2(bf16x8*kf,lds_cptr kp,int j){ kf[2*j]=*(const __attribute__((address_space(3))) bf16x8*)(kp+j*2048); kf[2*j+1]=*(const __attribute__((address_space(3))) bf16x8*)(kp+j*2048+512); }
__device__ __forceinline__ s16x4 vtr(lds_cptr p){ return __builtin_bit_cast(s16x4,__builtin_amdgcn_ds_read_tr16_b64_v4i16((__attribute__((address_space(3))) v4i16_t*)p)); }
__device__ __forceinline__ float rowmax(const f32x16&p0,const f32x16&p1){
  float a=max3f(p0[0],p0[1],p1[0]),b=max3f(p0[2],p0[3],p1[1]);a=max3f(a,p1[2],p1[3]);
  #pragma unroll
  for(int r=4;r<16;r+=4){a=max3f(a,p0[r],p0[r+1]);b=max3f(b,p0[r+2],p0[r+3]);a=max3f(a,p1[r],p1[r+1]);b=max3f(b,p1[r+2],p1[r+3]);}
  const float m=max2f(a,b);
  auto rr=__builtin_amdgcn_permlane32_swap(__float_as_uint(m),__float_as_uint(m),false,false);
  return max2f(__uint_as_float(rr[0]),__uint_as_float(rr[1]));
}
__device__ __forceinline__ void pv(f32x16*o,int vb,bf16x8 pa0,bf16x8 pa1,bf16x8 pa2,bf16x8 pa3){
  #pragma unroll
  for(int d0=0;d0<2;++d0){s16x4 lo[4],hi[4];
    #pragma unroll
    for(int ks=0;ks<4;++ks){
      asm volatile("ds_read_b64_tr_b16 %0,%1 offset:%c2":"=&v"(lo[ks]):"v"(vb),"i"(d0*4096+ks*1024):"memory");
      asm volatile("ds_read_b64_tr_b16 %0,%1 offset:%c2":"=&v"(hi[ks]):"v"(vb),"i"(d0*4096+ks*1024+512):"memory");}
    asm volatile("s_waitcnt lgkmcnt(0)":::"memory");SBAR();
    #define PK(k) (bf16x8){lo[k][0],lo[k][1],lo[k][2],lo[k][3],hi[k][0],hi[k][1],hi[k][2],hi[k][3]}
    o[d0]=__builtin_amdgcn_mfma_f32_32x32x16_bf16(pa0,PK(0),o[d0],0,0,0);
    o[d0]=__builtin_amdgcn_mfma_f32_32x32x16_bf16(pa1,PK(1),o[d0],0,0,0);
    o[d0]=__builtin_amdgcn_mfma_f32_32x32x16_bf16(pa2,PK(2),o[d0],0,0,0);
    o[d0]=__builtin_amdgcn_mfma_f32_32x32x16_bf16(pa3,PK(3),o[d0],0,0,0);
    #undef PK
  }
}

#ifndef ATTN_STORE16
#define ATTN_STORE16(p,v) (*(u32x4*)(p)=(v))
#endif
template<int THRL,int MODE> __device__ __forceinline__ void attn_unit(int b,int h,int kvb,const int*qlist,int nvalid,const bf16*Q,const bf16*__restrict__ K,const bf16*__restrict__ V,bf16*O,bf16*PO,float*PML,char*shm){
  int tid_=threadIdx.x; asm volatile("":"+v"(tid_)); const int tid=tid_,lane=tid&63,r32=lane&31,hi=lane>>5; const int wid=__builtin_amdgcn_readfirstlane(tid>>6);
  const long rowbase=(long)b*SEQ; const int q0=kvb*QB;
  int qent=0; if(MODE==0){ int qi=wid*QBLK+r32; qi=qi<nvalid?qi:nvalid-1; qent=qlist[qi]; }
  const long qrow=(MODE==0)?(rowbase+(qent>>2)):(rowbase+q0+wid*QBLK+r32);
  const bf16*Qp=Q+qrow*DM+h*D;
  const bf16*Kh=K+(rowbase+(long)kvb*QB)*DM+h*D,*Vh=V+(rowbase+(long)kvb*QB)*DM+h*D;
  const unsigned lds0=(unsigned)(uintptr_t)shm;
  float*wsf=(float*)(shm+LDS_WS)+wid*64;
  const bf16*ksrc=Kh+(long)lane*DM+wid*8;
  const bf16*vsrc=Vh+(long)(16*(wid&3)+(lane>>2))*DM+(wid>>2)*32+(lane&3)*8;
  const unsigned kdst=lds0+LDS_K+wid*1024, vdst=lds0+LDS_V+wid*1024;
  #define DMA_K(t,slot) glds16(ksrc+(long)(t)*KVBLK*DM,(unsigned)__builtin_amdgcn_readfirstlane(kdst+(slot)))
  #define DMA_V(t,slot) glds16(vsrc+(long)(t)*KVBLK*DM,(unsigned)__builtin_amdgcn_readfirstlane(vdst+(slot)))
  const int vb0=(int)(lds0+LDS_V)+((lane>>4)&1)*32+(lane&3)*8+(4*hi+((lane&15)>>2))*64;
  const char*Kbase=shm+LDS_K; bf16x8 kf[8];
  const lds_cptr shm3=(lds_cptr)shm; const lds_cptr kp0=shm3+LDS_K+hi*1024+r32*16; const lds_cptr vp0=shm3+LDS_V+((lane>>4)&1)*32+(lane&3)*8+(4*hi+((lane&15)>>2))*64;
  const int NT=4;
  DMA_K(0,0);DMA_V(0,0);DMA_K(1,SLOTB);
  bf16x8 qr[4];
  #pragma unroll
  for(int d0=0;d0<4;++d0)qr[d0]=*reinterpret_cast<const bf16x8*>(&Qp[d0*16+hi*8]);
  float mhat=0.f,l_reg=0.f;f32x16 o[2];o[0]=f32x16{};o[1]=f32x16{};f32x16 negm=f32x16{};asm volatile("":"+v"(negm));
  const int qrel=wid*QBLK+r32;
  #define CMASK(P0,P1,t) do{ if(MODE==1){ int jb_=(t)-(NT-4); if(jb_>=0)cmask(P0,P1,jb_,qrel,hi); } }while(0)
  bool resc=false;
  #define START(P0,P1) do{ const float rm=rowmax(P0,P1); resc=false; \
    { const float dl=rm; mhat=fadd_s(mhat,dl); \
      _Pragma("unroll") for(int r=0;r<16;++r){P0[r]=fsub_s(P0[r],dl);P1[r]=fsub_s(P1[r],dl);} \
      _Pragma("unroll") for(int r=0;r<16;++r)negm[r]=-mhat; asm volatile("":"+v"(negm)); } \
    _Pragma("unroll") for(int r=0;r<16;++r)P0[r]=__builtin_amdgcn_exp2f(P0[r]); }while(0)
  #define RESC() do{ if(resc){ asm volatile("s_waitcnt lgkmcnt(0)":::"memory"); \
      _Pragma("unroll") for(int d_=0;d_<2;++d_) _Pragma("unroll") for(int r=0;r<16;++r)o[d_][r]*=wsf[crow(r,hi)]; } }while(0)
  f32x16 pA0,pA1,pB0,pB1;
  int sl_prev=0,sl_cur=0,sl_next=SLOTB;
  #define ROT() do{sl_prev=sl_cur;sl_cur=sl_next;sl_next=(sl_next==(NSLOT-1)*SLOTB)?0:sl_next+SLOTB;}while(0)
  DMA_K(2,2*SLOTB);
  WAIT_BAR(3);
  qkt(pA0,pA1,Kbase,qr,negm,r32,hi);asm volatile("s_nop 15\n\ts_nop 7":"+v"(pA0),"+v"(pA1));CMASK(pA0,pA1,0);
  START(pA0,pA1);
  _Pragma("unroll") for(int r=0;r<16;++r)pA1[r]=__builtin_amdgcn_exp2f(pA1[r]);
  WAIT_BAR(0);
  DMA_K(3,0);DMA_V(1,SLOTB);
  ROT();
  kload8(kf,kp0+sl_cur);
  WAIT_BAR(2);
  s16x4 vlo[8],vhi[8]; u32x4 pw0,pw1,pw2,pw3;
  #define PKW(P,B) cvtpk_s(P[B],P[B+1])
  #define PAF(k) __builtin_bit_cast(bf16x8,pw##k)
  #define VFR(i) (bf16x8){vlo[i][0],vlo[i][1],vlo[i][2],vlo[i][3],vhi[i][0],vhi[i][1],vhi[i][2],vhi[i][3]}
  #define PIN(x) asm volatile("":"+v"(x))
  #define MX3(a,b,c) __builtin_fmaxf(__builtin_fmaxf((a),(b)),(c))
  #define GAPA(MF,A0,A1,A2,A3,W0,W1,PW) do{ MF; sacc+=A0; sacc+=A1; sacc+=A2; sacc+=A3; PIN(sacc); W0; W1; PIN(PW); SBAR(); }while(0)
  #define EX(v) __builtin_amdgcn_exp2f(v)
  #define GAPB(MF,X,B) do{ MF; X[B]=EX(X[B]); X[B+1]=EX(X[B+1]); X[B+2]=EX(X[B+2]); X[B+3]=EX(X[B+3]); PIN(X); SBAR(); }while(0)
  #define VRD(i) do{ vlo[i]=vtr(vp_+(((i)>>2)*4096+((i)&3)*1024)); vhi[i]=vtr(vp_+(((i)>>2)*4096+((i)&3)*1024+512)); }while(0)
  #define KRD(G,j) do{ if(G){ kload2(kf,kp0+sl_next,j); SBAR(); } }while(0)
  #define STEP(C0,C1,P0,P1,t,GK,GV,GL) do{ SBAR(); \
    const lds_cptr vp_=vp0+sl_prev; \
    VRD(0); SBAR(); float sacc=(P0[0]+P0[1]); \
    GAPA(C0=__builtin_amdgcn_mfma_f32_32x32x16_bf16(kf[0],qr[0],negm,0,0,0), P0[2],P0[3],P0[4],P0[5],     pw0[0]=PKW(P0,0), pw0[1]=PKW(P0,2), pw0); \
    VRD(4); SBAR(); GAPA(C1=__builtin_amdgcn_mfma_f32_32x32x16_bf16(kf[1],qr[0],negm,0,0,0), P0[6],P0[7],P0[8],P0[9],     pw0[2]=PKW(P0,4), pw0[3]=PKW(P0,6), pw0); \
    VRD(1); SBAR(); GAPA(C0=__builtin_amdgcn_mfma_f32_32x32x16_bf16(kf[2],qr[1],C0,0,0,0),   P0[10],P0[11],P0[12],P0[13], pw1[0]=PKW(P0,8), pw1[1]=PKW(P0,10), pw1); \
    VRD(5); SBAR(); GAPA(C1=__builtin_amdgcn_mfma_f32_32x32x16_bf16(kf[3],qr[1],C1,0,0,0),   P0[14],P0[15],P1[0],P1[1],   pw1[2]=PKW(P0,12),pw1[3]=PKW(P0,14), pw1); \
    VRD(2); SBAR(); GAPA(C0=__builtin_amdgcn_mfma_f32_32x32x16_bf16(kf[4],qr[2],C0,0,0,0),   P1[2],P1[3],P1[4],P1[5],     pw2[0]=PKW(P1,0), pw2[1]=PKW(P1,2), pw2); \
    VRD(6); SBAR(); GAPA(C1=__builtin_amdgcn_mfma_f32_32x32x16_bf16(kf[5],qr[2],C1,0,0,0),   P1[6],P1[7],P1[8],P1[9],     pw2[2]=PKW(P1,4), pw2[3]=PKW(P1,6), pw2); \
    VRD(3); SBAR(); GAPA(C0=__builtin_amdgcn_mfma_f32_32x32x16_bf16(kf[6],qr[3],C0,0,0,0),   P1[10],P1[11],P1[12],P1[13], pw3[0]=PKW(P1,8), pw3[1]=PKW(P1,10), pw3); \
    VRD(7); SBAR(); GAPA(C1=__builtin_amdgcn_mfma_f32_32x32x16_bf16(kf[7],qr[3],C1,0,0,0),   P1[14],P1[15],0.f,0.f,       pw3[2]=PKW(P1,12),pw3[3]=PKW(P1,14), pw3); \
    l_reg+=sacc; \
    if(GK){DMA_K((t)+3,sl_cur);} if(GV){DMA_V((t)+1,sl_next);} \
    CMASK(C0,C1,t); \
    { float a=MX3(C0[0],C0[1],C1[0]),b=MX3(C0[2],C0[3],C1[1]); a=MX3(a,C1[2],C1[3]); \
      _Pragma("unroll") for(int r=4;r<16;r+=4){a=MX3(a,C0[r],C0[r+1]);b=MX3(b,C0[r+2],C0[r+3]);a=MX3(a,C1[r],C1[r+1]);b=MX3(b,C1[r+2],C1[r+3]);} \
      float rm=__builtin_fmaxf(a,b); { auto rr=__builtin_amdgcn_permlane32_swap(__float_as_uint(rm),__float_as_uint(rm),false,false); rm=__builtin_fmaxf(__uint_as_float(rr[0]),__uint_as_float(rr[1])); } \
      resc=false; \
      if(__builtin_expect(__any(rm>(float)THRL),0)){ const float dl=__builtin_fmaxf(rm,0.f); mhat+=dl; \
        _Pragma("unroll") for(int r=0;r<16;++r){C0[r]-=dl;C1[r]-=dl;} \
        _Pragma("unroll") for(int r=0;r<16;++r)negm[r]=-mhat; asm volatile("":"+v"(negm)); \
        const float f=__builtin_amdgcn_exp2f(-dl); l_reg*=f; if(hi==0)wsf[r32]=f; resc=true; } } \
    SBAR(); \
    GAPB(o[0]=__builtin_amdgcn_mfma_f32_32x32x16_bf16(PAF(0),VFR(0),o[0],0,0,0), C0,0); \
    GAPB(o[1]=__builtin_amdgcn_mfma_f32_32x32x16_bf16(PAF(0),VFR(4),o[1],0,0,0), C0,4); \
    KRD(GL,0); GAPB(o[0]=__builtin_amdgcn_mfma_f32_32x32x16_bf16(PAF(1),VFR(1),o[0],0,0,0), C0,8); \
    KRD(GL,1); GAPB(o[1]=__builtin_amdgcn_mfma_f32_32x32x16_bf16(PAF(1),VFR(5),o[1],0,0,0), C0,12); \
    KRD(GL,2); GAPB(o[0]=__builtin_amdgcn_mfma_f32_32x32x16_bf16(PAF(2),VFR(2),o[0],0,0,0), C1,0); \
    KRD(GL,3); GAPB(o[1]=__builtin_amdgcn_mfma_f32_32x32x16_bf16(PAF(2),VFR(6),o[1],0,0,0), C1,4); \
    GAPB(o[0]=__builtin_amdgcn_mfma_f32_32x32x16_bf16(PAF(3),VFR(3),o[0],0,0,0), C1,8); \
    GAPB(o[1]=__builtin_amdgcn_mfma_f32_32x32x16_bf16(PAF(3),VFR(7),o[1],0,0,0), C1,12); \
    }while(0)
  int t=1;
  #undef CMASK
  #define CMASK(P0,P1,t) do{}while(0)
  for(;t+5<NT;t+=2){
    STEP(pB0,pB1,pA0,pA1,t,true,true,true);     WAIT_BAR(2); RESC(); ROT();
    STEP(pA0,pA1,pB0,pB1,t+1,true,true,true);   WAIT_BAR(2); RESC(); ROT();
  }
  #undef CMASK
  #define CMASK(P0,P1,t) do{ if(MODE==1){ int jb_=(t)-(NT-4); if(jb_>=0)cmask(P0,P1,jb_,qrel,hi); } }while(0)
  #define ENDW(tt) do{ if((tt)+3<NT){WAIT_BAR(2);} else if((tt)+2<NT){WAIT_BAR(1);} else {WAIT_BAR(0);} }while(0)
  for(;t+1<NT;t+=2){
    STEP(pB0,pB1,pA0,pA1,t,(t+3<NT),(t+1<NT),(t+1<NT));       ENDW(t);   RESC(); ROT();
    STEP(pA0,pA1,pB0,pB1,t+1,(t+4<NT),(t+2<NT),(t+2<NT));     ENDW(t+1); RESC(); ROT();
  }
  STEP(pB0,pB1,pA0,pA1,NT-1,false,false,false); RESC();
  { float sacc=pB0[0]+pB0[1]; _Pragma("unroll") for(int r=2;r<16;++r)sacc+=pB0[r]; _Pragma("unroll") for(int r=0;r<16;++r)sacc+=pB1[r]; l_reg+=sacc;
    pw0=(u32x4){PKW(pB0,0),PKW(pB0,2),PKW(pB0,4),PKW(pB0,6)};pw1=(u32x4){PKW(pB0,8),PKW(pB0,10),PKW(pB0,12),PKW(pB0,14)};pw2=(u32x4){PKW(pB1,0),PKW(pB1,2),PKW(pB1,4),PKW(pB1,6)};pw3=(u32x4){PKW(pB1,8),PKW(pB1,10),PKW(pB1,12),PKW(pB1,14)};
    SBAR(); pv(o,vb0+sl_cur,PAF(0),PAF(1),PAF(2),PAF(3)); }
  #undef PKW
  #undef PAF
  #undef VFR
  #undef PIN
  #undef MX3
  #undef GAPA
  #undef GAPB
  #undef EX
  #undef VRD
  #undef KRD
  #undef STEP
  #undef ENDW
  {auto rr=__builtin_amdgcn_permlane32_swap(__float_as_uint(l_reg),__float_as_uint(l_reg),false,false);l_reg=__uint_as_float(rr[0])+__uint_as_float(rr[1]);}
  float*xt=(float*)(shm+LDS_BYTES)+wid*128;
  const int nsel=(kvb<3)?kvb:3;
  if(MODE==0){ const int qi=wid*QBLK+r32; const int dst=(qi<nvalid)?(int)(((rowbase+(qent>>2))*NHEAD+h)*3+(qent&3)):-1;
    if(hi==0){ wsf[32+r32]=__builtin_amdgcn_rcpf(l_reg); ((int*)xt)[r32]=dst; if(dst>=0){ PML[(long)dst*2]=mhat; PML[(long)dst*2+1]=l_reg; } } }
  else { if(hi==0){ const long pb=((rowbase+q0+wid*QBLK+r32)*NHEAD+h)*3; float pm[3],pl[3]; float M=mhat;
      #pragma unroll
      for(int s_=0;s_<3;++s_){ pm[s_]=0.f; pl[s_]=0.f; if(s_<nsel){ pm[s_]=PML[(pb+s_)*2]; pl[s_]=PML[(pb+s_)*2+1]; M=__builtin_fmaxf(M,pm[s_]); } }
      const float aown=__builtin_amdgcn_exp2f(mhat-M); float L=aown*l_reg; float as_[3];
      #pragma unroll
      for(int s_=0;s_<3;++s_){ as_[s_]=(s_<nsel)?__builtin_amdgcn_exp2f(pm[s_]-M)*pl[s_]:0.f; L+=as_[s_]; }
      const float rL=__builtin_amdgcn_rcpf(L); wsf[32+r32]=aown*rL;
      #pragma unroll
      for(int s_=0;s_<3;++s_) xt[s_*32+r32]=as_[s_]*rL; } }
  asm volatile("s_waitcnt lgkmcnt(0)":::"memory");
  float rli[16];
  #pragma unroll
  for(int r=0;r<16;++r)rli[r]=wsf[32+crow(r,hi)];
  { bf16*stg=(bf16*)(shm+LDS_OST)+wid*2048;
    #pragma unroll
    for(int r=0;r<16;++r){const int orow=crow(r,hi);
      #pragma unroll
      for(int d0=0;d0<2;++d0)stg[orow*64+d0*32+r32]=__float2bfloat16(o[d0][r]*rli[r]);}
    asm volatile("s_waitcnt lgkmcnt(0)":::"memory");
    if(MODE==0){
      #pragma unroll
      for(int i=0;i<4;++i){const int row=i*8+(lane>>3),ch=lane&7; const u32x4 v=*(const u32x4*)(stg+row*64+ch*8); const int dst=((const int*)xt)[row];
        if(dst>=0) ATTN_STORE16(PO+(long)dst*64+ch*8,v);} }
    else { bf16*Ow=O+(rowbase+q0+wid*QBLK)*OPITCH+h*D;
      #pragma unroll
      for(int i=0;i<4;++i){const int row=i*8+(lane>>3),ch=lane&7; const u32x4 v=*(const u32x4*)(stg+row*64+ch*8);
        float f[8]; { const unsigned vw[4]={v.x,v.y,v.z,v.w};
          #pragma unroll
          for(int j=0;j<4;++j){ f[2*j]=__uint_as_float(vw[j]<<16); f[2*j+1]=__uint_as_float(vw[j]&0xffff0000u); } }
        const long pb=((rowbase+q0+wid*QBLK+row)*NHEAD+h)*3;
        #pragma unroll
        for(int s_=0;s_<3;++s_) if(s_<nsel){ const float c_=xt[s_*32+row]; const u32x4 pv=*(const u32x4*)(PO+(pb+s_)*64+ch*8); const unsigned pw[4]={pv.x,pv.y,pv.z,pv.w};
          #pragma unroll
          for(int j=0;j<4;++j){ f[2*j]+=c_*__uint_as_float(pw[j]<<16); f[2*j+1]+=c_*__uint_as_float(pw[j]&0xffff0000u); } }
        { int w0_=0,w1_=0; w0_=__builtin_amdgcn_cvt_pk_fp8_f32(f[0],f[1],w0_,false); w0_=__builtin_amdgcn_cvt_pk_fp8_f32(f[2],f[3],w0_,true); w1_=__builtin_amdgcn_cvt_pk_fp8_f32(f[4],f[5],w1_,false); w1_=__builtin_amdgcn_cvt_pk_fp8_f32(f[6],f[7],w1_,true);
          typedef unsigned u32x2_t __attribute__((ext_vector_type(2)));
          *(u32x2_t*)((unsigned char*)O+((rowbase+q0+wid*QBLK+row)*OPITCH+h*D+ch*8))=(u32x2_t){(unsigned)w0_,(unsigned)w1_}; } } } }
  asm volatile("s_waitcnt lgkmcnt(0)\n\ts_barrier":::"memory");
  #undef DMA_K
  #undef DMA_V
  #undef CMASK
  #undef START
  #undef RESC
  #undef ROT
}
constexpr int ATTN_LDS_BYTES=LDS_BYTES+8*128*4;
#undef SBAR
#undef WAIT_BAR
}

constexpr int NWAVES = 8, NTHR = 512;
constexpr int T_TOK = 65536, SEQ = 8192, NBATCH = 8, DM = 1024, DEPTH = 2;
constexpr int PMP = 1792;
constexpr int GLP = 3072;
constexpr int D_IN = 5120, NEXP = 64, NEXP1 = 65, TOPK = 6, DEXP = 256;
constexpr float EPS = 1e-6f;
constexpr int MAXROWS = 1600 * 256 + T_TOK;
constexpr size_t MiB = 1u << 20;
constexpr size_t WS_CTL = 0, CTL_ZERO_BYTES = 1 * MiB;
constexpr size_t WS_MOD = 1 * MiB;
constexpr size_t WS_KTAB = 2 * MiB;
constexpr size_t WS_A64 = 3 * MiB;
constexpr size_t WS_KMEAN = 4 * MiB;
constexpr size_t WS_WGU = 16 * MiB;
constexpr size_t WS_WD = 81 * MiB;
constexpr size_t WS_WR = WS_WD + (size_t)NEXP1 * 1024 * 256 * 2;
constexpr size_t WS_WIN = 114 * MiB;
constexpr size_t WS_WIN8 = 118 * MiB;
constexpr size_t WS_H8 = 820 * MiB;
constexpr size_t WS_WGLU = 124 * MiB;
constexpr size_t WS_WHO = 125 * MiB;
constexpr size_t WS_WMO = WS_WHO + 512 * 1024;
constexpr size_t WS_WRB = 9 * MiB;
constexpr size_t WS_RPART = 13 * MiB;
constexpr size_t WS_RSTD = 13 * MiB + 65536;
constexpr size_t WS_WOUT = 126 * MiB;
constexpr size_t WS_BT1 = 128 * MiB;
constexpr size_t WS_BT2 = 132 * MiB;
constexpr size_t WS_GL = 168 * MiB;
constexpr size_t WS_PM = 552 * MiB;
constexpr size_t WS_UG = 776 * MiB;
constexpr size_t WS_SLOC = 808 * MiB;
constexpr size_t WS_S0 = 816 * MiB;
constexpr size_t WS_HST = 820 * MiB;
constexpr size_t WS_HSEG = 888 * MiB;
constexpr size_t WS_HLAST = 884 * MiB;
constexpr size_t WS_H = 896 * MiB;
constexpr size_t WS_YS5 = 904 * MiB;
constexpr size_t WS_OH = 936 * MiB;
constexpr size_t WS_OM = 968 * MiB;
constexpr size_t WS_MERGED = 776 * MiB;
constexpr size_t WS_QL = 1000 * MiB;
constexpr size_t WS_PO = 16 * MiB;
constexpr size_t WS_PML = 1016 * MiB;
constexpr size_t WS_H2 = 114 * MiB;
constexpr size_t WS_H2_8 = 242 * MiB;
constexpr size_t WS_LOGITS = 49 * MiB;
constexpr size_t WS_TOPI = 65 * MiB;
constexpr size_t WS_TOPW = WS_TOPI + (size_t)T_TOK * 6 * 4;
constexpr size_t WS_POS = WS_TOPW + (size_t)T_TOK * 6 * 4;
constexpr size_t WS_ROWTOK = WS_POS + (size_t)T_TOK * 6 * 4;
constexpr size_t WS_ROWW = WS_ROWTOK + (size_t)MAXROWS * 4;
constexpr size_t WS_ROWDST = WS_ROWW + (size_t)MAXROWS * 4;
constexpr size_t WS_Y = 306 * MiB;
constexpr size_t WS_HID = 770 * MiB;
constexpr size_t WS_END = WS_HID + (size_t)MAXROWS * 256 * 2;
static_assert(WS_ROWDST + (size_t)MAXROWS * 4 <= 81 * MiB && (size_t)T_TOK * 7 + 1 <= (size_t)MAXROWS && WS_WGU + (size_t)65 * 512 * 1024 <= WS_LOGITS && WS_H2_8 + (size_t)T_TOK * 1024 <= WS_Y && WS_Y + (size_t)MAXROWS * 1024 <= WS_HID && WS_END <= 1024 * MiB, "ws map");
static_assert(WS_WR + 256 * 1024 * 2 <= WS_WIN && WS_BT2 + (size_t)16 * 1024 * 1152 * 2 <= WS_GL, "ws map 2");
constexpr int CW_TMO = 0;
constexpr int CW_CNT = 1024;
constexpr int CW_CUR = 1280;
constexpr int CW_QC = 2048;
constexpr int CW_BAR = 4096;
constexpr int RING_OFF = 0, RING_BYTES = 131072;
constexpr int LDSCTL_OFF = RING_BYTES, MISC_OFF = LDSCTL_OFF + 1024;
constexpr int LDS_BYTES = 147456;

#define XB_TMO      128
#define XB_XCNT(j)  (256  + 64 * (j))
#define XB_XSUB(j)  (1280 + 64 * (j))
#define XB_XGEN(j)  (2304 + 64 * (j))
#define XB_TOP      3328
#define XB_TOPGEN   3392
#define XCD_BAR_WORDS 3456
#define XB_SPIN_CAP (1u << 18)

__device__ __forceinline__ unsigned xb_ld(unsigned* p)              { return __hip_atomic_load(p, __ATOMIC_RELAXED, __HIP_MEMORY_SCOPE_AGENT); }
__device__ __forceinline__ unsigned xb_add(unsigned* p, unsigned v) { return __hip_atomic_fetch_add(p, v, __ATOMIC_RELAXED, __HIP_MEMORY_SCOPE_AGENT); }
__device__ __forceinline__ unsigned xb_xcc_id() { return (unsigned)__builtin_amdgcn_s_getreg((3 << 11) | 20) & 0xFu; }
#define XB_SPIN(cond, bar) do { unsigned _sp = 0; while (cond) { __builtin_amdgcn_s_sleep(1); \
    if ((++_sp & 255u) == 0u) { if (xb_ld(&(bar)[XB_TMO])) break; if (_sp > XB_SPIN_CAP) { atomicAdd(&(bar)[XB_TMO], 1u); break; } } } } while (0)

struct XcdBarrier {
    unsigned* bar; unsigned x;
    volatile LAS unsigned* st;
};

__device__ __forceinline__ XcdBarrier xcd_barrier_post(unsigned* bar, volatile LAS unsigned* st) {
    XcdBarrier b; b.bar = bar; b.x = xb_xcc_id(); b.st = st;
    if (threadIdx.x == 0) (void)xb_add(&bar[XB_XCNT(b.x)], 1u);
    return b;
}
__device__ __forceinline__ void xcd_barrier_complete(unsigned* bar, unsigned x, unsigned& nloc, unsigned& nx) {
    const unsigned G = gridDim.x * gridDim.y * gridDim.z;
    unsigned sum, cnt, mine, sp = 0u;
    for (;;) {
        sum = 0u; cnt = 0u; mine = 0u;
#pragma unroll
        for (unsigned j = 0; j < 16; ++j) { const unsigned c = xb_ld(&bar[XB_XCNT(j)]); sum += c; cnt += (c > 0u) ? 1u : 0u; mine = (j == x) ? c : mine; }
        if (sum == G) break;
        __builtin_amdgcn_s_sleep(1);
        if ((++sp & 255u) == 0u) { if (xb_ld(&bar[XB_TMO])) break; if (sp > XB_SPIN_CAP) { atomicAdd(&bar[XB_TMO], 1u); break; } }
    }
    nloc = mine > 0u ? mine : 1u; nx = cnt > 0u ? cnt : 1u;
}

__device__ __forceinline__ void xcd_barrier(const XcdBarrier& b) {
    asm volatile("s_waitcnt vmcnt(0)" ::: "memory");
    __syncthreads();
    if (threadIdx.x == 0) {
        unsigned* bar = b.bar;
        __builtin_amdgcn_s_waitcnt(0);
        unsigned nloc = b.st[0], nx = b.st[1];
        if (nloc == 0u) { xcd_barrier_complete(bar, b.x, nloc, nx); b.st[0] = nloc; b.st[1] = nx; }
        const unsigned old = xb_add(&bar[XB_XSUB(b.x)], 1u);
        const unsigned gen = old / nloc;
        if (old + 1u == (gen + 1u) * nloc) {
            __builtin_amdgcn_fence(__ATOMIC_RELEASE, "agent");
            asm volatile("s_waitcnt vmcnt(0)" ::: "memory");
            const unsigned og = xb_add(&bar[XB_TOP], 1u);
            const unsigned tg = og / nx;
            if (og + 1u == (tg + 1u) * nx) xb_add(&bar[XB_TOPGEN], 1u);
            else XB_SPIN(xb_ld(&bar[XB_TOPGEN]) == tg, bar);
            __builtin_amdgcn_fence(__ATOMIC_ACQUIRE, "agent");
            xb_add(&bar[XB_XGEN(b.x)], 1u);
            asm volatile("s_waitcnt vmcnt(0)" ::: "memory");
        } else {
            XB_SPIN(xb_ld(&bar[XB_XGEN(b.x)]) == gen, bar);
            __builtin_amdgcn_fence(__ATOMIC_ACQUIRE, "agent");
            asm volatile("s_waitcnt vmcnt(0)" ::: "memory");
        }
    }
    __syncthreads();
}


struct Frame {
    LAS unsigned char* lds; unsigned char* ldsg;
    volatile LAS unsigned* MISC;
    gu32* ctl;
    unsigned char* ws;
    int tid, lane, wave, vcu, G;
    float* out;
};
constexpr int PTR_OFF = 131072 + 2048;
DI const float* inp(const Frame& F, int i) { const LAS unsigned* p = (const LAS unsigned*)(F.lds + PTR_OFF) + 2 * i; const unsigned lo = __builtin_amdgcn_readfirstlane(p[0]), hi = __builtin_amdgcn_readfirstlane(p[1]); return (const float*)(GAS const float*)(((unsigned long long)hi << 32) | lo); }
DI float wave_sum(float v) {
#pragma unroll
    for (int o = 1; o < 64; o <<= 1) v += __shfl_xor(v, o);
    return v;
}
#define WGBAR() do { asm volatile("s_waitcnt vmcnt(0) lgkmcnt(0)" ::: "memory"); __builtin_amdgcn_s_barrier(); asm volatile("" ::: "memory"); } while (0)

enum { I_X = 0, I_C, I_ADAW, I_ADAB, I_N1G, I_WIN, I_LOGDT, I_LRE, I_LIM, I_BRE, I_BIM, I_CRE, I_CIM, I_SSMD, I_WGLU, I_LBL, I_HNG, I_HWO, I_MQG, I_MKG, I_MWO, I_WOUT, I_N2G,
       I_RW, I_RB, I_EWG, I_EWU, I_EWD, I_SWG, I_SWU, I_SWD };

DI int rowmap(int mode, int n) {
    if (mode == 0) return n;
    if (mode == 1) return (n < 1024) ? ((n >> 7) * 256 + (n & 127)) : (((n - 1024) >> 7) * 256 + 128 + ((n - 1024) & 127));
    if (mode == 2) return (n >> 7) * 256 + (n & 127);
    return (n >> 7) * 256 + 128 + (n & 127);
}
template <bool WIDE>
DI void transpose_item(const float* W, int K, int N, int spitch, bf16* WT, int ldk, int mode, int fp8, LAS float* scr, int item, int lane) {
    const int nblk = N / 32, kb = item / nblk, nb = item % nblk, k0 = 64 * kb, n0 = 32 * nb;
    if constexpr (WIDE) {
    { int lq = lane; asm volatile("" : "+v"(lq));
      const int kr = lq >> 3, nc = (lq & 7) * 4; const GAS float* wp = (const GAS float*)W + (size_t)(k0 + kr) * spitch + n0 + nc; LAS float* d = scr + kr * 33 + nc;
#pragma unroll 1
      for (int hh = 0; hh < 2; ++hh) { f32x4 t[4];
#pragma unroll
        for (int i = 0; i < 4; ++i) t[i] = *(const GAS f32x4*)(wp + (size_t)(8 * (4 * hh + i)) * spitch);
#pragma unroll
        for (int i = 0; i < 4; ++i) { LAS float* dd = d + (8 * (4 * hh + i)) * 33; dd[0] = t[i].x; dd[1] = t[i].y; dd[2] = t[i].z; dd[3] = t[i].w; } } }
    } else {
#pragma unroll 8
    for (int i = 0; i < 32; ++i) { const int kk = 2 * i + (lane >> 5); scr[kk * 33 + (lane & 31)] = W[(size_t)(k0 + kk) * spitch + n0 + (lane & 31)]; }
    }
    LDS_WAIT(); asm volatile("" ::: "memory");
    const int c = lane & 7;
#pragma unroll
    for (int j = 0; j < 4; ++j) { const int n = (lane >> 3) + 8 * j; const LAS float* s = scr + (8 * c) * 33 + n;
        if (fp8) { int w0 = 0, w1 = 0; const float sc = (fp8 == 2) ? 1.0f : 64.0f;
            w0 = __builtin_amdgcn_cvt_pk_fp8_f32(s[0 * 33] * sc, s[1 * 33] * sc, w0, false); w0 = __builtin_amdgcn_cvt_pk_fp8_f32(s[2 * 33] * sc, s[3 * 33] * sc, w0, true);
            w1 = __builtin_amdgcn_cvt_pk_fp8_f32(s[4 * 33] * sc, s[5 * 33] * sc, w1, false); w1 = __builtin_amdgcn_cvt_pk_fp8_f32(s[6 * 33] * sc, s[7 * 33] * sc, w1, true);
            *(GAS u32x2*)((unsigned char*)WT + (size_t)rowmap(mode, n0 + n) * ldk + k0 + 8 * c) = (u32x2){(unsigned)w0, (unsigned)w1}; }
        else { u32x4 o; o.x = pk2(s[0 * 33], s[1 * 33]); o.y = pk2(s[2 * 33], s[3 * 33]); o.z = pk2(s[4 * 33], s[5 * 33]); o.w = pk2(s[6 * 33], s[7 * 33]);
        *(GAS u32x4*)(WT + (size_t)rowmap(mode, n0 + n) * ldk + k0 + 8 * c) = o; } }
    LDS_WAIT(); asm volatile("" ::: "memory");
}
struct TJob { const float* src; size_t sstride; int nb, K, N; bf16* dst; size_t dstride; int ldk, mode; int spitch, fp8; };
DI void tp_load(const float* W, int N, int spitch, int item, int lane, f32x4 (&t)[8]) {
    int lq = lane; asm volatile("" : "+v"(lq));
    const int nblk = N / 32, kb = item / nblk, nb = item % nblk, k0 = 64 * kb, n0 = 32 * nb, kr = lq >> 3, nc = (lq & 7) * 4;
    const GAS float* wp = (const GAS float*)W + (size_t)(k0 + kr) * spitch + n0 + nc;
#pragma unroll
    for (int i = 0; i < 8; ++i) t[i] = *(const GAS f32x4*)(wp + (size_t)(8 * i) * spitch);
}
DI void tp_stage(const f32x4 (&t)[8], LAS float* scr, int lane) {
    int lq = lane; asm volatile("" : "+v"(lq));
    const int kr = lq >> 3, nc = (lq & 7) * 4; LAS float* d = scr + kr * 33 + nc;
#pragma unroll
    for (int i = 0; i < 8; ++i) { LAS float* dd = d + (8 * i) * 33; dd[0] = t[i].x; dd[1] = t[i].y; dd[2] = t[i].z; dd[3] = t[i].w; }
}
DI void tp_emit(int N, bf16* WT, int ldk, int mode, int fp8, const LAS float* scr, int item, int lane) {
    const int nblk = N / 32, kb = item / nblk, nb = item % nblk, k0 = 64 * kb, n0 = 32 * nb, c = lane & 7;
#pragma unroll
    for (int j = 0; j < 4; ++j) { const int n = (lane >> 3) + 8 * j; const LAS float* s = scr + (8 * c) * 33 + n;
        if (fp8) { int w0 = 0, w1 = 0; const float sc = (fp8 == 2) ? 1.0f : 64.0f;
            w0 = __builtin_amdgcn_cvt_pk_fp8_f32(s[0 * 33] * sc, s[1 * 33] * sc, w0, false); w0 = __builtin_amdgcn_cvt_pk_fp8_f32(s[2 * 33] * sc, s[3 * 33] * sc, w0, true);
            w1 = __builtin_amdgcn_cvt_pk_fp8_f32(s[4 * 33] * sc, s[5 * 33] * sc, w1, false); w1 = __builtin_amdgcn_cvt_pk_fp8_f32(s[6 * 33] * sc, s[7 * 33] * sc, w1, true);
            *(GAS u32x2*)((unsigned char*)WT + (size_t)rowmap(mode, n0 + n) * ldk + k0 + 8 * c) = (u32x2){(unsigned)w0, (unsigned)w1}; }
        else { u32x4 o; o.x = pk2(s[0 * 33], s[1 * 33]); o.y = pk2(s[2 * 33], s[3 * 33]); o.z = pk2(s[4 * 33], s[5 * 33]); o.w = pk2(s[6 * 33], s[7 * 33]);
        *(GAS u32x4*)(WT + (size_t)rowmap(mode, n0 + n) * ldk + k0 + 8 * c) = o; } }
}
template <bool WIDE>
DI void p0_convert(Frame& F, int l, unsigned jmask) {
    LAS float* scr = (LAS float*)(F.lds + RING_OFF + F.wave * 16384);
    const int gw = F.vcu * NWAVES + F.wave, NGW = F.G * NWAVES;
    unsigned char* ws = F.ws;
    int base = 0;
    auto run = [&](const TJob jb) {
        const int per = (jb.K / 64) * (jb.N / 32), tot = per * jb.nb;
        int first = gw - (base % NGW); if (first < 0) first += NGW;
        if constexpr (WIDE) { f32x4 t[8]; int it = first;
            if (it < tot) tp_load(jb.src + (size_t)(it / per) * jb.sstride, jb.N, jb.spitch, it % per, F.lane, t);
            for (; it < tot; it += NGW) { const int b = it / per, r = it % per, itn = it + NGW;
                tp_stage(t, scr, F.lane); LDS_WAIT(); asm volatile("" ::: "memory");
                if (itn < tot) tp_load(jb.src + (size_t)(itn / per) * jb.sstride, jb.N, jb.spitch, itn % per, F.lane, t);
                tp_emit(jb.N, jb.dst + (size_t)b * jb.dstride, jb.ldk, jb.mode, jb.fp8, scr, r, F.lane);
                LDS_WAIT(); asm volatile("" ::: "memory"); } }
        else {
        for (int it = first; it < tot; it += NGW) { const int b = it / per, r = it % per;
            transpose_item<WIDE>(jb.src + (size_t)b * jb.sstride, jb.K, jb.N, jb.spitch, jb.dst + (size_t)b * jb.dstride, jb.ldk, jb.mode, jb.fp8, scr, r, F.lane); } }
        base += tot;
    };
    if ((jmask >> 0) & 1u) run(TJob{inp(F, I_WIN) + (size_t)l * 1024 * D_IN, 0, 1, 1024, 2048, (bf16*)(ws + WS_WIN), 0, 1024, 0, D_IN, 0});
    if ((jmask >> 1) & 1u) run(TJob{inp(F, I_WGLU) + (size_t)l * 256 * 2048, 0, 1, 256, 2048, (bf16*)(ws + WS_WGLU), 0, 256, 1, 2048, 2});
    if ((jmask >> 2) & 1u) run(TJob{inp(F, I_HWO) + (size_t)l * 256 * 1024, 0, 1, 256, 1024, (bf16*)(ws + WS_WHO), 0, 256, 0, 1024, 2});
    if ((jmask >> 3) & 1u) run(TJob{inp(F, I_MWO) + (size_t)l * 256 * 1024, 0, 1, 256, 1024, (bf16*)(ws + WS_WMO), 0, 256, 0, 1024, 2});
    if ((jmask >> 4) & 1u) run(TJob{inp(F, I_WOUT) + (size_t)l * 1024 * 1024, 0, 1, 1024, 1024, (bf16*)(ws + WS_WOUT), 0, 1024, 0, 1024, 1});
    if ((jmask >> 5) & 1u) run(TJob{inp(F, I_RW) + (size_t)l * 1024 * 64, 0, 1, 1024, 64, (bf16*)(ws + WS_WR), 0, 1024, 0, 64, 0});
    if ((jmask >> 6) & 1u) run(TJob{inp(F, I_EWG) + (size_t)l * NEXP * 1024 * 256, (size_t)1024 * 256, NEXP, 1024, 256, (bf16*)(ws + WS_WGU), (size_t)512 * 512, 1024, 2, 256, 1});
    if ((jmask >> 7) & 1u) run(TJob{inp(F, I_EWU) + (size_t)l * NEXP * 1024 * 256, (size_t)1024 * 256, NEXP, 1024, 256, (bf16*)(ws + WS_WGU), (size_t)512 * 512, 1024, 3, 256, 1});
    if ((jmask >> 8) & 1u) run(TJob{inp(F, I_EWD) + (size_t)l * NEXP * 256 * 1024, (size_t)256 * 1024, NEXP, 256, 1024, (bf16*)(ws + WS_WD), (size_t)1024 * 128, 256, 0, 1024, 2});
    if ((jmask >> 9) & 1u) run(TJob{inp(F, I_SWG) + (size_t)l * 1024 * 256, 0, 1, 1024, 256, (bf16*)(ws + WS_WGU) + (size_t)NEXP * 512 * 512, 0, 1024, 2, 256, 1});
    if ((jmask >> 10) & 1u) run(TJob{inp(F, I_SWU) + (size_t)l * 1024 * 256, 0, 1, 1024, 256, (bf16*)(ws + WS_WGU) + (size_t)NEXP * 512 * 512, 0, 1024, 3, 256, 1});
    if ((jmask >> 11) & 1u) run(TJob{inp(F, I_SWD) + (size_t)l * 256 * 1024, 0, 1, 256, 1024, (bf16*)(ws + WS_WD) + (size_t)NEXP * 1024 * 128, 0, 256, 0, 1024, 2});
    if ((jmask >> 12) & 1u) run(TJob{inp(F, I_WIN) + (size_t)l * 1024 * D_IN, 0, 1, 1024, 5120, (bf16*)(ws + WS_WIN8), 0, 1024, 0, D_IN, 1});
}

DI void p0_adaln(Frame& F) {
    LAS float* cond = (LAS float*)(F.lds + RING_OFF);
    LAS float* red = (LAS float*)(F.lds + RING_OFF + 32768);
    const float* c = inp(F, I_C);
    for (int i = F.tid; i < NBATCH * DM; i += NTHR) cond[i] = fsilu(c[i]);
    WGBAR();
    float* MOD = (float*)(F.ws + WS_MOD);
    const int col = F.tid & 63, kc = F.tid >> 6;
    for (int u = F.vcu; u < DEPTH * 96; u += F.G) {
        const int l = u / 96, n0 = (u % 96) * 64;
        const float* W = inp(F, I_ADAW) + (size_t)l * DM * 6144 + n0 + col;
        float a[8];
#pragma unroll
        for (int b = 0; b < 8; ++b) a[b] = 0.f;
        for (int k0 = kc * 128; k0 < kc * 128 + 128; k0 += 16) { float w16[16];
#pragma unroll
          for (int i = 0; i < 16; ++i) w16[i] = W[(size_t)(k0 + i) * 6144];
#pragma unroll
          for (int i = 0; i < 16; ++i) { const int k = k0 + i; const float w = w16[i];
#pragma unroll
            for (int b = 0; b < 8; ++b) a[b] += w * cond[b * DM + k]; } }
#pragma unroll
        for (int b = 0; b < 8; ++b) red[(kc * 8 + b) * 64 + col] = a[b];
        WGBAR();
        { const int b = F.tid >> 6; float s = 0.f;
#pragma unroll
          for (int q = 0; q < 8; ++q) s += red[(q * 8 + b) * 64 + col];
          MOD[((size_t)l * 8 + b) * 6144 + n0 + col] = s + inp(F, I_ADAB)[(size_t)l * 6144 + n0 + col]; }
        WGBAR();
    }
}

DI void cis(float ang, float& c, float& s) { s = sinf(ang); c = cosf(ang); }

DI void p0_s5tab(Frame& F, int l) {
    LAS float* L = (LAS float*)(F.lds + RING_OFF);
    constexpr int US = 4608;
    float* KTAB = (float*)(F.ws + WS_KTAB); float* A64 = (float*)(F.ws + WS_A64);
    bf16* BT1 = (bf16*)(F.ws + WS_BT1); bf16* BT2 = (bf16*)(F.ws + WS_BT2);
    const float* cre = inp(F, I_CRE) + (size_t)l * 16 * 16 * 64; const float* cim = inp(F, I_CIM) + (size_t)l * 16 * 16 * 64;
    const float* bre = inp(F, I_BRE) + (size_t)l * 16 * 64 * 16; const float* bim = inp(F, I_BIM) + (size_t)l * 16 * 64 * 16;
    for (int ub = F.vcu; ub < 1024; ub += 4 * F.G) {
    if (F.tid < 256 && ub + (F.tid >> 6) * F.G < 1024) { const int k = F.tid >> 6, p = F.tid & 63, uu = ub + k * F.G, g = uu >> 6, j = uu & 63; LAS float* U = L + k * US;
        const float dt = expf(inp(F, I_LOGDT)[l * 16 + g]); const float lr = inp(F, I_LRE)[(l * 16 + g) * 64 + p], li = inp(F, I_LIM)[(l * 16 + g) * 64 + p];
        float cr, sr; const float mag = expf(lr * dt); cis(li * dt, cr, sr); const float ar = mag * cr, ai = mag * sr;
        const float inv = 1.0f / (lr * lr + li * li);
        U[384 + 2 * p] = ((ar - 1.0f) * lr + ai * li) * inv; U[384 + 2 * p + 1] = (ai * lr - (ar - 1.0f) * li) * inv;
        float m, c2, s2;
        m = expf((float)j * lr * dt); cis((float)j * (li * dt), c2, s2); U[2 * p] = m * c2; U[2 * p + 1] = m * s2;
        m = expf((float)(j + 1) * lr * dt); cis((float)(j + 1) * (li * dt), c2, s2); U[128 + 2 * p] = m * c2; U[128 + 2 * p + 1] = m * s2;
        m = expf((float)(63 - j) * lr * dt); cis((float)(63 - j) * (li * dt), c2, s2); U[256 + 2 * p] = m * c2; U[256 + 2 * p + 1] = m * s2;
        if (j == 0) { m = expf(64.0f * lr * dt); cis(64.0f * (li * dt), c2, s2); A64[(g * 64 + p) * 2] = m * c2; A64[(g * 64 + p) * 2 + 1] = m * s2; }
    }
    WGBAR();
    for (int ee = F.tid; ee < 4096; ee += NTHR) { const int k = ee >> 10, e = ee & 1023, uu = ub + k * F.G, g = uu >> 6, p = e >> 4, h = e & 15; LAS float* U = L + k * US; if (uu >= 1024) continue;
        const float br = bre[(g * 64 + p) * 16 + h], bi = bim[(g * 64 + p) * 16 + h], cr = U[384 + 2 * p], ci = U[384 + 2 * p + 1];
        const float xr = cr * br - ci * bi, xi = cr * bi + ci * br; U[512 + 2 * e] = xr; U[512 + 2 * e + 1] = xi;
        const float ar = U[2 * p], ai = U[2 * p + 1]; U[2560 + 2 * e] = ar * xr - ai * xi; U[2560 + 2 * e + 1] = ar * xi + ai * xr; }
    WGBAR();
    for (int it = F.tid; it < 1024; it += NTHR) { const int k = it >> 8, t1 = it & 255, uu = ub + k * F.G, g = uu >> 6, j = uu & 63, hp = t1 >> 4, h = t1 & 15; const LAS float* Z = L + k * US + 2560; float s = 0.f; if (uu >= 1024) continue;
        for (int p = 0; p < 64; ++p) s += cre[(g * 16 + hp) * 64 + p] * Z[2 * (p * 16 + h)] - cim[(g * 16 + hp) * 64 + p] * Z[2 * (p * 16 + h) + 1];
        KTAB[((g * 64 + j) * 16 + hp) * 16 + h] = s; }
    for (int ee = F.tid; ee < 8192; ee += NTHR) { const int k = ee >> 11, e = ee & 2047, uu = ub + k * F.G, g = uu >> 6, j = uu & 63, hp = e >> 7, q = e & 127, p = q & 63; const LAS float* AJ1 = L + k * US + 128; if (uu >= 1024) continue;
        const float c_r = cre[(g * 16 + hp) * 64 + p], c_i = cim[(g * 16 + hp) * 64 + p], ar = AJ1[2 * p], ai = AJ1[2 * p + 1];
        const float v = (q < 64) ? (c_r * ar - c_i * ai) : -(c_r * ai + c_i * ar);
        BT2[((size_t)(g * 1024 + j * 16 + hp)) * 1152 + 1024 + q] = (bf16)f2bf(v); }
    for (int ee = F.tid; ee < 8192; ee += NTHR) { const int k = ee >> 11, e = ee & 2047, uu = ub + k * F.G, g = uu >> 6, j = uu & 63, q = e >> 4, h = e & 15, p = q & 63; const LAS float* U = L + k * US; if (uu >= 1024) continue;
        const float ar = U[256 + 2 * p], ai = U[256 + 2 * p + 1], xr = U[512 + 2 * (p * 16 + h)], xi = U[512 + 2 * (p * 16 + h) + 1];
        const float v = (q < 64) ? (ar * xr - ai * xi) : (ar * xi + ai * xr);
        BT1[((size_t)(g * 128 + q)) * 1024 + j * 16 + h] = (bf16)f2bf(v); }
    WGBAR();
    }
}
DI void p1_s5fill(Frame& F) {
    const float* KTAB = (const float*)(F.ws + WS_KTAB); bf16* BT2 = (bf16*)(F.ws + WS_BT2);
    const size_t gt = (size_t)F.vcu * NTHR + F.tid, GT = (size_t)F.G * NTHR;
    for (size_t it = gt; it < (size_t)16 * 1024 * 128; it += GT) {
        const int kc = (int)(it & 127), n = (int)((it >> 7) & 1023), g = (int)(it >> 17);
        const int tau = n >> 4, hp = n & 15, sigma = kc >> 1, h0 = (kc & 1) * 8;
        if (sigma > (tau | 15)) continue;
        u32x4 o = (u32x4){0u, 0u, 0u, 0u};
        if (sigma <= tau) { const float* s = KTAB + ((g * 64 + (tau - sigma)) * 16 + hp) * 16 + h0;
            const f32x4 a = *(const f32x4*)s, b = *(const f32x4*)(s + 4); o.x = pk2(a.x, a.y); o.y = pk2(a.z, a.w); o.z = pk2(b.x, b.y); o.w = pk2(b.z, b.w); }
        *(u32x4*)(BT2 + ((size_t)(g * 1024 + n)) * 1152 + kc * 8) = o;
    }
}

constexpr int XPITCH = 2048;
template <bool IN16>
DI void norm_load(const void* X, int m, int lane, float (&v)[2][8]) {
#pragma unroll
    for (int j = 0; j < 2; ++j) { const int col = 8 * lane + 512 * j;
        if (IN16) unpack8(*(const GAS u32x4*)((const bf16*)X + (size_t)m * XPITCH + col), v[j]);
        else { const GAS f32x4* p = (const GAS f32x4*)((const float*)X + (size_t)m * DM + col); const f32x4 a = p[0], b = p[1]; v[j][0] = a.x; v[j][1] = a.y; v[j][2] = a.z; v[j][3] = a.w; v[j][4] = b.x; v[j][5] = b.y; v[j][6] = b.z; v[j][7] = b.w; } }
}
template <bool IN16, int NR>
DI void norm_rows(Frame& F, const void* X, const float* gain, const float* shift, const float* scale, bf16* O, unsigned char* O8, float* RSTD = nullptr) {
    const int gw = F.vcu * NWAVES + F.wave, NGW = F.G * NWAVES;
    for (int m = gw; m < T_TOK; m += NR * NGW) {
        float v[NR][2][8]; float rstd[NR];
#pragma unroll
        for (int r = 0; r < NR; ++r) { const int mm = (m + r * NGW < T_TOK) ? m + r * NGW : m; norm_load<IN16>(X, mm, F.lane, v[r]); }
#pragma unroll
        for (int r = 0; r < NR; ++r) { float s2 = 0.f;
#pragma unroll
            for (int j = 0; j < 2; ++j)
#pragma unroll
                for (int k = 0; k < 8; ++k) s2 += v[r][j][k] * v[r][j][k];
            rstd[r] = 1.0f / sqrtf(wave_sum(s2) * (1.0f / DM) + EPS); }
#pragma unroll
        for (int r = 0; r < NR; ++r) { const int mm = m + r * NGW; if (mm >= T_TOK) break; const int b = mm >> 13; const float rs = rstd[r]; if (RSTD && F.lane == 0) RSTD[mm] = rs;
#pragma unroll
            for (int j = 0; j < 2; ++j) { const int col = 8 * F.lane + 512 * j; float y[8];
#pragma unroll
                for (int h = 0; h < 2; ++h) { const f32x4 g = *(const f32x4*)(gain + col + 4 * h), sh = *(const f32x4*)(shift + b * 6144 + col + 4 * h), sc = *(const f32x4*)(scale + b * 6144 + col + 4 * h);
                    const float* xv = v[r][j];
                    y[4 * h + 0] = xv[4 * h + 0] * rs * g.x * (sc.x + 1.0f) + sh.x; y[4 * h + 1] = xv[4 * h + 1] * rs * g.y * (sc.y + 1.0f) + sh.y;
                    y[4 * h + 2] = xv[4 * h + 2] * rs * g.z * (sc.z + 1.0f) + sh.z; y[4 * h + 3] = xv[4 * h + 3] * rs * g.w * (sc.w + 1.0f) + sh.w; }
                u32x4 w; if (O) { w.x = pk2(y[0], y[1]); w.y = pk2(y[2], y[3]); w.z = pk2(y[4], y[5]); w.w = pk2(y[6], y[7]); *(GAS u32x4*)(O + (size_t)mm * DM + col) = w; }
                if (O8) { int q0 = 0, q1 = 0; q0 = __builtin_amdgcn_cvt_pk_fp8_f32(y[0], y[1], q0, false); q0 = __builtin_amdgcn_cvt_pk_fp8_f32(y[2], y[3], q0, true);
                    q1 = __builtin_amdgcn_cvt_pk_fp8_f32(y[4], y[5], q1, false); q1 = __builtin_amdgcn_cvt_pk_fp8_f32(y[6], y[7], q1, true);
                    *(GAS u32x2*)(O8 + (size_t)mm * DM + col) = (u32x2){(unsigned)q0, (unsigned)q1}; } } }
    }
}

DI void router_prep(Frame& F, int l, const float* shift2, const float* scale2) {
    const float* Wr = inp(F, I_RW) + (size_t)l * 1024 * 64; const float* g2 = inp(F, I_N2G) + l * DM;
    bf16* WRB = (bf16*)(F.ws + WS_WRB); float* PART = (float*)(F.ws + WS_RPART);
    for (int it = F.vcu * NTHR + F.tid; it < 8 * 128 * 64; it += F.G * NTHR) { const int e = it & 63, kc = (it >> 6) & 127, b = it >> 13; float w[8];
#pragma unroll
        for (int j = 0; j < 8; ++j) { const int k = kc * 8 + j; w[j] = Wr[(size_t)k * 64 + e] * g2[k] * (1.0f + scale2[b * 6144 + k]); }
        *(u32x4*)(WRB + ((size_t)(b * 256 + e)) * 1024 + kc * 8) = pack8(w); }
    LAS float* red = (LAS float*)(F.lds + RING_OFF);
    for (int u = F.vcu; u < 64; u += F.G) { const int b = u >> 3, kseg = u & 7, e = F.tid & 63, kk = F.tid >> 6; float s = 0.f;
#pragma unroll
        for (int i = 0; i < 16; ++i) { const int k = kseg * 128 + kk * 16 + i; s += shift2[b * 6144 + k] * Wr[(size_t)k * 64 + e]; }
        red[kk * 64 + e] = s;
        WGBAR();
        if (F.tid < 64) { float t = 0.f;
#pragma unroll
            for (int q = 0; q < 8; ++q) t += red[q * 64 + F.tid];
            PART[(b * 8 + kseg) * 64 + F.tid] = t; }
        WGBAR(); }
}

typedef const f32x4 (&AccRef)[2][2][4][2];
DI unsigned fp8x4(float a, float b, float c, float d) { int w = __builtin_bit_cast(int, a); w = __builtin_amdgcn_cvt_pk_fp8_f32(a, b, w, false); w = __builtin_amdgcn_cvt_pk_fp8_f32(c, d, w, true); return (unsigned)w; }
DI void unfp8x4(unsigned w, float (&o)[4]) { const f32x2 lo = __builtin_amdgcn_cvt_pk_f32_fp8((int)w, false), hi = __builtin_amdgcn_cvt_pk_f32_fp8((int)w, true); o[0] = lo.x; o[1] = lo.y; o[2] = hi.x; o[3] = hi.y; }
DI void plain_avoff(int lda, const int (&R)[2], const int (&C)[2], unsigned (&v)[2][2]) {
#pragma unroll
    for (int h = 0; h < 2; ++h)
#pragma unroll
        for (int i = 0; i < 2; ++i) v[h][i] = (unsigned)(((h * 128 + R[i]) * lda + C[i]) * 2);
}
DI void acc8(AccRef acc, int ai, int bj, int m, float (&v)[8]) {
    const f32x4 a = acc[ai][bj][m][0], b = acc[ai][bj][m][1]; v[0] = a.x; v[1] = a.y; v[2] = a.z; v[3] = a.w; v[4] = b.x; v[5] = b.y; v[6] = b.z; v[7] = b.w;
}
struct PlainBase {
    static constexpr bool SEG2 = false, GATHER = false, MIXED = false;
    const char* A; const char* B; int lda, lda2, ldb, K; pg8::TileOrder ord;
    DI void setup(const void* A_, int lda_, const void* B_, int K_, int M, int N, int G, int c) { A = (const char*)A_; B = (const char*)B_; lda = lda_; lda2 = lda_; ldb = K_; K = K_; ord.init(M, N, G, c); }
    DI bool next(int i, pg8::GU& u) const { int pm, pn; if (!ord.next(i, pm, pn)) return false;
        u.pm = pm; u.pn = pn; u.e = 0; u.A = A + (size_t)pm * 256 * lda * 2; u.A2 = u.A; u.B = B + (size_t)pn * 256 * ldb * 2; u.nt1 = u.nt = K / 64; u.kstepA = 128; u.kstepA2 = 128; u.bjump = 0; u.lda = lda; u.lda2 = lda; return true; }
};
struct PolWin : PlainBase {
    static constexpr int NST = 16; static constexpr bool PERM = true;
    unsigned char* wsb;
    DI void epi(AccRef acc, const pg8::GU& u, int wr, int wc, int fr, int fq) const {
        int pitch; int coff[2]; const bool sig = u.pn >= 8;
#pragma unroll
        for (int bj = 0; bj < 2; ++bj) { const int c0 = bj * 128 + wc * 32 + fq * 8;
            coff[bj] = (u.pn == 0) ? ((c0 >> 4) * (T_TOK * 16) + (c0 & 15)) : (u.pn < 8) ? ((u.pn - 1) * 256 + c0) : ((u.pn - 8) * 256 + c0); }
        const size_t boff = (u.pn == 0) ? WS_UG : (u.pn < 8) ? WS_PM : WS_GL; pitch = (u.pn == 0) ? 16 : (u.pn < 8) ? PMP : GLP; bf16* base = (bf16*)(wsb + boff);
#pragma unroll
        for (int ai = 0; ai < 2; ++ai)
#pragma unroll
            for (int m = 0; m < 4; ++m) { const size_t t = (size_t)(u.pm * 256 + ai * 128 + wr * 64 + m * 16 + fr);
#pragma unroll
                for (int bj = 0; bj < 2; ++bj) { float v[8]; acc8(acc, ai, bj, m, v);
                    if (sig) {
#pragma unroll
                        for (int j = 0; j < 8; ++j) v[j] = fsigmoid(v[j]); }
                    *(u32x4*)(base + t * pitch + coff[bj]) = pack8(v); }
                asm volatile("" ::: "memory"); __builtin_amdgcn_sched_barrier(0); }
    }
};
constexpr float W8_SCALE = 64.0f;
constexpr bool WIN_ALL_F8 = true;
constexpr unsigned WIN_F8_TILES = 0xFFFFFu;
struct PolWinMix {
    static constexpr int NST = 8; static constexpr bool PERM = true, PERM16F8 = true, SEG2 = true, GATHER = false, MIXED = true;
    const char* H; const char* H8; const char* WIN; const char* WIN8; unsigned char* wsb; pg8::TileOrder ord;
    static constexpr int lda = 1024, lda2 = 512, ldb = 1024, ldb2 = 512;
    DI bool next(int i, pg8::GU& u) const { int pm, pn; if (!ord.next(i, pm, pn)) return false; u.pm = pm; u.pn = pn; const bool f8 = ((WIN_F8_TILES >> pn) & 1u) != 0; u.e = f8 ? 1 : 0;
        u.A = H + (size_t)pm * 256 * 1024 * 2; u.A2 = H8 + (size_t)pm * 256 * 1024; u.B = f8 ? (WIN8 + (size_t)pn * 256 * 1024) : (WIN + (size_t)pn * 256 * 1024 * 2);
        u.nt = f8 ? 8 : 16; u.nt1 = f8 ? 0 : 16; u.kstepA = 128; u.kstepA2 = 128; u.bjump = 0; u.lda = 1024; u.lda2 = 512; return true; }
    DI void epi(AccRef acc, const pg8::GU& u, int wr, int wc, int fr, int fq) const {
        if (u.pn >= 8) {
            unsigned char* base = wsb + WS_GL + ((size_t)u.pm * 256 + wr * 64 + fr) * GLP + (u.pn - 8) * 256 + wc * 64 + fq * 16;
#pragma unroll
            for (int ai = 0; ai < 2; ++ai)
#pragma unroll
                for (int m = 0; m < 4; ++m) { u32x4 o;
#pragma unroll
                    for (int bj = 0; bj < 2; ++bj) { float v[8]; acc8(acc, ai, bj, m, v);
#pragma unroll
                        for (int j = 0; j < 8; ++j) v[j] = fsigmoid(v[j] * (1.0f / W8_SCALE));
                        int w0 = __builtin_bit_cast(int, v[0]), w1 = __builtin_bit_cast(int, v[4]);
                        w0 = __builtin_amdgcn_cvt_pk_fp8_f32(v[0], v[1], w0, false); w0 = __builtin_amdgcn_cvt_pk_fp8_f32(v[2], v[3], w0, true);
                        w1 = __builtin_amdgcn_cvt_pk_fp8_f32(v[4], v[5], w1, false); w1 = __builtin_amdgcn_cvt_pk_fp8_f32(v[6], v[7], w1, true);
                        if (bj == 0) { o.x = (unsigned)w0; o.y = (unsigned)w1; } else { o.z = (unsigned)w0; o.w = (unsigned)w1; } }
                    *(u32x4*)(base + (size_t)(ai * 128 + m * 16) * GLP) = o;
                    if (m == 3) { asm volatile("" ::: "memory"); __builtin_amdgcn_sched_barrier(0); } }
            return; }
        if (((WIN_F8_TILES & 0xFFu) == 0xFFu) || u.e != 0) {
            const int c16 = wc * 64 + fq * 16; bf16* base = (u.pn == 0) ? (bf16*)(wsb + WS_UG) + ((size_t)(c16 >> 4) * T_TOK) * 16 : (bf16*)(wsb + WS_PM) + (u.pn - 1) * 256 + c16; const int pitch = (u.pn == 0) ? 16 : PMP;
#pragma unroll
            for (int ai = 0; ai < 2; ++ai)
#pragma unroll
                for (int m = 0; m < 4; ++m) { const size_t t = (size_t)(u.pm * 256 + ai * 128 + wr * 64 + m * 16 + fr);
#pragma unroll
                    for (int bj = 0; bj < 2; ++bj) { float v[8]; acc8(acc, ai, bj, m, v);
#pragma unroll
                        for (int j = 0; j < 8; ++j) v[j] *= (1.0f / W8_SCALE);
                        *(u32x4*)(base + t * pitch + bj * 8) = pack8(v); }
                    asm volatile("" ::: "memory"); __builtin_amdgcn_sched_barrier(0); }
            return; }
        if constexpr ((WIN_F8_TILES & 0xFFu) != 0xFFu) {
        int pitch; int coff[2];
#pragma unroll
        for (int bj = 0; bj < 2; ++bj) { const int c0 = bj * 128 + wc * 32 + fq * 8;
            coff[bj] = (u.pn == 0) ? ((c0 >> 4) * (T_TOK * 16) + (c0 & 15)) : ((u.pn - 1) * 256 + c0); }
        const size_t boff = (u.pn == 0) ? WS_UG : WS_PM; pitch = (u.pn == 0) ? 16 : PMP; bf16* base = (bf16*)(wsb + boff);
#pragma unroll
        for (int ai = 0; ai < 2; ++ai)
#pragma unroll
            for (int m = 0; m < 4; ++m) { const size_t t = (size_t)(u.pm * 256 + ai * 128 + wr * 64 + m * 16 + fr);
#pragma unroll
                for (int bj = 0; bj < 2; ++bj) { float v[8]; acc8(acc, ai, bj, m, v);
                    *(u32x4*)(base + t * pitch + coff[bj]) = pack8(v); }
                asm volatile("" ::: "memory"); __builtin_amdgcn_sched_barrier(0); }
        }
    }
};
DI void gates8(const u32x2 w, float (&g)[8]) {
    const f32x2 a = __builtin_amdgcn_cvt_pk_f32_fp8((int)w.x, false), b = __builtin_amdgcn_cvt_pk_f32_fp8((int)w.x, true), c = __builtin_amdgcn_cvt_pk_f32_fp8((int)w.y, false), d = __builtin_amdgcn_cvt_pk_f32_fp8((int)w.y, true);
    g[0] = a.x; g[1] = a.y; g[2] = b.x; g[3] = b.y; g[4] = c.x; g[5] = c.y; g[6] = d.x; g[7] = d.y;
}
struct PolS5a {
    static constexpr int NST = 16; static constexpr bool PERM = false, SEG2 = false, GATHER = false, MIXED = false;
    const char* UG; const char* BT1; float* SLOC; int ldb, G, c; static constexpr int lda = 1024, lda2 = 1024;
    DI bool next(int i, pg8::GU& u) const { const int L = i * G + c; if (L >= 64) return false; u.pm = L & 3; u.e = L >> 2; u.pn = 0;
        u.A = UG + ((size_t)u.e * T_TOK * 16 + (size_t)u.pm * 256 * 1024) * 2; u.A2 = u.A; u.B = BT1 + (size_t)u.e * 128 * 1024 * 2; u.nt1 = u.nt = 16; u.kstepA = 128; u.kstepA2 = 128; u.bjump = 0; u.lda = 1024; u.lda2 = 1024; return true; }
    DI void epi(AccRef acc, const pg8::GU& u, int wr, int wc, int fr, int fq) const {
#pragma unroll
        for (int ai = 0; ai < 2; ++ai)
#pragma unroll
            for (int m = 0; m < 4; ++m) { const int row = u.pm * 256 + ai * 128 + wr * 64 + m * 16 + fr;
#pragma unroll
                for (int n = 0; n < 2; ++n) *(f32x4*)(SLOC + ((size_t)row * 16 + u.e) * 128 + wc * 32 + n * 16 + fq * 4) = acc[ai][0][m][n]; }
    }
};
struct PolS5b {
    static constexpr int NST = 16; static constexpr bool PERM = true, SEG2 = true, GATHER = false, MIXED = false;
    const char* UG; const char* S0; const char* BT2; const float* Dsk; unsigned char* YS5; int ldb, G, c; static constexpr int lda = 1024, lda2 = 2048;
    DI bool next(int i, pg8::GU& u) const { const int L = i * G + c; if (L >= 256) return false; u.e = L >> 4; u.pm = (L >> 2) & 3; u.pn = 3 - (L & 3);
        u.A = UG + ((size_t)u.e * T_TOK * 16 + (size_t)u.pm * 256 * 1024) * 2; u.A2 = S0 + ((size_t)u.pm * 256 * 2048 + (size_t)u.e * 128) * 2;
        u.B = BT2 + ((size_t)u.e * 1024 + (size_t)u.pn * 256) * 1152 * 2; u.nt1 = 4 * (u.pn + 1); u.nt = u.nt1 + 2; u.kstepA = 128; u.kstepA2 = 128; u.bjump = (1024 - u.nt1 * 64) * 2; u.lda = 1024; u.lda2 = 2048; return true; }
    DI void epi(AccRef acc, const pg8::GU& u, int wr, int wc, int fr, int fq) const {
        const bf16* Ug = (const bf16*)UG + (size_t)u.e * T_TOK * 16;
        const int h0 = (fq & 1) * 8;
        const f32x4 d0 = *(const f32x4*)(Dsk + u.e * 16 + h0), d1 = *(const f32x4*)(Dsk + u.e * 16 + h0 + 4);
        const float dd[8] = {d0.x, d0.y, d0.z, d0.w, d1.x, d1.y, d1.z, d1.w};
#pragma unroll
        for (int ai = 0; ai < 2; ++ai) { u32x4 uq[4][2];
#pragma unroll
            for (int m = 0; m < 4; ++m)
#pragma unroll
                for (int bj = 0; bj < 2; ++bj) { const int row = u.pm * 256 + ai * 128 + wr * 64 + m * 16 + fr, cc = u.pn * 256 + bj * 128 + wc * 32 + fq * 8; uq[m][bj] = *(const u32x4*)(Ug + ((size_t)row * 64 + (cc >> 4)) * 16 + h0); }
#pragma unroll
            for (int m = 0; m < 4; ++m) { const int row = u.pm * 256 + ai * 128 + wr * 64 + m * 16 + fr;
#pragma unroll
                for (int bj = 0; bj < 2; ++bj) { const int cc = u.pn * 256 + bj * 128 + wc * 32 + fq * 8, tau = cc >> 4; const size_t t = (size_t)row * 64 + tau;
                    float v[8], uu[8]; acc8(acc, ai, bj, m, v); unpack8(uq[m][bj], uu);
#pragma unroll
                    for (int j = 0; j < 8; ++j) v[j] = gelu_tanh(v[j] + dd[j] * uu[j]);
                    *(u32x2*)(YS5 + t * 256 + u.e * 16 + h0) = (u32x2){fp8x4(v[0], v[1], v[2], v[3]), fp8x4(v[4], v[5], v[6], v[7])}; } }
            asm volatile("" ::: "memory"); __builtin_amdgcn_sched_barrier(0); }
    }
};
struct PolGlu {
    static constexpr int NST = 4; static constexpr bool PERM = true, PERMSW = true, SEG2 = false, GATHER = false, MIXED = true;
    const char* A; const char* B; pg8::TileOrder ord; static constexpr int lda = 128, lda2 = 128, ldb = 128, ldb2 = 128;
    const unsigned char* GL; unsigned char* MERGED;
    DI bool next(int i, pg8::GU& u) const { int pm, pn; if (!ord.next(i, pm, pn)) return false; u.pm = pm; u.pn = pn; u.e = 1; u.A = A + (size_t)pm * 256 * 256; u.A2 = u.A; u.B = B + (size_t)pn * 256 * 256;
        u.nt1 = u.nt = 2; u.kstepA = 128; u.kstepA2 = 128; u.bjump = 0; u.lda = 128; u.lda2 = 128; return true; }
    DI void epi(AccRef acc, const pg8::GU& u, int wr, int wc, int fr, int fq) const {
        const int up = fq >> 1, c16 = u.pn * 128 + wc * 32 + (fq & 1) * 16, n0 = c16 + up * 8; u32x2 gq[2][4];
#pragma unroll
        for (int ai = 0; ai < 2; ++ai)
#pragma unroll
            for (int m = 0; m < 4; ++m) { const size_t t = (size_t)(u.pm * 256 + ai * 128 + wr * 64 + m * 16 + fr); gq[ai][m] = *(const u32x2*)(GL + t * GLP + n0); }
        unsigned char* base = MERGED + ((size_t)u.pm * 256 + wr * 64 + up * 16 + fr) * DM + c16;
#pragma unroll
        for (int ai = 0; ai < 2; ++ai)
#pragma unroll
            for (int mp = 0; mp < 2; ++mp) { unsigned q[2][2];
#pragma unroll
                for (int h = 0; h < 2; ++h) { const int m = 2 * mp + h;
                    float z1[8], z2[8], g[8]; acc8(acc, ai, 0, m, z1); acc8(acc, ai, 1, m, z2); gates8(gq[ai][m], g);
#pragma unroll
                    for (int j = 0; j < 8; ++j) z1[j] = g[j] * z1[j] * fsigmoid(z2[j]);
                    q[h][0] = fp8x4(z1[0], z1[1], z1[2], z1[3]); q[h][1] = fp8x4(z1[4], z1[5], z1[6], z1[7]); }
                const auto s0 = __builtin_amdgcn_permlane32_swap(q[0][0], q[1][0], false, false), s1 = __builtin_amdgcn_permlane32_swap(q[0][1], q[1][1], false, false);
                *(u32x4*)(base + (size_t)(ai * 128 + mp * 32) * DM) = (u32x4){s0[0], s1[0], s0[1], s1[1]}; }
    }
};
struct PolRmw {
    static constexpr int NST = 8; static constexpr bool PERM = true, PERM16 = true, SEG2 = false, GATHER = false, MIXED = true;
    const char* A1; const char* A2; const char* B1; const char* B2; const unsigned char* GL; unsigned char* MERGED; pg8::TileOrder ord; int nper;
    static constexpr int lda = 128, lda2 = 128, ldb = 128, ldb2 = 128;
    DI bool next(int i, pg8::GU& u) const { if (i >= 2 * nper) return false; const int br = (i >= nper) ? 1 : 0; int pm, pn; if (!ord.next(i - br * nper, pm, pn)) return false;
        u.pm = pm; u.pn = pn; u.e = 1; u.A = A1 + (size_t)br * (size_t)(A2 - A1) + (size_t)pm * 256 * 256; u.A2 = u.A; u.B = B1 + (size_t)br * (size_t)(B2 - B1) + (size_t)pn * 256 * 256;
        u.nt = 2; u.nt1 = 2; u.kstepA = 128; u.kstepA2 = 128; u.bjump = br; u.lda = 128; u.lda2 = 128; return true; }
    DI void epi(AccRef acc, const pg8::GU& u, int wr, int wc, int fr, int fq) const {
        const int gcol = (u.bjump + 1) * 1024, c16 = u.pn * 256 + wc * 64 + fq * 16;
#pragma unroll
        for (int ai = 0; ai < 2; ++ai) { u32x4 gq[4], oq[4];
#pragma unroll
            for (int m = 0; m < 4; ++m) { const size_t t = (size_t)(u.pm * 256 + ai * 128 + wr * 64 + m * 16 + fr); gq[m] = *(const u32x4*)(GL + t * GLP + gcol + c16); oq[m] = *(const u32x4*)(MERGED + t * DM + c16); }
#pragma unroll
            for (int m = 0; m < 4; ++m) { const size_t t = (size_t)(u.pm * 256 + ai * 128 + wr * 64 + m * 16 + fr); unsigned od[4];
#pragma unroll
                for (int d = 0; d < 4; ++d) { const f32x4 v = acc[ai][d >> 1][m][d & 1]; float g[4], o[4];
                    unfp8x4(d == 0 ? gq[m].x : d == 1 ? gq[m].y : d == 2 ? gq[m].z : gq[m].w, g); unfp8x4(d == 0 ? oq[m].x : d == 1 ? oq[m].y : d == 2 ? oq[m].z : oq[m].w, o);
                    od[d] = fp8x4(o[0] + g[0] * v.x, o[1] + g[1] * v.y, o[2] + g[2] * v.z, o[3] + g[3] * v.w); }
                *(u32x4*)(MERGED + t * DM + c16) = (u32x4){od[0], od[1], od[2], od[3]}; }
            asm volatile("" ::: "memory"); __builtin_amdgcn_sched_barrier(0); }
    }
};
template <bool IN16>
struct PolWout {
    static constexpr int NST = 16; static constexpr bool PERM = true, SEG2 = false, GATHER = false, MIXED = true;
    const char* A; const char* B; pg8::TileOrder ord; static constexpr int lda = 512, lda2 = 512, ldb = 512, ldb2 = 512;
    const void* Xin; bf16* X; const float* gate;
    DI bool next(int i, pg8::GU& u) const { int pm, pn; if (!ord.next(i, pm, pn)) return false; u.pm = pm; u.pn = pn; u.e = 1; u.A = A + (size_t)pm * 256 * 1024; u.A2 = u.A; u.B = B + (size_t)pn * 256 * 1024;
        u.nt1 = u.nt = 8; u.kstepA = 128; u.kstepA2 = 128; u.bjump = 0; u.lda = 512; u.lda2 = 512; return true; }
    DI void epi(AccRef acc, const pg8::GU& u, int wr, int wc, int fr, int fq) const {
        const int b = u.pm >> 5; float g[2][8];
#pragma unroll
        for (int bj = 0; bj < 2; ++bj) { const float* gp = gate + b * 6144 + u.pn * 256 + bj * 128 + wc * 32 + fq * 8; const f32x4 a = *(const f32x4*)gp * (1.0f / W8_SCALE), c = *(const f32x4*)(gp + 4) * (1.0f / W8_SCALE);
            g[bj][0] = a.x; g[bj][1] = a.y; g[bj][2] = a.z; g[bj][3] = a.w; g[bj][4] = c.x; g[bj][5] = c.y; g[bj][6] = c.z; g[bj][7] = c.w; }
#pragma unroll
        for (int ai = 0; ai < 2; ++ai) { u32x4 xq[4][2]; f32x4 xa[4][2], xc[4][2];
#pragma unroll
            for (int m = 0; m < 4; ++m) { const size_t t = (size_t)(u.pm * 256 + ai * 128 + wr * 64 + m * 16 + fr);
#pragma unroll
                for (int bj = 0; bj < 2; ++bj) { const int n0 = u.pn * 256 + bj * 128 + wc * 32 + fq * 8;
                    if (IN16) xq[m][bj] = *(const u32x4*)((const bf16*)Xin + t * XPITCH + n0);
                    else { xa[m][bj] = *(const f32x4*)((const float*)Xin + t * DM + n0); xc[m][bj] = *(const f32x4*)((const float*)Xin + t * DM + n0 + 4); } } }
#pragma unroll
            for (int m = 0; m < 4; ++m) { const size_t t = (size_t)(u.pm * 256 + ai * 128 + wr * 64 + m * 16 + fr);
#pragma unroll
                for (int bj = 0; bj < 2; ++bj) { const int n0 = u.pn * 256 + bj * 128 + wc * 32 + fq * 8; float v[8], x[8]; acc8(acc, ai, bj, m, v);
                    if (IN16) unpack8(xq[m][bj], x);
                    else { const f32x4 a = xa[m][bj], c = xc[m][bj]; x[0] = a.x; x[1] = a.y; x[2] = a.z; x[3] = a.w; x[4] = c.x; x[5] = c.y; x[6] = c.z; x[7] = c.w; }
#pragma unroll
                    for (int j = 0; j < 8; ++j) x[j] += g[bj][j] * v[j];
                    *(u32x4*)(X + t * XPITCH + n0) = pack8(x); } }
            asm volatile("" ::: "memory"); __builtin_amdgcn_sched_barrier(0); }
    }
};
struct PolRouter : PlainBase {
    static constexpr int NST = 0; static constexpr bool PERM = false;
    float* LOG; const float* RSTD; const float* PART; const char* Bb;
    DI bool next(int i, pg8::GU& u) const { if (!PlainBase::next(i, u)) return false; u.B = Bb + (size_t)(u.pm >> 5) * 256 * 1024 * 2; return true; }
    DI void epi(AccRef acc, const pg8::GU& u, int wr, int wc, int fr, int fq) const {
        if (wc < 2) { const int b = u.pm >> 5; f32x4 bias[2];
#pragma unroll
            for (int n = 0; n < 2; ++n) { f32x4 sb = (f32x4){0.f, 0.f, 0.f, 0.f};
#pragma unroll
                for (int q = 0; q < 8; ++q) sb += *(const f32x4*)(PART + (b * 8 + q) * 64 + wc * 32 + n * 16 + fq * 4);
                bias[n] = sb; }
            float rs[2][4];
#pragma unroll
            for (int ai = 0; ai < 2; ++ai)
#pragma unroll
                for (int m = 0; m < 4; ++m) rs[ai][m] = RSTD[(size_t)(u.pm * 256 + ai * 128 + wr * 64 + m * 16 + fr)];
#pragma unroll
            for (int ai = 0; ai < 2; ++ai)
#pragma unroll
                for (int m = 0; m < 4; ++m) { const size_t t = (size_t)(u.pm * 256 + ai * 128 + wr * 64 + m * 16 + fr);
#pragma unroll
                    for (int n = 0; n < 2; ++n) *(f32x4*)(LOG + t * 64 + wc * 32 + n * 16 + fq * 4) = acc[ai][0][m][n] * rs[ai][m] + bias[n]; } }
    }
};
struct GroupSched {
    const LAS int* blkpfx; int nNt, G, c;
    DI bool pick(int i, int& rb, int& pn, int& e) const { const int total = blkpfx[NEXP1] * nNt; const int L = i * G + c; if (L >= total) return false;
        rb = __builtin_amdgcn_readfirstlane(L / nNt); pn = __builtin_amdgcn_readfirstlane(L % nNt);
        int lj = threadIdx.x; asm volatile("" : "+v"(lj)); lj &= 63;
        const int vj = blkpfx[lj], v64 = blkpfx[NEXP];
        const unsigned long long mk = __ballot(vj <= rb);
        e = (rb >= __builtin_amdgcn_readfirstlane(v64)) ? NEXP : (__builtin_popcountll(mk) - 1);
        e = __builtin_amdgcn_readfirstlane(e); return true; }
};
constexpr float HID8_SCALE = 16.0f;
struct PolGateUp {
    static constexpr int NST = 4; static constexpr bool PERM = true, PERMSW = true, SEG2 = false, GATHER = true, MIXED = true;
    GroupSched gs; const char* H2; const char* WGU; const int* ROWTOK; const float* ROWW; unsigned char* HID; static constexpr int lda = 512, lda2 = 512, ldb = 1024, ldb2 = 512;
    DI bool next(int i, pg8::GU& u) const { int rb, pn, e; if (!gs.pick(i, rb, pn, e)) return false; u.pm = rb; u.pn = pn; u.e = 1;
        u.A = H2; u.A2 = H2; u.B = WGU + ((size_t)e * 512 + (size_t)pn * 256) * 1024; u.nt1 = u.nt = 8; u.kstepA = 128; u.kstepA2 = 128; u.bjump = 0; u.lda = 512; u.lda2 = 512; return true; }
    DI void avoff(const pg8::GU& u, const int (&R)[2], const int (&C)[2], unsigned (&v)[2][2]) const {
#pragma unroll
        for (int h = 0; h < 2; ++h)
#pragma unroll
            for (int i = 0; i < 2; ++i) { const int tok = ROWTOK[(size_t)u.pm * 256 + h * 128 + R[i]]; v[h][i] = (unsigned)(tok * 1024 + C[i] * 2); }
    }
    struct Pre { float w[2][4]; };
    DI void pre(const pg8::GU& u, int wr, int fr, Pre& p) const {
#pragma unroll
        for (int ai = 0; ai < 2; ++ai)
#pragma unroll
            for (int m = 0; m < 4; ++m) p.w[ai][m] = ROWW[(size_t)u.pm * 256 + ai * 128 + wr * 64 + m * 16 + fr]; }
    DI void epi(AccRef acc, const pg8::GU& u, int wr, int wc, int fr, int fq, Pre& p, const pg8::GU& un, bool has_next) const {
        float wq[2][4];
#pragma unroll
        for (int ai = 0; ai < 2; ++ai)
#pragma unroll
            for (int m = 0; m < 4; ++m) wq[ai][m] = p.w[ai][m];
        if (has_next) pre(un, wr, fr, p);
        const int up = fq >> 1;
        unsigned char* base = HID + ((size_t)u.pm * 256 + wr * 64 + up * 16 + fr) * 256 + u.pn * 128 + wc * 32 + (fq & 1) * 16;
#pragma unroll
        for (int ai = 0; ai < 2; ++ai)
#pragma unroll
            for (int mp = 0; mp < 2; ++mp) { unsigned q[2][2];
#pragma unroll
                for (int h = 0; h < 2; ++h) { const int m = 2 * mp + h; const float ws = wq[ai][m] * (HID8_SCALE / (W8_SCALE * W8_SCALE));
                    float z1[8], z2[8]; acc8(acc, ai, 0, m, z1); acc8(acc, ai, 1, m, z2);
#pragma unroll
                    for (int j = 0; j < 8; ++j) {
                        const float r = __builtin_amdgcn_rcpf(1.0f + __builtin_amdgcn_exp2f((-1.4426950408889634f / W8_SCALE) * z1[j]));
                        z1[j] = __builtin_amdgcn_fmed3f((ws * z1[j]) * (z2[j] * r), -448.0f, 448.0f); }
                    int w0 = 0, w1 = 0;
                    w0 = __builtin_amdgcn_cvt_pk_fp8_f32(z1[0], z1[1], w0, false); w0 = __builtin_amdgcn_cvt_pk_fp8_f32(z1[2], z1[3], w0, true);
                    w1 = __builtin_amdgcn_cvt_pk_fp8_f32(z1[4], z1[5], w1, false); w1 = __builtin_amdgcn_cvt_pk_fp8_f32(z1[6], z1[7], w1, true);
                    q[h][0] = (unsigned)w0; q[h][1] = (unsigned)w1; }
                const auto s0 = __builtin_amdgcn_permlane32_swap(q[0][0], q[1][0], false, false), s1 = __builtin_amdgcn_permlane32_swap(q[0][1], q[1][1], false, false);
                *(u32x4*)(base + (size_t)(ai * 128 + mp * 32) * 256) = (u32x4){s0[0], s1[0], s0[1], s1[1]}; }
    }
};
constexpr float Y8_SCALE = 16.0f;
static_assert(Y8_SCALE == HID8_SCALE, "the down accumulator is stored unscaled");
struct PolDown {
    static constexpr int NST = 8; static constexpr bool PERM = true, PERM16 = true, SEG2 = false, GATHER = false, MIXED = true;
    GroupSched gs; const char* HIDp; const char* WD; unsigned char* Y8; const int* ROWDST; static constexpr int lda = 128, lda2 = 128, ldb = 128, ldb2 = 128;
    DI bool next(int i, pg8::GU& u) const { int rb, pn, e; if (!gs.pick(i, rb, pn, e)) return false; u.pm = rb; u.pn = pn; u.e = 1;
        u.A = HIDp + (size_t)rb * 256 * 256; u.A2 = u.A; u.B = WD + ((size_t)e * 1024 + (size_t)pn * 256) * 256; u.nt1 = u.nt = 2; u.kstepA = 128; u.kstepA2 = 128; u.bjump = 0; u.lda = 128; u.lda2 = 128; return true; }
    struct Pre { int d[2][4]; };
    DI void pre(const pg8::GU& u, int wr, int fr, Pre& p) const {
#pragma unroll
        for (int ai = 0; ai < 2; ++ai)
#pragma unroll
            for (int m = 0; m < 4; ++m) p.d[ai][m] = ROWDST[(size_t)u.pm * 256 + ai * 128 + wr * 64 + m * 16 + fr]; }
    DI void epi(AccRef acc, const pg8::GU& u, int wr, int wc, int fr, int fq, Pre& p, const pg8::GU& un, bool has_next) const {
        int dst[2][4];
#pragma unroll
        for (int ai = 0; ai < 2; ++ai)
#pragma unroll
            for (int m = 0; m < 4; ++m) dst[ai][m] = p.d[ai][m];
        if (has_next) pre(un, wr, fr, p);
        unsigned char* base = Y8 + u.pn * 256 + wc * 64 + fq * 16;
#pragma unroll
        for (int ai = 0; ai < 2; ++ai)
#pragma unroll
            for (int m = 0; m < 4; ++m) { u32x4 o;
#pragma unroll
                for (int bj = 0; bj < 2; ++bj) { const f32x4 a = acc[ai][bj][m][0], b = acc[ai][bj][m][1];
                    int w0 = __builtin_bit_cast(int, a.x), w1 = __builtin_bit_cast(int, b.x);
                    w0 = __builtin_amdgcn_cvt_pk_fp8_f32(a.x, a.y, w0, false); w0 = __builtin_amdgcn_cvt_pk_fp8_f32(a.z, a.w, w0, true);
                    w1 = __builtin_amdgcn_cvt_pk_fp8_f32(b.x, b.y, w1, false); w1 = __builtin_amdgcn_cvt_pk_fp8_f32(b.z, b.w, w1, true);
                    if (bj == 0) { o.x = (unsigned)w0; o.y = (unsigned)w1; } else { o.z = (unsigned)w0; o.w = (unsigned)w1; } }
                *(u32x4*)(base + (size_t)dst[ai][m] * 1024) = o; }
    }
};

DI void s5_carry_unit(Frame& F, int u) {
    const int b = u >> 4, g = u & 15, p = F.tid & 63, cg = F.tid >> 6;
    const float* SLOC = (const float*)(F.ws + WS_SLOC); bf16* S0 = (bf16*)(F.ws + WS_S0); const float* A64 = (const float*)(F.ws + WS_A64);
    LAS float* R15 = (LAS float*)(F.lds + RING_OFF);
    const float Ar = A64[(g * 64 + p) * 2], Ai = A64[(g * 64 + p) * 2 + 1];
    float xr[16], xi[16];
#pragma unroll
    for (int k = 0; k < 16; ++k) { const size_t base = ((size_t)(b * 128 + cg * 16 + k) * 16 + g) * 128; xr[k] = SLOC[base + p]; xi[k] = SLOC[base + 64 + p]; }
    float rr = 0.f, ri = 0.f;
#pragma unroll
    for (int k = 0; k < 16; ++k) { const float nr = Ar * rr - Ai * ri + xr[k], ni = Ar * ri + Ai * rr + xi[k]; rr = nr; ri = ni; xr[k] = rr; xi[k] = ri; }
    R15[(cg * 64 + p) * 2] = rr; R15[(cg * 64 + p) * 2 + 1] = ri;
    float A16r = Ar, A16i = Ai;
#pragma unroll
    for (int q = 0; q < 4; ++q) { const float nr = A16r * A16r - A16i * A16i, ni = 2.f * A16r * A16i; A16r = nr; A16i = ni; }
    WGBAR();
    float Gr = 0.f, Gi = 0.f;
    for (int q = 0; q < cg; ++q) { const float tr = R15[(q * 64 + p) * 2], ti = R15[(q * 64 + p) * 2 + 1]; const float nr = A16r * Gr - A16i * Gi + tr, ni = A16r * Gi + A16i * Gr + ti; Gr = nr; Gi = ni; }
    float pr = 1.f, pi = 0.f;
#pragma unroll
    for (int k = 0; k < 16; ++k) {
        float sr = pr * Gr - pi * Gi, si = pr * Gi + pi * Gr;
        if (k > 0) { sr += xr[k - 1]; si += xi[k - 1]; }
        const size_t base = ((size_t)(b * 128 + cg * 16 + k) * 16 + g) * 128;
        S0[base + p] = (bf16)f2bf(sr); S0[base + 64 + p] = (bf16)f2bf(si);
        const float nr = pr * Ar - pi * Ai, ni = pr * Ai + pi * Ar; pr = nr; pi = ni;
    }
    WGBAR();
}

constexpr int HG_FT = 0, HG_CUM = 8192, HG_SEG = 25600, HG_QT = 27648, HG_QE = 36864, HG_KT = 46080, HG_INT = 69120, HG_ST = 78336, HG_PS = 87552, HG_OUT = 105984;
constexpr int HP = 72;
constexpr int CP = 68;
DI float hg_lb_calc(Frame& F, int l, int col) { if (l == 0) return 0.f; const float x0 = inp(F, I_LBL)[col], x1 = inp(F, I_LBL)[256 + col]; return 1.0f / (1.0f + expf(x0 - x1)); }
constexpr int HG_LBTAB = LDSCTL_OFF + 13312;
DI void hg_lb_table(Frame& F, int l) { LAS float* T = (LAS float*)(F.lds + HG_LBTAB); if (F.tid < 256) T[F.tid] = hg_lb_calc(F, l, F.tid); asm volatile("s_waitcnt lgkmcnt(0)" ::: "memory"); __builtin_amdgcn_s_barrier(); asm volatile("" ::: "memory"); }
DI float hg_lb(Frame& F, int l, int col) { if (l == 0) return 0.f; return ((const LAS float*)(F.lds + HG_LBTAB))[col]; }
#define LBAR() do { asm volatile("s_waitcnt lgkmcnt(0)" ::: "memory"); __builtin_amdgcn_s_barrier(); asm volatile("" ::: "memory"); } while (0)
struct HgRegs { u32x4 ft, inp, q, g; f32x4 s0, s1; unsigned short fc[8]; float sg[8]; };
DI void hg_fetch(Frame& F, int u, bool h3, HgRegs& r) {
    const bf16* PM = (const bf16*)(F.ws + WS_PM); const float* HST = (const float*)(F.ws + WS_HST);
    const int bh = u >> 7, c = u & 127, b = bh >> 2, head = bh & 3, tok0 = b * SEQ + c * 64;
    const int t = F.tid >> 3, kc = F.tid & 7; const bf16* row = PM + (size_t)(tok0 + t) * PMP + head * 64 + kc * 8;
    r.inp = *(const u32x4*)(row + 512); if (h3) r.ft = *(const u32x4*)(row + 256);
    { const int k = F.tid & 63, seg = F.tid >> 6; const bf16* col = PM + (size_t)(tok0 + seg * 8) * PMP + head * 64 + 256 + k;
#pragma unroll
      for (int j = 0; j < 8; ++j) r.fc[j] = col[(size_t)j * PMP];
      if (h3) { const float* sgp = (const float*)(F.ws + WS_HSEG) + (size_t)u * 512 + k;
#pragma unroll
          for (int s_ = 0; s_ < 8; ++s_) r.sg[s_] = sgp[s_ * 64]; } }
    if (h3) { r.q = *(const u32x4*)(row); r.g = *(const u32x4*)(row + 768); const float* sp = HST + (size_t)u * 4096 + t * 64 + kc * 8; r.s0 = *(const f32x4*)sp; r.s1 = *(const f32x4*)(sp + 4); }
}
template <bool H3>
DI void hg_stepA(Frame& F, const HgRegs& r, float lbk, float (&fv)[8], float (&cum)[8], float& last, int u) {
    LAS float* CUM = (LAS float*)(F.lds + HG_CUM); LAS float* SEG = (LAS float*)(F.lds + HG_SEG);
    const int k = F.tid & 63, seg = F.tid >> 6; float run = 0.f;
#pragma unroll
    for (int j = 0; j < 8; ++j) { const float fr = bf2f(r.fc[j]); const float f = lbk + (1.0f - lbk) * fsigmoid(fr); fv[j] = f; run += __builtin_amdgcn_logf(f); cum[j] = run; }
    float off = 0.f, tot = 0.f;
    if constexpr (H3) {
#pragma unroll
        for (int s = 0; s < 8; ++s) { const float v = r.sg[s]; tot += v; if (s < seg) off += v; }
    } else {
        SEG[seg * 64 + k] = run; ((float*)(F.ws + WS_HSEG))[(size_t)u * 512 + seg * 64 + k] = run;
        LBAR();
#pragma unroll
        for (int s = 0; s < 8; ++s) { const float v = SEG[s * 64 + k]; tot += v; if (s < seg) off += v; }
    }
    last = tot;
#pragma unroll
    for (int j = 0; j < 8; ++j) { cum[j] += off; if constexpr (H3) CUM[(seg * 8 + j) * CP + k] = cum[j]; }
}
typedef short hg_s4 __attribute__((ext_vector_type(4)));
DI void hg_store_inpT(Frame& F, const HgRegs& r) {
    LAS bf16* INT = (LAS bf16*)(F.lds + HG_INT);
    const int s = F.tid >> 3, vc = F.tid & 7;
    *(LAS u32x4*)(INT + s * HP + vc * 8) = r.inp;
}
DI bf16x8 hg_trB(const LAS bf16* T, int v16, int s0, int lane) {
    const int quad = lane >> 4, q = (lane & 15) >> 2, pp = lane & 3;
    const LAS bf16* a = T + (s0 + 8 * quad + q) * HP + v16 + 4 * pp;
    const hg_s4 lo = __builtin_amdgcn_ds_read_tr16_b64_v4i16((LAS hg_s4*)a), hi = __builtin_amdgcn_ds_read_tr16_b64_v4i16((LAS hg_s4*)(a + 4 * HP));
    return __builtin_shufflevector(lo, hi, 0, 1, 2, 3, 4, 5, 6, 7);
}
DI void hgrn_h1_unit(Frame& F, int l, int u, const HgRegs& r) {
    float* HST = (float*)(F.ws + WS_HST); float* HLAST = (float*)(F.ws + WS_HLAST);
    const int bh = u >> 7, head = bh & 3;
    const int k = F.tid & 63, seg = F.tid >> 6;
    const float lbk = hg_lb(F, l, head * 64 + k);
    float fv[8], cum[8], last;
    hg_stepA<false>(F, r, lbk, fv, cum, last, u);
    LAS bf16* KST = (LAS bf16*)(F.lds + HG_QT);
    { float ks[8];
#pragma unroll
      for (int j = 0; j < 8; ++j) ks[j] = (1.0f - fv[j]) * __builtin_amdgcn_exp2f(last - cum[j]);
      *(LAS u32x4*)(KST + k * HP + seg * 8) = pack8(ks); }
    if (seg == 0) HLAST[(size_t)u * 64 + k] = last;
    hg_store_inpT(F, r);
    LBAR();
    { const int w = F.wave, kt = w >> 1, vts = (w & 1) * 2, row = F.lane & 15, quad = F.lane >> 4;
      const LAS bf16* INT = (const LAS bf16*)(F.lds + HG_INT);
#pragma unroll
      for (int vt = 0; vt < 2; ++vt) { f32x4 acc = (f32x4){0.f, 0.f, 0.f, 0.f};
#pragma unroll
          for (int ks = 0; ks < 2; ++ks) { const bf16x8 a = *(const LAS bf16x8*)(KST + (kt * 16 + row) * HP + ks * 32 + quad * 8), bb = hg_trB(INT, (vts + vt) * 16, ks * 32, F.lane);
              acc = __builtin_amdgcn_mfma_f32_16x16x32_bf16(a, bb, acc, 0, 0, 0); }
#pragma unroll
          for (int j = 0; j < 4; ++j) HST[(size_t)u * 4096 + (kt * 16 + quad * 4 + j) * 64 + (vts + vt) * 16 + row] = acc[j]; } }
}
DI void hgrn_h1_phase(Frame& F, int l) {
    int u0, n;
    if (F.G == 256) { if (F.vcu < 64) { u0 = F.vcu * 7; n = 7; } else { u0 = 448 + (F.vcu - 64) * 19; n = 19; } }
    else { const int per = (4096 + F.G - 1) / F.G; u0 = F.vcu * per; n = (u0 + per <= 4096) ? per : (4096 - u0 > 0 ? 4096 - u0 : 0); }
    if (n <= 0) return;
    hg_lb_table(F, l);
    HgRegs cur, nxt;
    hg_fetch(F, u0, false, cur);
    for (int k = 0; k < n; ++k) { if (k + 1 < n) hg_fetch(F, u0 + k + 1, false, nxt); hgrn_h1_unit(F, l, u0 + k, cur); cur = nxt; }
    LBAR();
}
DI void hgrn_carry_unit(Frame& F, int u) {
    float* HST = (float*)(F.ws + WS_HST); const float* HLAST = (const float*)(F.ws + WS_HLAST);
    const int bh = u >> 3, v = F.tid & 63, k = (F.tid >> 6) + 8 * (u & 7);
    float s = 0.f;
    float d[8], dec[8];
#pragma unroll
    for (int j = 0; j < 8; ++j) { const size_t uu = (size_t)bh * 128 + j; d[j] = HST[uu * 4096 + k * 64 + v]; dec[j] = HLAST[uu * 64 + k]; }
    for (int c0 = 0; c0 < 128; c0 += 8) {
        float dn[8], decn[8]; const int cn = (c0 + 8 < 128) ? c0 + 8 : c0;
#pragma unroll
        for (int j = 0; j < 8; ++j) { const size_t uu = (size_t)bh * 128 + cn + j; dn[j] = HST[uu * 4096 + k * 64 + v]; decn[j] = HLAST[uu * 64 + k]; }
#pragma unroll
        for (int j = 0; j < 8; ++j) { const size_t uu = (size_t)bh * 128 + c0 + j; HST[uu * 4096 + k * 64 + v] = s; s = __builtin_amdgcn_exp2f(dec[j]) * s + d[j]; }
#pragma unroll
        for (int j = 0; j < 8; ++j) { d[j] = dn[j]; dec[j] = decn[j]; }
    }
}
DI void hgrn_h3_unit(Frame& F, int l, int u, const HgRegs& r, const float (&hng)[8]) {
    unsigned char* OH = F.ws + WS_OH;
    const int bh = u >> 7, c = u & 127, b = bh >> 2, head = bh & 3, tok0 = b * SEQ + c * 64;
    { const int k = F.tid & 63; const float lbk = hg_lb(F, l, head * 64 + k); float fv[8], cum[8], last; hg_stepA<true>(F, r, lbk, fv, cum, last, u); }
    hg_store_inpT(F, r);
    { LAS bf16* ST = (LAS bf16*)(F.lds + HG_ST); const int k = F.tid >> 3, vc = F.tid & 7;
      const float sv[8] = {r.s0.x, r.s0.y, r.s0.z, r.s0.w, r.s1.x, r.s1.y, r.s1.z, r.s1.w};
      *(LAS u32x4*)(ST + k * HP + vc * 8) = (u32x4){pk2(sv[0], sv[1]), pk2(sv[2], sv[3]), pk2(sv[4], sv[5]), pk2(sv[6], sv[7])}; }
    LBAR();
    {
      const LAS bf16* FT = (const LAS bf16*)(F.lds + HG_FT); const LAS float* CUM = (const LAS float*)(F.lds + HG_CUM);
      LAS bf16* QT = (LAS bf16*)(F.lds + HG_QT); LAS bf16* QE = (LAS bf16*)(F.lds + HG_QE); LAS bf16* KT = (LAS bf16*)(F.lds + HG_KT);
      const int t = F.tid >> 3, kc = F.tid & 7, ib = t >> 4;
      float q[8], fr[8], cm[8], rf[8], o1[8], o2[8];
      unpack8(r.q, q);
      unpack8(r.ft, fr);
      { const LAS f32x4* c4 = (const LAS f32x4*)(CUM + t * CP + kc * 8); const f32x4 a = c4[0], b = c4[1];
        cm[0] = a.x; cm[1] = a.y; cm[2] = a.z; cm[3] = a.w; cm[4] = b.x; cm[5] = b.y; cm[6] = b.z; cm[7] = b.w;
        f32x4 ra = (f32x4){0.f, 0.f, 0.f, 0.f}, rb = ra;
        if (ib > 0) { const LAS f32x4* r4 = (const LAS f32x4*)(CUM + (16 * ib - 1) * CP + kc * 8); ra = r4[0]; rb = r4[1]; }
        rf[0] = ra.x; rf[1] = ra.y; rf[2] = ra.z; rf[3] = ra.w; rf[4] = rb.x; rf[5] = rb.y; rf[6] = rb.z; rf[7] = rb.w; }
      { float lb8[8];
        if (l == 0) {
#pragma unroll
            for (int j = 0; j < 8; ++j) lb8[j] = 0.f; }
        else { const LAS f32x4* t4 = (const LAS f32x4*)((const LAS float*)(F.lds + HG_LBTAB) + head * 64 + kc * 8); const f32x4 a = t4[0], b = t4[1]; lb8[0] = a.x; lb8[1] = a.y; lb8[2] = a.z; lb8[3] = a.w; lb8[4] = b.x; lb8[5] = b.y; lb8[6] = b.z; lb8[7] = b.w; }
#pragma unroll
        for (int j = 0; j < 8; ++j) { const float lbk = lb8[j]; fr[j] = 1.0f - (lbk + (1.0f - lbk) * fsigmoid(fr[j])); } }
#pragma unroll
      for (int j = 0; j < 8; ++j) { o1[j] = q[j] * __builtin_amdgcn_exp2f(cm[j] - rf[j]); o2[j] = q[j] * __builtin_amdgcn_exp2f(cm[j]); }
      *(LAS u32x4*)(QT + t * HP + kc * 8) = pack8(o1); *(LAS u32x4*)(QE + t * HP + kc * 8) = pack8(o2);
      for (int i2 = ib; i2 < 4; ++i2) { const int rowoff = (i2 == 0) ? 0 : (i2 == 1) ? 16 : (i2 == 2) ? 48 : 96;
          float r2v[8];
          { f32x4 ra = (f32x4){0.f, 0.f, 0.f, 0.f}, rb = ra;
            if (i2 > 0) { const LAS f32x4* r4 = (const LAS f32x4*)(CUM + (16 * i2 - 1) * CP + kc * 8); ra = r4[0]; rb = r4[1]; }
            r2v[0] = ra.x; r2v[1] = ra.y; r2v[2] = ra.z; r2v[3] = ra.w; r2v[4] = rb.x; r2v[5] = rb.y; r2v[6] = rb.z; r2v[7] = rb.w; }
#pragma unroll
          for (int j = 0; j < 8; ++j) { const float r2 = r2v[j]; o1[j] = fr[j] * __builtin_amdgcn_exp2f(fminf(r2 - cm[j], 115.41560327111707f)); }
          *(LAS u32x4*)(KT + (rowoff + t) * HP + kc * 8) = pack8(o1); }
    }
    asm volatile("s_waitcnt lgkmcnt(0)" ::: "memory"); __builtin_amdgcn_s_barrier(); asm volatile("" ::: "memory");
    { const int w = F.wave, ib = w >> 1, vh = w & 1, row = F.lane & 15, quad = F.lane >> 4;
      const LAS bf16* QT = (const LAS bf16*)(F.lds + HG_QT); const LAS bf16* QE = (const LAS bf16*)(F.lds + HG_QE); const LAS bf16* KT = (const LAS bf16*)(F.lds + HG_KT);
      const LAS bf16* INT = (const LAS bf16*)(F.lds + HG_INT); const LAS bf16* ST = (const LAS bf16*)(F.lds + HG_ST);
      LAS bf16* PS = (LAS bf16*)(F.lds + HG_PS) + w * 16 * HP; LAS float* OUT = (LAS float*)(F.lds + HG_OUT);
      const int rowoff = (ib == 0) ? 0 : (ib == 1) ? 16 : (ib == 2) ? 48 : 96;
      const bf16x8 qa0 = *(const LAS bf16x8*)(QT + (16 * ib + row) * HP + quad * 8), qa1 = *(const LAS bf16x8*)(QT + (16 * ib + row) * HP + 32 + quad * 8);
      f32x4 accO[2] = {(f32x4){0.f, 0.f, 0.f, 0.f}, (f32x4){0.f, 0.f, 0.f, 0.f}};
      const int tq = (F.lane & 15) >> 2, tp = F.lane & 3;
      for (int st = 0; st <= ib; ++st) {
          const bf16x8 b0 = *(const LAS bf16x8*)(KT + (rowoff + st * 16 + row) * HP + quad * 8), b1 = *(const LAS bf16x8*)(KT + (rowoff + st * 16 + row) * HP + 32 + quad * 8);
          f32x4 sT = (f32x4){0.f, 0.f, 0.f, 0.f};
          sT = __builtin_amdgcn_mfma_f32_16x16x32_bf16(b0, qa0, sT, 0, 0, 0); sT = __builtin_amdgcn_mfma_f32_16x16x32_bf16(b1, qa1, sT, 0, 0, 0);
          if (st == ib) {
#pragma unroll
              for (int j = 0; j < 4; ++j) if (quad * 4 + j > row) sT[j] = 0.f; }
          const hg_s4 p4 = (hg_s4){(short)f2bf(sT[0]), (short)f2bf(sT[1]), (short)f2bf(sT[2]), (short)f2bf(sT[3])};
#pragma unroll
          for (int vt = 0; vt < 2; ++vt) { const hg_s4 b4 = __builtin_amdgcn_ds_read_tr16_b64_v4i16((LAS hg_s4*)(INT + (st * 16 + 4 * quad + tq) * HP + (vh * 2 + vt) * 16 + 4 * tp));
              accO[vt] = __builtin_amdgcn_mfma_f32_16x16x16bf16_1k(p4, b4, accO[vt], 0, 0, 0); }
      }
#pragma unroll
      for (int vt = 0; vt < 2; ++vt) { f32x4 acc = accO[vt]; const int vrow = (vh * 2 + vt) * 16 + row;
#pragma unroll
          for (int ks = 0; ks < 2; ++ks) { const bf16x8 a = *(const LAS bf16x8*)(QE + (16 * ib + row) * HP + ks * 32 + quad * 8), bb = hg_trB(ST, (vh * 2 + vt) * 16, ks * 32, F.lane);
              acc = __builtin_amdgcn_mfma_f32_16x16x32_bf16(a, bb, acc, 0, 0, 0); }
#pragma unroll
          for (int j = 0; j < 4; ++j) OUT[(16 * ib + quad * 4 + j) * CP + vrow] = acc[j]; }
    }
    asm volatile("s_waitcnt lgkmcnt(0)" ::: "memory"); __builtin_amdgcn_s_barrier(); asm volatile("" ::: "memory");
    { const LAS float* OUT = (const LAS float*)(F.lds + HG_OUT); const int t = F.tid >> 3, vc = F.tid & 7;
      float o[8], g[8]; float ss = 0.f;

      { const LAS f32x4* o4 = (const LAS f32x4*)(OUT + t * CP + vc * 8); const f32x4 a = o4[0], b = o4[1]; o[0] = a.x; o[1] = a.y; o[2] = a.z; o[3] = a.w; o[4] = b.x; o[5] = b.y; o[6] = b.z; o[7] = b.w; }
#pragma unroll
      for (int j = 0; j < 8; ++j) ss += o[j] * o[j];
      ss += __shfl_xor(ss, 1); ss += __shfl_xor(ss, 2); ss += __shfl_xor(ss, 4);
      const float rstd = 1.0f / sqrtf(ss * (1.0f / 64.0f) + EPS);
      unpack8(r.g, g);
#pragma unroll
      for (int j = 0; j < 8; ++j) o[j] = o[j] * rstd * hng[j] * fsilu(g[j]);
      *(u32x2*)(OH + (size_t)(tok0 + t) * 256 + head * 64 + vc * 8) = (u32x2){fp8x4(o[0], o[1], o[2], o[3]), fp8x4(o[4], o[5], o[6], o[7])}; }
}
DI void hgrn_h3_phase(Frame& F, int l) {
    HgRegs cur, nxt; int u = F.vcu; if (u >= 4096) return;
    hg_lb_table(F, l);
    float hng[8];
#pragma unroll
    for (int j = 0; j < 8; ++j) hng[j] = inp(F, I_HNG)[l * 64 + (F.tid & 7) * 8 + j];
    hg_fetch(F, u, true, cur);
    for (; u < 4096; u += F.G) { const int un = u + F.G; if (un < 4096) hg_fetch(F, un, true, nxt); hgrn_h3_unit(F, l, u, cur, hng); cur = nxt; }
    LBAR();
}

DI void moba_prep_unit(Frame& F, int l, int u) {
    bf16* PM = (bf16*)(F.ws + WS_PM); float* KMEAN = (float*)(F.ws + WS_KMEAN);
    LAS float* KS = (LAS float*)(F.lds + RING_OFF);
    const int b = u >> 5, blk = u & 31, tg = F.tid >> 5, hd = (F.tid >> 3) & 3, dc = F.tid & 7;
    float qg[8], kg[8], ksum[8];
#pragma unroll
    for (int j = 0; j < 8; ++j) { qg[j] = inp(F, I_MQG)[l * 64 + dc * 8 + j] * attn_body::C2; kg[j] = inp(F, I_MKG)[l * 64 + dc * 8 + j]; ksum[j] = 0.f; }
    _Pragma("unroll 1") for (int ih = 0; ih < 4; ++ih) {
        u32x4 qr[4], kr[4];
#pragma unroll
        for (int i8 = 0; i8 < 4; ++i8) { const size_t row = (size_t)b * SEQ + blk * 256 + (ih * 4 + i8) * 16 + tg;
            qr[i8] = *(const u32x4*)(PM + row * PMP + 1024 + hd * 64 + dc * 8); kr[i8] = *(const u32x4*)(PM + row * PMP + 1280 + hd * 64 + dc * 8); }
#pragma unroll
        for (int i8 = 0; i8 < 4; ++i8) { const size_t row = (size_t)b * SEQ + blk * 256 + (ih * 4 + i8) * 16 + tg;
            bf16* qp = PM + row * PMP + 1024 + hd * 64 + dc * 8; bf16* kp = PM + row * PMP + 1280 + hd * 64 + dc * 8;
            float q[8], k[8]; unpack8(qr[i8], q); unpack8(kr[i8], k);
            float sq = 0.f, sk = 0.f;
#pragma unroll
            for (int j = 0; j < 8; ++j) { sq += q[j] * q[j]; sk += k[j] * k[j]; }
            sq += __shfl_xor(sq, 1); sq += __shfl_xor(sq, 2); sq += __shfl_xor(sq, 4); sk += __shfl_xor(sk, 1); sk += __shfl_xor(sk, 2); sk += __shfl_xor(sk, 4);
            const float rq = 1.0f / sqrtf(sq * (1.0f / 64.0f) + EPS), rk = 1.0f / sqrtf(sk * (1.0f / 64.0f) + EPS);
#pragma unroll
            for (int j = 0; j < 8; ++j) { q[j] = q[j] * rq * qg[j]; k[j] = k[j] * rk * kg[j]; ksum[j] += k[j]; }
            *(u32x4*)qp = pack8(q); *(u32x4*)kp = pack8(k); }
    }
#pragma unroll
    for (int j = 0; j < 8; ++j) KS[tg * 256 + hd * 64 + dc * 8 + j] = ksum[j];
    WGBAR();
    if (F.tid < 256) { float s = 0.f;
#pragma unroll
        for (int q = 0; q < 16; ++q) s += KS[q * 256 + F.tid];
        KMEAN[((size_t)(b * 4 + (F.tid >> 6)) * 32 + blk) * 64 + (F.tid & 63)] = s * (1.0f / 256.0f); }
    WGBAR();
}
DI int ql_base(int bh, int j) { return (bh * 496 + 31 * j - (j * (j - 1)) / 2) * 256; }
DI void moba_select_unit(Frame& F, int l, int u) {
    const bf16* PM = (const bf16*)(F.ws + WS_PM); const float* KMEAN = (const float*)(F.ws + WS_KMEAN); int* QL = (int*)(F.ws + WS_QL);
    LAS float* KM = (LAS float*)(F.lds + RING_OFF);
    int* hist = (int*)(F.ldsg + RING_OFF + 32768); LAS int* basel = (LAS int*)(F.lds + RING_OFF + 32768 + 512);
    const int b = u >> 5, blk = u & 31;
    for (int i = F.tid; i < 4 * 32 * 64 / 4; i += NTHR) ((LAS f32x4*)KM)[i] = ((const f32x4*)(KMEAN + (size_t)b * 4 * 32 * 64))[i];
    if (F.tid < 128) hist[F.tid] = 0;
    WGBAR();
    int sj[2][3], sr[2][3];
    for (int r = 0; r < 2; ++r) {
        const int p = F.tid + NTHR * r, tokl = p & 255, hd = __builtin_amdgcn_readfirstlane(p >> 8);
        const size_t row = (size_t)b * SEQ + blk * 256 + tokl;
        float q[64];
#pragma unroll
        for (int c8 = 0; c8 < 8; ++c8) { float t8[8]; unpack8(*(const u32x4*)(PM + row * PMP + 1024 + hd * 64 + c8 * 8), t8);
#pragma unroll
            for (int j = 0; j < 8; ++j) q[c8 * 8 + j] = t8[j]; }
        float v0 = -INFINITY, v1 = -INFINITY, v2 = -INFINITY; int i0 = -1, i1 = -1, i2 = -1;
        for (int j = 0; j < blk; ++j) { const LAS f32x4* km = (const LAS f32x4*)(KM + (hd * 32 + j) * 64); float g = 0.f;
#pragma unroll
            for (int d4 = 0; d4 < 16; ++d4) { const f32x4 kk = km[d4]; g += q[d4 * 4] * kk.x + q[d4 * 4 + 1] * kk.y + q[d4 * 4 + 2] * kk.z + q[d4 * 4 + 3] * kk.w; }
            if (g > v0) { v2 = v1; i2 = i1; v1 = v0; i1 = i0; v0 = g; i0 = j; } else if (g > v1) { v2 = v1; i2 = i1; v1 = g; i1 = j; } else if (g > v2) { v2 = g; i2 = j; } }
        sj[r][0] = i0; sj[r][1] = i1; sj[r][2] = i2;
#pragma unroll
        for (int s = 0; s < 3; ++s) sr[r][s] = (sj[r][s] >= 0) ? atomicAdd(&hist[hd * 32 + sj[r][s]], 1) : 0;
    }
    WGBAR();
    if (F.tid < 128) { const int c = hist[F.tid]; basel[F.tid] = c ? (int)atomicAdd((unsigned*)(F.ctl + CW_QC + l * 1024 + b * 128 + F.tid), (unsigned)c) : 0; }
    WGBAR();
    for (int r = 0; r < 2; ++r) { const int p = F.tid + NTHR * r, tokl = p & 255, hd = p >> 8;
#pragma unroll
        for (int s = 0; s < 3; ++s) if (sj[r][s] >= 0) QL[ql_base(b * 4 + hd, sj[r][s]) + basel[hd * 32 + sj[r][s]] + sr[r][s]] = ((blk * 256 + tokl) << 2) | s; }
    WGBAR();
}
DI void moba_gather_phase(Frame& F, int l, unsigned char* lds) {
    LAS int* QCL = (LAS int*)(F.lds + LDSCTL_OFF + 4096);
    LAS int* PFX = (LAS int*)(F.lds + LDSCTL_OFF + 8192);
    for (int i = F.tid; i < 1024; i += NTHR) QCL[i] = (int)__hip_atomic_load(F.ctl + CW_QC + l * 1024 + i, RLX_AGENT);
    WGBAR();
    if (F.tid < 32) { int acc = 0; for (int j = 0; j < 32; ++j) { const int cnt = (j < 31) ? QCL[F.tid * 32 + j] : 0; acc += (cnt + 255) >> 8; } PFX[1056 + F.tid] = acc; }
    WGBAR();
    if (F.tid < 32) { int base = 0; for (int q = 0; q < F.tid; ++q) base += PFX[1056 + q];
        for (int j = 0; j < 32; ++j) { PFX[F.tid * 32 + j] = base; const int cnt = (j < 31) ? QCL[F.tid * 32 + j] : 0; base += (cnt + 255) >> 8; }
        if (F.tid == 31) PFX[1024] = base; }
    WGBAR();
    const int total = PFX[1024];
    const attn_body::bf16* pm = (const attn_body::bf16*)(F.ws + WS_PM); const int* QL = (const int*)(F.ws + WS_QL);
    const int rank = (F.G == 256) ? ((3 - (F.vcu & 3)) * 64 + (F.vcu >> 2)) : F.vcu;
    for (int U = rank; U < total; U += F.G) {
        int lo = 0, hi = 1023;
#pragma unroll
        for (int s = 0; s < 10; ++s) { const int mid = (lo + hi + 1) >> 1; if (PFX[mid] <= U) lo = mid; else hi = mid - 1; }
        const int id = __builtin_amdgcn_readfirstlane(lo), c = U - PFX[id], bh = id >> 5, j = id & 31;
        const int nv = QCL[id] - c * 256;
        attn_body::attn_unit<8, 0>(bh >> 2, bh & 3, j, QL + ql_base(bh, j) + c * 256, nv < 256 ? nv : 256, pm + 1024, pm + 1280, pm + 1536, (attn_body::bf16*)nullptr, (attn_body::bf16*)(F.ws + WS_PO), (float*)(F.ws + WS_PML), (char*)lds + RING_OFF);
    }
}
DI void moba_own_phase(Frame& F, unsigned char* lds) {
    const attn_body::bf16* pm = (const attn_body::bf16*)(F.ws + WS_PM);
    for (int U = F.vcu; U < 1024; U += F.G) { const int bh = U >> 5, qb = U & 31;
        attn_body::attn_unit<8, 1>(bh >> 2, bh & 3, qb, (const int*)nullptr, 256, pm + 1024, pm + 1280, pm + 1536, (attn_body::bf16*)(F.ws + WS_OM), (attn_body::bf16*)(F.ws + WS_PO), (float*)(F.ws + WS_PML), (char*)lds + RING_OFF); }
}

DI void moe_route_unit(Frame& F, int l, int u) {
    const float* LOG = (const float*)(F.ws + WS_LOGITS); int* TOPI = (int*)(F.ws + WS_TOPI); float* TOPW = (float*)(F.ws + WS_TOPW);
    int* hist = (int*)(F.ldsg + RING_OFF); LAS float* biasl = (LAS float*)(F.lds + RING_OFF + 512);
    if (F.tid < 64) { hist[F.tid] = 0; biasl[F.tid] = inp(F, I_RB)[l * 64 + F.tid]; }
    WGBAR();
    const size_t t = (size_t)u * 512 + F.tid;
    float key[64];
#pragma unroll
    for (int c4 = 0; c4 < 16; ++c4) { const f32x4 v = *(const f32x4*)(LOG + t * 64 + c4 * 4);
        key[c4 * 4] = fsigmoid(v.x) + biasl[c4 * 4]; key[c4 * 4 + 1] = fsigmoid(v.y) + biasl[c4 * 4 + 1]; key[c4 * 4 + 2] = fsigmoid(v.z) + biasl[c4 * 4 + 2]; key[c4 * 4 + 3] = fsigmoid(v.w) + biasl[c4 * 4 + 3]; }
    int idx[6]; float sc[6]; float sum = 0.f;
#pragma unroll
    for (int k = 0; k < 6; ++k) { float best = -INFINITY; int bi = 0;
#pragma unroll
        for (int e = 0; e < 64; ++e) if (key[e] > best) { best = key[e]; bi = e; }
#pragma unroll
        for (int e = 0; e < 64; ++e) if (e == bi) key[e] = -INFINITY;
        idx[k] = bi; sc[k] = best - biasl[bi]; sum += sc[k]; }
    const float inv = 2.5f / sum;
#pragma unroll
    for (int k = 0; k < 6; ++k) { TOPI[t * 6 + k] = idx[k]; TOPW[t * 6 + k] = sc[k] * inv; atomicAdd(&hist[idx[k]], 1); }
    WGBAR();
    if (F.tid < 64) atomicAdd((unsigned*)(F.ctl + CW_CNT + l * 64 + F.tid), (unsigned)hist[F.tid]);
    WGBAR();
}
DI void moe_route_unit256(Frame& F, int l, int pm) {
    const float* LOG = (const float*)(F.ws + WS_LOGITS); int* TOPI = (int*)(F.ws + WS_TOPI); float* TOPW = (float*)(F.ws + WS_TOPW);
    int* hist = (int*)(F.ldsg + RING_OFF); LAS float* biasl = (LAS float*)(F.lds + RING_OFF + 512);
    if (F.tid < 64) { hist[F.tid] = 0; biasl[F.tid] = inp(F, I_RB)[l * 64 + F.tid]; }
    WGBAR();
    const size_t t = (size_t)pm * 256 + (F.tid & 255); const bool act = F.tid < 256;
    float key[64];
#pragma unroll
    for (int c4 = 0; c4 < 16; ++c4) { const f32x4 v = *(const f32x4*)(LOG + t * 64 + c4 * 4);
        key[c4 * 4] = fsigmoid(v.x) + biasl[c4 * 4]; key[c4 * 4 + 1] = fsigmoid(v.y) + biasl[c4 * 4 + 1]; key[c4 * 4 + 2] = fsigmoid(v.z) + biasl[c4 * 4 + 2]; key[c4 * 4 + 3] = fsigmoid(v.w) + biasl[c4 * 4 + 3]; }
    int idx[6]; float sc[6]; float sum = 0.f;
#pragma unroll
    for (int k = 0; k < 6; ++k) { float best = -INFINITY; int bi = 0;
#pragma unroll
        for (int e = 0; e < 64; ++e) if (key[e] > best) { best = key[e]; bi = e; }
#pragma unroll
        for (int e = 0; e < 64; ++e) if (e == bi) key[e] = -INFINITY;
        idx[k] = bi; sc[k] = best - biasl[bi]; sum += sc[k]; }
    const float inv = 2.5f / sum;
    if (act) {
#pragma unroll
    for (int k = 0; k < 6; ++k) { TOPI[t * 6 + k] = idx[k]; TOPW[t * 6 + k] = sc[k] * inv; atomicAdd(&hist[idx[k]], 1); } }
    WGBAR();
    if (F.tid < 64) atomicAdd((unsigned*)(F.ctl + CW_CNT + l * 64 + F.tid), (unsigned)hist[F.tid]);
    WGBAR();
}
DI void moe_tables(Frame& F, int l, LAS int* blkpfx, LAS int* rowpfx) {
    if (F.tid < NEXP) {
        const int cnt = (int)__hip_atomic_load(F.ctl + CW_CNT + l * 64 + F.tid, RLX_AGENT); const int nb = (cnt + 255) >> 8;
        int inc = nb;
#pragma unroll
        for (int d = 1; d < 64; d <<= 1) { const int t = __shfl_up(inc, d); if ((int)F.tid >= d) inc += t; }
        const int exc = inc - nb, tot = __shfl(inc, 63);
        blkpfx[F.tid] = exc; rowpfx[F.tid] = exc * 256;
        if (F.tid == 0) { blkpfx[NEXP] = tot; rowpfx[NEXP] = tot * 256; blkpfx[NEXP1] = tot + T_TOK / 256; rowpfx[NEXP1] = (tot + T_TOK / 256) * 256; } }
    WGBAR();
}
DI void moe_scatter_unit(Frame& F, int l, int u, const LAS int* rowpfx) {
    const int* TOPI = (const int*)(F.ws + WS_TOPI); const float* TOPW = (const float*)(F.ws + WS_TOPW); int* ROWDST = (int*)(F.ws + WS_ROWDST); int* ROWTOK = (int*)(F.ws + WS_ROWTOK); float* ROWW = (float*)(F.ws + WS_ROWW);
    int* hist = (int*)(F.ldsg + RING_OFF); LAS int* basel = (LAS int*)(F.lds + RING_OFF + 512);
    if (F.tid < 64) hist[F.tid] = 0;
    WGBAR();
    const size_t t = (size_t)u * 512 + F.tid; int e[6], r[6];
#pragma unroll
    for (int k = 0; k < 6; ++k) { e[k] = TOPI[t * 6 + k]; r[k] = atomicAdd(&hist[e[k]], 1); }
    WGBAR();
    if (F.tid < 64) basel[F.tid] = (int)atomicAdd((unsigned*)(F.ctl + CW_CUR + l * 64 + F.tid), (unsigned)hist[F.tid]);
    WGBAR();
    float tw[6];
#pragma unroll
    for (int k = 0; k < 6; ++k) tw[k] = TOPW[t * 6 + k];
#pragma unroll
    for (int k = 0; k < 6; ++k) { const int pos = rowpfx[e[k]] + basel[e[k]] + r[k]; ROWDST[pos] = (int)t * 7 + k; ROWTOK[pos] = (int)t; ROWW[pos] = tw[k]; }
    WGBAR();
}
DI void moe_fill_rows(Frame& F, int l, const LAS int* rowpfx) {
    int* ROWTOK = (int*)(F.ws + WS_ROWTOK); float* ROWW = (float*)(F.ws + WS_ROWW); int* ROWDST = (int*)(F.ws + WS_ROWDST);
    for (int e = F.vcu; e < NEXP; e += F.G) { const int cnt = (int)__hip_atomic_load(F.ctl + CW_CNT + l * 64 + e, RLX_AGENT); const int lo = rowpfx[e] + cnt, hi = rowpfx[e + 1];
        for (int i = lo + F.tid; i < hi; i += NTHR) { ROWTOK[i] = 0; ROWW[i] = 0.f; ROWDST[i] = T_TOK * 7; } }
    const int sh0 = rowpfx[NEXP];
    for (int t = F.vcu * NTHR + F.tid; t < T_TOK; t += F.G * NTHR) { ROWTOK[sh0 + t] = t; ROWW[sh0 + t] = 1.0f; ROWDST[sh0 + t] = t * 7 + 6; }
}
template <bool NORM>
DI void moe_combine(Frame& F, const float* gate, const bf16* Xin, void* Xout, const LAS int* rowpfx, const float* ngain, const float* nshift, const float* nscale, bf16* Hn, unsigned char* Hn8) {
    const unsigned char* Y8 = (const unsigned char*)(F.ws + WS_Y);
    const int gw = F.vcu * NWAVES + F.wave, NGW = F.G * NWAVES;
    for (int t = gw; t < T_TOK; t += NGW) {
        const int b = t >> 13;
        u32x4 w[7];
#pragma unroll
        for (int k = 0; k < 7; ++k) w[k] = *(const u32x4*)(Y8 + ((size_t)t * 7 + k) * 1024 + F.lane * 16);
        const bf16* xp = Xin + (size_t)t * XPITCH + F.lane * 16; const float* gp = gate + b * 6144 + F.lane * 16;
        float xo[2][8]; unpack8(*(const u32x4*)xp, xo[0]); unpack8(*(const u32x4*)(xp + 8), xo[1]);
        if (!NORM) { asm volatile("s_waitcnt vmcnt(0)" ::: "memory"); }
        f32x4 xn[4]; float ss = 0.f;
#pragma unroll
        for (int q = 0; q < 4; ++q) { f32x4 a = (f32x4){0.f, 0.f, 0.f, 0.f};
#pragma unroll
            for (int k = 0; k < 7; ++k) { const unsigned ww = (q == 0) ? w[k].x : (q == 1) ? w[k].y : (q == 2) ? w[k].z : w[k].w;
                const f32x2 lo = __builtin_amdgcn_cvt_pk_f32_fp8((int)ww, false), hi = __builtin_amdgcn_cvt_pk_f32_fp8((int)ww, true); a.x += lo.x; a.y += lo.y; a.z += hi.x; a.w += hi.y; }
            const f32x4 x = (f32x4){xo[q >> 1][(q & 1) * 4 + 0], xo[q >> 1][(q & 1) * 4 + 1], xo[q >> 1][(q & 1) * 4 + 2], xo[q >> 1][(q & 1) * 4 + 3]}, g = *(const f32x4*)(gp + q * 4);
            xn[q] = x + g * a * (1.0f / Y8_SCALE);
            if (NORM) ss += (xn[q].x * xn[q].x + xn[q].y * xn[q].y) + (xn[q].z * xn[q].z + xn[q].w * xn[q].w); }
        if (NORM) { bf16* xq = (bf16*)Xout + (size_t)t * XPITCH + F.lane * 16;
            *(u32x4*)xq = (u32x4){pk2(xn[0].x, xn[0].y), pk2(xn[0].z, xn[0].w), pk2(xn[1].x, xn[1].y), pk2(xn[1].z, xn[1].w)};
            *(u32x4*)(xq + 8) = (u32x4){pk2(xn[2].x, xn[2].y), pk2(xn[2].z, xn[2].w), pk2(xn[3].x, xn[3].y), pk2(xn[3].z, xn[3].w)}; }
        else { float* xq = (float*)Xout + (size_t)t * DM + F.lane * 16;
#pragma unroll
            for (int q = 0; q < 4; ++q) *(f32x4*)(xq + q * 4) = xn[q]; }
        if (NORM) { const float rstd = 1.0f / sqrtf(wave_sum(ss) * (1.0f / DM) + EPS); const int col = F.lane * 16; u32x4 hb[2]; unsigned h8[4];
#pragma unroll
            for (int q = 0; q < 4; ++q) { const f32x4 g = *(const f32x4*)(ngain + col + q * 4), sh = *(const f32x4*)(nshift + b * 6144 + col + q * 4), sc = *(const f32x4*)(nscale + b * 6144 + col + q * 4);
                const f32x4 y = xn[q] * rstd * g * (sc + 1.0f) + sh;
                const unsigned p0 = pk2(y.x, y.y), p1 = pk2(y.z, y.w); if (q & 1) { hb[q >> 1].z = p0; hb[q >> 1].w = p1; } else { hb[q >> 1].x = p0; hb[q >> 1].y = p1; }
                int qq = 0; qq = __builtin_amdgcn_cvt_pk_fp8_f32(y.x, y.y, qq, false); qq = __builtin_amdgcn_cvt_pk_fp8_f32(y.z, y.w, qq, true); h8[q] = (unsigned)qq; }
            if (Hn) { *(u32x4*)(Hn + (size_t)t * DM + col) = hb[0]; *(u32x4*)(Hn + (size_t)t * DM + col + 8) = hb[1]; }
            *(u32x4*)(Hn8 + (size_t)t * DM + col) = (u32x4){h8[0], h8[1], h8[2], h8[3]}; }
    }
}

#ifndef ONLY
#define ONLY -1
#endif
#define PH(n) (ONLY < 0 || ONLY == (n))
#ifndef ONLY5
#define ONLY5 -1
#endif
#define PH5(n) (ONLY5 < 0 || ONLY5 == (n))
#ifdef PROBE_MASK
#define PROBE_PHASE(p) do { if (blockIdx.x == 0 && threadIdx.x == 0) { volatile LAS unsigned long long* _pp = (volatile LAS unsigned long long*)(F.lds + MISC_OFF + 64); const unsigned long long _n = __builtin_amdgcn_s_memrealtime(); if ((PROBE_MASK >> (p)) & 1) _pp[0] += _n - _pp[1]; _pp[1] = _n; } } while (0)
#else
#define PROBE_PHASE(p) do { } while (0)
#endif
#define GRID_BAR() do { XcdBarrier _b = bar; GAS unsigned* _p = (GAS unsigned*)_b.bar; asm volatile("" : "+s"(_p)); _b.bar = (unsigned*)_p; unsigned _x = _b.x; asm volatile("" : "+s"(_x)); _b.x = _x; xcd_barrier(_b); } while (0)
#define PHASE_BEGIN() do { int _t = threadIdx.x; asm volatile("" : "+v"(_t)); F.tid = _t; F.lane = _t & 63; F.wave = __builtin_amdgcn_readfirstlane(_t >> 6); GAS unsigned char* _w = (GAS unsigned char*)ws0; asm volatile("" : "+s"(_w)); F.ws = (unsigned char*)_w; ws = F.ws; F.ctl = (gu32*)(F.ws + WS_CTL); MOD = (float*)(ws + WS_MOD); modl = MOD + (size_t)l * 8 * 6144; } while (0)
template <int l> DI void run_layer(Frame& F, const XcdBarrier& bar, unsigned char* ws0, unsigned char* lds, LAS int* blkpfx, LAS int* rowpfx, int bx) {
    unsigned char* ws = ws0; float* MOD = (float*)(ws + WS_MOD);
        bf16* XA = (bf16*)F.out; bf16* XB = (bf16*)F.out + 1024;
        const float* modl = MOD + (size_t)l * 8 * 6144;
        if (PH(0)) { PHASE_BEGIN();
        if (l == 0) p0_adaln(F);
        p0_s5tab(F, l);
        p0_convert<false>(F, l, WIN_ALL_F8 ? 0x101Eu : 0x101Fu);
        }
        GRID_BAR();
        PROBE_PHASE(0);
        if (l == 0) {
        if (PH(1)) { PHASE_BEGIN();
        norm_rows<false, 2>(F, inp(F, I_X), inp(F, I_N1G) + l * DM, modl + 0, modl + 1024, WIN_ALL_F8 ? (bf16*)nullptr : (bf16*)(ws + WS_H), ws + WS_H8);
        }
        GRID_BAR();
        PROBE_PHASE(1);
        }
        if (PH(2)) { PHASE_BEGIN();
        { PolWinMix P; P.H = (const char*)(ws + WS_H); P.H8 = (const char*)(ws + WS_H8); P.WIN = (const char*)(ws + WS_WIN); P.WIN8 = (const char*)(ws + WS_WIN8); P.wsb = ws; P.ord.init(T_TOK, D_IN, F.G, bx);
          pg8::gemm_phase(F.lds + RING_OFF, P); }
        }
        GRID_BAR();
        PROBE_PHASE(2);
        if (PH(3)) { PHASE_BEGIN();
        p1_s5fill(F);
        { PolS5a P; P.UG = (const char*)(ws + WS_UG); P.BT1 = (const char*)(ws + WS_BT1); P.SLOC = (float*)(ws + WS_SLOC); P.ldb = 1024; P.G = F.G; P.c = F.vcu;
          pg8::gemm_phase(F.lds + RING_OFF, P); }
        PROBE_PHASE(20);
        hgrn_h1_phase(F, l);
        PROBE_PHASE(21);
        for (int u = F.vcu; u < 256; u += F.G) moba_prep_unit(F, l, u);
        }
        GRID_BAR();
        PROBE_PHASE(3);
        if (PH(4)) { PHASE_BEGIN();
        for (int u = F.vcu; u < 128; u += F.G) s5_carry_unit(F, u);
        for (int u = F.vcu; u < 256; u += F.G) hgrn_carry_unit(F, u);
        if (F.G == 256) {
            const int c = F.vcu & 127; moba_select_unit(F, l, (c >> 4) * 32 + (c & 15) + (F.vcu >= 128 ? 16 : 0)); }
        else for (int u = F.vcu; u < 256; u += F.G) moba_select_unit(F, l, u);
        }
        GRID_BAR();
        PROBE_PHASE(4);
        if (PH(5)) { PHASE_BEGIN();
        if (PH5(0)) { PolS5b P; P.UG = (const char*)(ws + WS_UG); P.S0 = (const char*)(ws + WS_S0); P.BT2 = (const char*)(ws + WS_BT2); P.Dsk = inp(F, I_SSMD) + l * 256; P.YS5 = ws + WS_YS5; P.ldb = 1152; P.G = F.G; P.c = F.vcu;
          pg8::gemm_phase(F.lds + RING_OFF, P); }
        PROBE_PHASE(17);
        if (PH5(1)) hgrn_h3_phase(F, l);
        PROBE_PHASE(18);
        if (PH5(2)) moba_gather_phase(F, l, lds);
        }
        GRID_BAR();
        PROBE_PHASE(5);
        if (PH(6)) { PHASE_BEGIN();
        moba_own_phase(F, lds);
        { PolGlu P; P.A = (const char*)(ws + WS_YS5); P.B = (const char*)(ws + WS_WGLU); P.ord.init(T_TOK, 2048, F.G, bx); P.GL = (const unsigned char*)(ws + WS_GL); P.MERGED = ws + WS_MERGED;
          pg8::gemm_phase(F.lds + RING_OFF, P); }
        }
        GRID_BAR();
        PROBE_PHASE(6);
        if (PH(7)) { PHASE_BEGIN();
        { PolRmw P; P.A1 = (const char*)(ws + WS_OH); P.A2 = (const char*)(ws + WS_OM); P.B1 = (const char*)(ws + WS_WHO); P.B2 = (const char*)(ws + WS_WMO);
          P.GL = (const unsigned char*)(ws + WS_GL); P.MERGED = ws + WS_MERGED; P.ord.init(T_TOK, DM, F.G, bx); P.nper = (P.ord.nwg > P.ord.c) ? (P.ord.nwg - P.ord.c + P.ord.G - 1) / P.ord.G : 0;
          pg8::gemm_phase(F.lds + RING_OFF, P); }
        }
        GRID_BAR();
        PROBE_PHASE(7);
        if (PH(9)) { PHASE_BEGIN();
        { PolWout<(l != 0)> P; P.A = (const char*)(ws + WS_MERGED); P.B = (const char*)(ws + WS_WOUT); P.ord.init(T_TOK, DM, F.G, bx); P.Xin = (l == 0) ? (const void*)inp(F, I_X) : (const void*)XB; P.X = XA; P.gate = modl + 2048;
          pg8::gemm_phase(F.lds + RING_OFF, P); }
        }
        GRID_BAR();
        PROBE_PHASE(9);
        if (PH(10)) { PHASE_BEGIN();
        norm_rows<true, 4>(F, XA, inp(F, I_N2G) + l * DM, modl + 3072, modl + 4096, (bf16*)nullptr, ws + WS_H2_8, (float*)(ws + WS_RSTD));
        p0_convert<true>(F, l, 0x0FC0u);
        WGBAR();
        router_prep(F, l, modl + 3072, modl + 4096);
        }
        GRID_BAR();
        PROBE_PHASE(10);
        if (PH(11)) { PHASE_BEGIN();
        { PolRouter P; P.setup(XA, XPITCH, ws + WS_WRB, DM, T_TOK, 256, F.G, bx); P.Bb = (const char*)(ws + WS_WRB); P.LOG = (float*)(ws + WS_LOGITS); P.RSTD = (const float*)(ws + WS_RSTD); P.PART = (const float*)(ws + WS_RPART);
          pg8::gemm_phase(F.lds + RING_OFF, P);
          if (F.G == 256) { int pm, pn; P.ord.next(0, pm, pn); WGBAR(); moe_route_unit256(F, l, pm); } }
        }
        if (F.G != 256) {
        GRID_BAR();
        for (int u = F.vcu; u < T_TOK / 512; u += F.G) moe_route_unit(F, l, u);
        }
        GRID_BAR();
        PROBE_PHASE(12);
        if (PH(13)) { PHASE_BEGIN();
        moe_tables(F, l, blkpfx, rowpfx);
        for (int u = F.vcu; u < T_TOK / 512; u += F.G) moe_scatter_unit(F, l, u, rowpfx);
        moe_fill_rows(F, l, rowpfx);
        }
        GRID_BAR();
        PROBE_PHASE(13);
        if (PH(14)) { PHASE_BEGIN();
        { PolGateUp P; P.gs.blkpfx = blkpfx; P.gs.nNt = 2; P.gs.G = F.G; P.gs.c = F.vcu; P.H2 = (const char*)(ws + WS_H2_8); P.WGU = (const char*)(ws + WS_WGU);
          P.ROWTOK = (const int*)(ws + WS_ROWTOK); P.ROWW = (const float*)(ws + WS_ROWW); P.HID = ws + WS_HID;
          pg8::gemm_phase(F.lds + RING_OFF, P); }
        }
        GRID_BAR();
        PROBE_PHASE(14);
        if (PH(15)) { PHASE_BEGIN();
        { PolDown P; P.gs.blkpfx = blkpfx; P.gs.nNt = 4; P.gs.G = F.G; P.gs.c = F.vcu; P.HIDp = (const char*)(ws + WS_HID); P.WD = (const char*)(ws + WS_WD); P.Y8 = (unsigned char*)(ws + WS_Y); P.ROWDST = (const int*)(ws + WS_ROWDST);
          pg8::gemm_phase(F.lds + RING_OFF, P); }
        }
        GRID_BAR();
        PROBE_PHASE(15);
        if (PH(16)) { PHASE_BEGIN();
        if (l == 0) moe_combine<true>(F, modl + 5120, XA, XB, rowpfx, inp(F, I_N1G) + DM, MOD + (size_t)8 * 6144 + 0, MOD + (size_t)8 * 6144 + 1024, WIN_ALL_F8 ? (bf16*)nullptr : (bf16*)(ws + WS_H), ws + WS_H8);
        else moe_combine<false>(F, modl + 5120, XA, F.out, rowpfx, nullptr, nullptr, nullptr, nullptr, nullptr);
        }
        GRID_BAR();
        PROBE_PHASE(16);
}
struct Args { const float* in[31]; float* out; unsigned char* ws; int pad0, pad1; };
__global__ void __launch_bounds__(NTHR, 2) fwd_kernel(Args args) {
    extern __shared__ __attribute__((aligned(16))) unsigned char lds[];
    Frame F;
    F.lds = (LAS unsigned char*)lds; F.ldsg = lds;
    F.MISC = (volatile LAS unsigned*)(F.lds + MISC_OFF);
    F.tid = threadIdx.x; F.lane = F.tid & 63; F.wave = __builtin_amdgcn_readfirstlane(F.tid >> 6);
    F.G = gridDim.x; { const int bx = blockIdx.x; F.vcu = (F.G % 8 == 0) ? (bx % 8) * (F.G / 8) + bx / 8 : bx; }
    F.ws = args.ws; F.ctl = (gu32*)(args.ws + WS_CTL); F.out = args.out;
    for (int u = F.tid; u < (LDS_BYTES - LDSCTL_OFF) / 4; u += NTHR) ((LAS unsigned*)(F.lds + LDSCTL_OFF))[u] = 0u;
    __syncthreads();
    if (F.tid < 31) ((LAS unsigned long long*)(F.lds + PTR_OFF))[F.tid] = (unsigned long long)args.in[F.tid];
    __syncthreads();
    XcdBarrier bar = xcd_barrier_post((unsigned*)(F.ctl + CW_BAR), F.MISC + 8);
    unsigned char* ws = F.ws;
    LAS int* blkpfx = (LAS int*)(F.lds + LDSCTL_OFF); LAS int* rowpfx = (LAS int*)(F.lds + LDSCTL_OFF + 320);
    float* MOD = (float*)(ws + WS_MOD);
    const int bx = (int)blockIdx.x;
#ifdef PROBE_MASK
    if (blockIdx.x == 0 && threadIdx.x == 0) { volatile LAS unsigned long long* _pp = (volatile LAS unsigned long long*)(F.lds + MISC_OFF + 64); _pp[0] = 0; _pp[1] = __builtin_amdgcn_s_memrealtime(); }
#endif
    run_layer<0>(F, bar, args.ws, lds, blkpfx, rowpfx, bx);
    run_layer<1>(F, bar, args.ws, lds, blkpfx, rowpfx, bx);
#ifdef PROBE_MASK
    if (blockIdx.x == 0 && threadIdx.x == 0) { const unsigned long long t0 = __builtin_amdgcn_s_memrealtime(); const unsigned long long _pa = ((volatile LAS unsigned long long*)(F.lds + MISC_OFF + 64))[0]; while (__builtin_amdgcn_s_memrealtime() - t0 < 3ull * _pa) __builtin_amdgcn_s_sleep(8); }
#endif
}

extern "C" void kernel_launch(void* const* d_in, const int* in_sizes, int n_in, void* d_out, int out_size, void* d_ws, size_t ws_size, hipStream_t stream) {
    static int grid = 0;
    if (grid == 0) {
        if (n_in != 31 || in_sizes[0] != T_TOK * DM || out_size != T_TOK * DM || ws_size < WS_END) {
            fprintf(stderr, "kernel_launch: unexpected shapes (n_in %d, in0 %d, out %d, ws %zu, need %zu); nothing launched\n", n_in, n_in > 0 ? in_sizes[0] : -1, out_size, ws_size, (size_t)WS_END); grid = -1; return; }
        int dev = 0, cus = 0, per_cu = 0;
        if (hipGetDevice(&dev) != hipSuccess || hipDeviceGetAttribute(&cus, hipDeviceAttributeMultiprocessorCount, dev) != hipSuccess) { grid = -1; return; }
        if (hipFuncSetAttribute((const void*)fwd_kernel, hipFuncAttributeMaxDynamicSharedMemorySize, LDS_BYTES) != hipSuccess) { fprintf(stderr, "kernel_launch: hipFuncSetAttribute failed\n"); grid = -1; return; }
        if (hipOccupancyMaxActiveBlocksPerMultiprocessor(&per_cu, (const void*)fwd_kernel, NTHR, LDS_BYTES) != hipSuccess || per_cu < 1) { fprintf(stderr, "kernel_launch: occupancy query says %d\n", per_cu); }
        (void)hipGetLastError();
        grid = cus;
    }
    if (grid < 0) return;
    if (hipMemsetAsync((char*)d_ws + WS_CTL, 0, CTL_ZERO_BYTES, stream) != hipSuccess) return;
    Args a{};
    for (int i = 0; i < 31; ++i) a.in[i] = (const float*)d_in[i];
    a.out = (float*)d_out; a.ws = (unsigned char*)d_ws; a.pad0 = 0; a.pad1 = 0;
    hipLaunchKernelGGL(fwd_kernel, dim3(grid), dim3(NTHR), LDS_BYTES, stream, a);
}
```

```cpp
#include <hip/hip_runtime.h>
#include <cstdio>
#include <cstdint>

#define GAS __attribute__((address_space(1)))
#define LAS __attribute__((address_space(3)))
typedef unsigned short bf16;
typedef short bf16x8 __attribute__((ext_vector_type(8)));
typedef float f32x4 __attribute__((ext_vector_type(4)));
typedef float f32x2 __attribute__((ext_vector_type(2)));
typedef unsigned u32x4 __attribute__((ext_vector_type(4)));
typedef unsigned u32x2 __attribute__((ext_vector_type(2)));
typedef GAS unsigned gu32;
#define RLX_AGENT __ATOMIC_RELAXED, __HIP_MEMORY_SCOPE_AGENT
#define LDS_WAIT() asm volatile("s_waitcnt lgkmcnt(0)" ::: "memory")
#define VM_WAIT() asm volatile("s_waitcnt vmcnt(0)" ::: "memory")
#define DI __device__ __forceinline__

DI unsigned f2bf(float f) { unsigned u = __builtin_bit_cast(unsigned, f); return (u + 0x7fffu + ((u >> 16) & 1u)) >> 16; }
DI unsigned pk2(float lo, float hi) { return f2bf(lo) | (f2bf(hi) << 16); }
DI float bflo(unsigned w) { return __builtin_bit_cast(float, w << 16); }
DI float bfhi(unsigned w) { return __builtin_bit_cast(float, w & 0xffff0000u); }
DI float bf2f(bf16 b) { return __builtin_bit_cast(float, ((unsigned)b) << 16); }
DI unsigned cvt_pk_bf16(float lo, float hi) { unsigned r; asm volatile("v_cvt_pk_bf16_f32 %0, %1, %2" : "=v"(r) : "v"(lo), "v"(hi)); return r; }
DI float fsigmoid(float x) { return __builtin_amdgcn_rcpf(1.0f + __builtin_amdgcn_exp2f(-1.4426950408889634f * x)); }
DI float fsilu(float x) { return x * fsigmoid(x); }
DI float fexp(float x) { return __builtin_amdgcn_exp2f(1.4426950408889634f * x); }
DI float gelu_tanh(float y) { const float z = 1.5957691216057308f * (y + 0.044715f * y * y * y); return y * fsigmoid(z); }
DI void unpack8(const u32x4 w, float (&o)[8]) { o[0] = bflo(w.x); o[1] = bfhi(w.x); o[2] = bflo(w.y); o[3] = bfhi(w.y); o[4] = bflo(w.z); o[5] = bfhi(w.z); o[6] = bflo(w.w); o[7] = bfhi(w.w); }
DI u32x4 pack8(const float (&v)[8]) { u32x4 w; w.x = cvt_pk_bf16(v[0], v[1]); w.y = cvt_pk_bf16(v[2], v[3]); w.z = cvt_pk_bf16(v[4], v[5]); w.w = cvt_pk_bf16(v[6], v[7]); return w; }

namespace pg8 {
constexpr int BM = 256, BK = 64, HALF = 128, HTB = HALF * BK * 2, STAGE_BYTES = 8 * HTB, NXCD = 8, WGM = 8;
__host__ __device__ __forceinline__ int lds_byte(int r, int c) { const int st = (r >> 4) * 2 + (c >> 5), rr = r & 15, cc = c & 31, ob = rr * 64 + cc * 2; return st * 1024 + (ob ^ (((ob >> 9) & 1) << 5)); }
__host__ __device__ __forceinline__ void stage_rc(int b, int& R, int& C) { const int st = b / 1024, sb = b % 1024, swz = sb ^ (((sb >> 9) & 1) << 5); R = (st >> 1) * 16 + swz / 64; C = (st & 1) * 32 + (swz % 64) / 2; }
__host__ __device__ __forceinline__ int perm32(int rho) { const int n = rho >> 4, i = rho & 15; return 8 * (i >> 2) + 4 * n + (i & 3); }

typedef int v4i_t __attribute__((ext_vector_type(4))); typedef int v8i_t __attribute__((ext_vector_type(8)));
__device__ __forceinline__ v8i_t cat8(bf16x8 a, bf16x8 b) { return __builtin_shufflevector(__builtin_bit_cast(v4i_t, a), __builtin_bit_cast(v4i_t, b), 0, 1, 2, 3, 4, 5, 6, 7); }
__device__ __forceinline__ bf16x8 lo8(v8i_t a) { return __builtin_bit_cast(bf16x8, (v4i_t)__builtin_shufflevector(a, a, 0, 1, 2, 3)); }
__device__ __forceinline__ bf16x8 hi8(v8i_t a) { return __builtin_bit_cast(bf16x8, (v4i_t)__builtin_shufflevector(a, a, 4, 5, 6, 7)); }
struct GU { const char* A; const char* A2; const char* B; int nt1, nt, kstepA, kstepA2, bjump, pm, pn, e, lda, lda2; };

struct TileOrder {
    int nM, nN, nwg, G, c;
    DI void init(int M, int N, int G_, int c_) { nM = M / BM; nN = N / BM; nwg = nM * nN; G = G_; c = c_; }
    DI bool next(int i, int& pm, int& pn) const {
        const long L = (long)i * G + c; if (L >= nwg) return false;
        int wgid = (int)L; { const int q = nwg / NXCD, r = nwg % NXCD, xcd = wgid % NXCD, off = wgid / NXCD; wgid = (xcd < r ? xcd * (q + 1) : r * (q + 1) + (xcd - r) * q) + off; }
        const int nig = WGM * nN, gid = wgid / nig, fm = gid * WGM, gsz = (nM - fm) < WGM ? (nM - fm) : WGM;
        pm = fm + ((wgid % nig) % gsz); pn = (wgid % nig) / gsz; return true;
    }
};

template <class P> __device__ __forceinline__ int ldb2_of(const P& S) { if constexpr (P::MIXED) return S.ldb2; else return S.ldb; }
template <class P, class = void> struct perm16_of { static constexpr bool v = false; };
template <class P> struct perm16_of<P, decltype((void)P::PERM16)> { static constexpr bool v = P::PERM16; };
template <class P, class = void> struct pre_of { struct type {}; static constexpr bool v = false; };
template <class P> struct pre_of<P, decltype((void)sizeof(typename P::Pre))> { using type = typename P::Pre; static constexpr bool v = true; };
template <class P, class = void> struct permsw_of { static constexpr bool v = false; };
template <class P> struct permsw_of<P, decltype((void)P::PERMSW)> { static constexpr bool v = P::PERMSW; };
__host__ __device__ __forceinline__ int perm32sw(int rho) { const int n = rho >> 4, i = rho & 15, q = i >> 2; return 16 * (q & 1) + 8 * (q >> 1) + 4 * n + (i & 3); }
template <class P, class = void> struct perm16f8_of { static constexpr bool v = false; };
template <class P> struct perm16f8_of<P, decltype((void)P::PERM16F8)> { static constexpr bool v = P::PERM16F8; };
__host__ __device__ __forceinline__ int perm16(int R) { return 64 * (R >> 5) + 16 * ((R & 15) >> 2) + 4 * ((R >> 4) & 1) + (R & 3); }
template <class P>
__device__ __forceinline__ void gemm_phase(LAS unsigned char* lds, const P& S) {
    int tid = threadIdx.x; asm volatile("" : "+v"(tid));
    const int wid = __builtin_amdgcn_readfirstlane(tid >> 6), lane = tid & 63, wr = wid >> 2, wc = wid & 3, fr = lane & 15, fq = lane >> 4;
    int R[2], C[2]; unsigned voffB[2], voffB2[2], voffA1[2], voffA2[2];
#pragma unroll
    for (int i = 0; i < 2; ++i) { stage_rc(tid * 16 + i * 8192, R[i], C[i]); const int Rb = perm16_of<P>::v ? perm16(R[i]) : permsw_of<P>::v ? ((R[i] & ~31) + perm32sw(R[i] & 31)) : P::PERM ? ((R[i] & ~31) + perm32(R[i] & 31)) : R[i]; voffB[i] = (unsigned)(Rb * S.ldb + C[i]) * 2u;
        voffA1[i] = (unsigned)(R[i] * S.lda + C[i]) * 2u; voffA2[i] = (unsigned)(R[i] * (S.lda2 - S.lda)) * 2u;
        const int Rb2 = perm16f8_of<P>::v ? perm16(R[i]) : Rb; voffB2[i] = (unsigned)(Rb2 * ldb2_of(S) - Rb * S.ldb) * 2u; }
    const unsigned ldsw = (unsigned)wid * 1024u;
    const int aoff = lds_byte(wr * 64 + fr, fq * 8), boff = lds_byte(wc * 32 + fr, fq * 8);
#define PG8_SA(b, h) (((b) * 2 + (h)) * HTB)
#define PG8_SB(b, h) ((4 + (b) * 2 + (h)) * HTB)
#define PG8_STAGE_A(bufoff, h, U, V, t) do { const int _t = (t); const bool _s2 = P::SEG2 && (_t >= (U).nt1); \
        const char* _gb = (_s2 ? (U).A2 + (size_t)(_t - (U).nt1) * (size_t)(U).kstepA2 : (U).A + (size_t)_t * (size_t)(U).kstepA) + (P::GATHER ? (size_t)0 : (size_t)(h) * (size_t)(128 * 2) * (size_t)(_s2 ? S.lda2 : S.lda)); \
        _Pragma("unroll") for (int _i = 0; _i < 2; ++_i) { const unsigned _o = P::GATHER ? (V)[h][_i] : (P::SEG2 ? (voffA1[_i] + (voffA2[_i] & (0u - (unsigned)_s2))) : voffA1[_i]); \
        __builtin_amdgcn_global_load_lds((const unsigned*)(_gb + _o), (LAS unsigned*)(lds + (bufoff) + ldsw + _i * 8192), 16, 0, 0); } } while (0)
#define PG8_STAGE_B(bufoff, h, U, t) do { const int _t = (t); const bool _m8 = P::MIXED && ((U).e != 0); \
        const char* _gb = (U).B + (size_t)(h) * (size_t)(((perm16_of<P>::v || (perm16f8_of<P>::v && _m8)) ? 8 : 128) * 2) * (size_t)(_m8 ? ldb2_of(S) : S.ldb) + (size_t)_t * 128u + ((P::SEG2 && _t >= (U).nt1) ? (size_t)(U).bjump : (size_t)0); \
        _Pragma("unroll") for (int _i = 0; _i < 2; ++_i) { const unsigned _ob = P::MIXED ? (voffB[_i] + (voffB2[_i] & (0u - (unsigned)_m8))) : voffB[_i]; \
        __builtin_amdgcn_global_load_lds((const unsigned*)(_gb + _ob), (LAS unsigned*)(lds + (bufoff) + ldsw + _i * 8192), 16, 0, 0); } } while (0)
#define PG8_LDA(dst, b, h) do { _Pragma("unroll") for (int m = 0; m < 4; ++m) { if constexpr (P::MIXED) { dst##8[m] = cat8(*(const LAS bf16x8*)(lds + PG8_SA(b, h) + aoff + m * 2048), *(const LAS bf16x8*)(lds + PG8_SA(b, h) + aoff + m * 2048 + 1024)); } \
        else { _Pragma("unroll") for (int k = 0; k < 2; ++k) dst[m][k] = *(const LAS bf16x8*)(lds + PG8_SA(b, h) + aoff + m * 2048 + k * 1024); } } } while (0)
#define PG8_LDB(dst, b, h) do { _Pragma("unroll") for (int n = 0; n < 2; ++n) { if constexpr (P::MIXED) { dst##8[n] = cat8(*(const LAS bf16x8*)(lds + PG8_SB(b, h) + boff + n * 2048), *(const LAS bf16x8*)(lds + PG8_SB(b, h) + boff + n * 2048 + 1024)); } \
        else { _Pragma("unroll") for (int k = 0; k < 2; ++k) dst[n][k] = *(const LAS bf16x8*)(lds + PG8_SB(b, h) + boff + n * 2048 + k * 1024); } } } while (0)
#define PG8_MMA(ai, bj, At, Bt) PG8_MMAX(ai, bj, At, Bt, 0)
#define PG8_MMAX(ai, bj, At, Bt, F8) do { __builtin_amdgcn_s_setprio(1); \
        if constexpr (P::MIXED) { if constexpr (F8) { _Pragma("unroll") for (int m = 0; m < 4; ++m) _Pragma("unroll") for (int n = 0; n < 2; ++n) \
                asm volatile("v_mfma_f32_16x16x128_f8f6f4 %0, %1, %2, %0" : "+v"(acc[ai][bj][m][n]) : "v"(Bt##8[n]), "v"(At##8[m])); } \
            else { _Pragma("unroll") for (int m = 0; m < 4; ++m) _Pragma("unroll") for (int n = 0; n < 2; ++n) { \
                acc[ai][bj][m][n] = __builtin_amdgcn_mfma_f32_16x16x32_bf16(lo8(Bt##8[n]), lo8(At##8[m]), acc[ai][bj][m][n], 0, 0, 0); \
                acc[ai][bj][m][n] = __builtin_amdgcn_mfma_f32_16x16x32_bf16(hi8(Bt##8[n]), hi8(At##8[m]), acc[ai][bj][m][n], 0, 0, 0); } } } \
        else { _Pragma("unroll") for (int m = 0; m < 4; ++m) _Pragma("unroll") for (int n = 0; n < 2; ++n) _Pragma("unroll") for (int k = 0; k < 2; ++k) \
            acc[ai][bj][m][n] = __builtin_amdgcn_mfma_f32_16x16x32_bf16(Bt[n][k], At[m][k], acc[ai][bj][m][n], 0, 0, 0); } \
        __builtin_amdgcn_s_setprio(0); } while (0)
#define PG8_WAIT_V(n) asm volatile("s_waitcnt vmcnt(" #n ")" ::: "memory")
#define PG8_WAIT_V8R() asm volatile("s_cmp_lg_u32 %0, 0\n\ts_cbranch_scc1 1f\n\ts_cmp_eq_u32 %1, 0\n\ts_cbranch_scc1 1f\n\ts_waitcnt vmcnt(%2)\n\ts_branch 2f\n1:\n\ts_waitcnt vmcnt(8)\n2:" :: "s"(tsc), "s"(uisc), "n"(8 + (P::NST < 55 ? P::NST : 55)) : "memory", "scc")
#define PG8_WAIT_L(n) asm volatile("s_waitcnt lgkmcnt(" #n ")" ::: "memory")
#define PG8_BAR __builtin_amdgcn_s_barrier()
#define PG8_SCHED __builtin_amdgcn_sched_barrier(0)
#define PG8_KLOOP(F8) \
        for (int t = 0; t < nt; t += 2) { \
            const bool last = (t == nt - 2); const int tsc = __builtin_amdgcn_readfirstlane(t), uisc = __builtin_amdgcn_readfirstlane(ui); \
            GU U2 = cur; unsigned V2a[2][2]; int t2 = t + 2; \
_Pragma("unroll") \
            for (int h = 0; h < 2; ++h) \
_Pragma("unroll") \
                for (int i = 0; i < 2; ++i) V2a[h][i] = (P::GATHER && last) ? vAn[h][i] : vAc[h][i]; \
            if (last) { U2 = nxt; t2 = 0; } \
            const int t3 = t2 + 1; \
            PG8_LDB(B0, 0, 0); PG8_LDB(B1, 0, 1); PG8_SCHED; PG8_LDA(At, 0, 0); PG8_STAGE_A(PG8_SA(1, 1), 1, cur, vAc, t + 1); \
            PG8_WAIT_V8R(); PG8_WAIT_L(0); PG8_BAR; PG8_MMAX(0, 0, At, B0, F8); PG8_MMAX(0, 1, At, B1, F8); PG8_BAR; PG8_SCHED; \
            PG8_LDA(At, 0, 1); PG8_STAGE_B(PG8_SB(0, 0), 0, U2, t2); PG8_STAGE_B(PG8_SB(0, 1), 1, U2, t2); PG8_STAGE_A(PG8_SA(0, 0), 0, U2, V2a, t2); \
            PG8_WAIT_V8R(); PG8_WAIT_L(0); PG8_BAR; PG8_MMAX(1, 0, At, B0, F8); PG8_MMAX(1, 1, At, B1, F8); PG8_BAR; PG8_SCHED; \
            PG8_LDB(B0, 1, 0); PG8_LDB(B1, 1, 1); PG8_SCHED; PG8_LDA(At, 1, 0); PG8_STAGE_A(PG8_SA(0, 1), 1, U2, V2a, t2); \
            PG8_WAIT_V(8); PG8_WAIT_L(0); PG8_BAR; PG8_MMAX(0, 0, At, B0, F8); PG8_MMAX(0, 1, At, B1, F8); PG8_BAR; PG8_SCHED; \
            PG8_LDA(At, 1, 1); PG8_STAGE_B(PG8_SB(1, 0), 0, U2, t3); PG8_STAGE_B(PG8_SB(1, 1), 1, U2, t3); PG8_STAGE_A(PG8_SA(1, 0), 0, U2, V2a, t3); \
            PG8_WAIT_V(8); PG8_WAIT_L(0); PG8_BAR; PG8_MMAX(1, 0, At, B0, F8); PG8_MMAX(1, 1, At, B1, F8); PG8_BAR; PG8_SCHED; \
        }
    GU cur, nxt; int ui = 0;
    if (!S.next(0, cur)) return;
    unsigned vAc[2][2], vAn[2][2];
    if constexpr (P::GATHER) S.avoff(cur, R, C, vAc); else { vAc[0][0] = vAc[0][1] = vAc[1][0] = vAc[1][1] = 0u; }
    f32x4 acc[2][2][4][2];
#pragma unroll
    for (int a = 0; a < 2; ++a)
#pragma unroll
        for (int b = 0; b < 2; ++b)
#pragma unroll
            for (int m = 0; m < 4; ++m)
#pragma unroll
                for (int n = 0; n < 2; ++n) acc[a][b][m][n] = (f32x4){0.f, 0.f, 0.f, 0.f};
    bf16x8 At[4][2], B0[2][2], B1[2][2]; v8i_t At8[4], B08[2], B18[2];
    typename pre_of<P>::type pre;
    if constexpr (pre_of<P>::v) S.pre(cur, wr, fr, pre);
    PG8_STAGE_B(PG8_SB(0, 0), 0, cur, 0); PG8_STAGE_B(PG8_SB(0, 1), 1, cur, 0); PG8_STAGE_A(PG8_SA(0, 0), 0, cur, vAc, 0); PG8_STAGE_A(PG8_SA(0, 1), 1, cur, vAc, 0);
    if (wr == 1) PG8_BAR;
    PG8_WAIT_V(2); PG8_BAR;
    PG8_STAGE_B(PG8_SB(1, 0), 0, cur, 1); PG8_STAGE_A(PG8_SA(1, 0), 0, cur, vAc, 1); PG8_STAGE_B(PG8_SB(1, 1), 1, cur, 1);
    PG8_WAIT_V(6); PG8_BAR;
    bool has_next = S.next(1, nxt);
    if (!has_next) nxt = cur;
    if constexpr (P::GATHER) { if (has_next) S.avoff(nxt, R, C, vAn); else {
#pragma unroll
        for (int h = 0; h < 2; ++h)
#pragma unroll
            for (int i = 0; i < 2; ++i) vAn[h][i] = vAc[h][i]; } }
    else { vAn[0][0] = vAn[0][1] = vAn[1][0] = vAn[1][1] = 0u; }
    for (;;) {
        const int nt = cur.nt;
        if (P::MIXED && cur.e != 0) { PG8_KLOOP(1) } else { PG8_KLOOP(0) }
        if (wr == 0) PG8_BAR;
        if constexpr (P::MIXED) { PG8_SCHED; asm volatile("s_nop 15\n\ts_nop 15" ::: "memory"); PG8_SCHED; }
        GU nn; unsigned vAnn[2][2]; const bool has_nn = has_next && S.next(ui + 2, nn);
        if constexpr (P::GATHER) { if (has_nn) S.avoff(nn, R, C, vAnn); }
        if constexpr (pre_of<P>::v) S.epi(acc, cur, wr, wc, fr, fq, pre, nxt, has_next); else S.epi(acc, cur, wr, wc, fr, fq);
        if (!has_next) break;
#pragma unroll
        for (int a = 0; a < 2; ++a)
#pragma unroll
            for (int b = 0; b < 2; ++b)
#pragma unroll
                for (int m = 0; m < 4; ++m)
#pragma unroll
                    for (int n = 0; n < 2; ++n) acc[a][b][m][n] = (f32x4){0.f, 0.f, 0.f, 0.f};
        cur = nxt;
#pragma unroll
        for (int h = 0; h < 2; ++h)
#pragma unroll
            for (int i = 0; i < 2; ++i) vAc[h][i] = vAn[h][i];
        has_next = has_nn;
        if (has_nn) { nxt = nn;
            if constexpr (P::GATHER) {
#pragma unroll
                for (int h = 0; h < 2; ++h)
#pragma unroll
                    for (int i = 0; i < 2; ++i) vAn[h][i] = vAnn[h][i]; } }
        ++ui;
        if (wr == 1) PG8_BAR;
    }
    PG8_WAIT_V(0);
    PG8_BAR;
#undef PG8_SA
#undef PG8_SB
#undef PG8_STAGE_A
#undef PG8_STAGE_B
#undef PG8_LDA
#undef PG8_LDB
#undef PG8_MMA
#undef PG8_MMAX
#undef PG8_KLOOP
#undef PG8_WAIT_V
#undef PG8_WAIT_V8R
#undef PG8_WAIT_L
#undef PG8_BAR
#undef PG8_SCHED
}
}
#include <hip/hip_bf16.h>
#include <cmath>
namespace attn_body {
using bf16=__hip_bfloat16;
using bf16x8=__attribute__((ext_vector_type(8)))short;
using s16x4=__attribute__((ext_vector_type(4)))short;
using f32x16=__attribute__((ext_vector_type(16)))float;
using u32x4=__attribute__((ext_vector_type(4)))unsigned;
constexpr int BATCH=8,NHEAD=4,SEQ=8192,D=64,DM=1792;
constexpr int NW=8,QBLK=32,QB=QBLK*NW,KVBLK=64,NQB=SEQ/QB;
constexpr int ATTN_PITCH=DM, ATTN_UNIT_ROWS=QB, OPITCH=256;
__device__ __forceinline__ int crow(int r,int hi){return (r&3)+8*(r>>2)+4*hi;}
#define SBAR() __builtin_amdgcn_sched_barrier(0)
__device__ __forceinline__ void cmask(f32x16&p0,f32x16&p1,int jb,int qrel,int hi){
  const float NEG=-INFINITY; int kb=64*jb+4*hi;
  #pragma unroll
  for(int r=0;r<16;++r){int kv=kb+(r&3)+8*(r>>2); if(kv>qrel)p0[r]=NEG; if(kv+32>qrel)p1[r]=NEG;}
}

constexpr int NSLOT=3, SLOTB=8192;
constexpr int LDS_K=0, LDS_V=NSLOT*SLOTB, LDS_WS=2*NSLOT*SLOTB, LDS_OST=LDS_WS+NW*64*4, LDS_BYTES=LDS_OST+NW*4096;
constexpr float C2=0.125f*1.4426950408889634f;
__device__ __forceinline__ void glds16(const void*gsrc,unsigned lds_dst){unsigned keep;
  asm volatile("s_mov_b32 %0, m0\n\ts_mov_b32 m0, %2\n\ts_nop 0\n\tglobal_load_lds_dwordx4 %1, off\n\ts_mov_b32 m0, %0":"=&s"(keep):"v"(gsrc),"s"(lds_dst):"memory");}
__device__ __forceinline__ float max3f(float a,float b,float c){float r;asm("v_max3_f32 %0, %1, %2, %3":"=v"(r):"v"(a),"v"(b),"v"(c));return r;}
__device__ __forceinline__ float max2f(float a,float b){float r;asm("v_max_f32_e32 %0, %1, %2":"=v"(r):"v"(a),"v"(b));return r;}
__device__ __forceinline__ float fadd_s(float a,float b){float r;asm("v_add_f32_e32 %0, %1, %2":"=v"(r):"v"(a),"v"(b));return r;}
__device__ __forceinline__ float fsub_s(float a,float b){float r;asm("v_sub_f32_e32 %0, %1, %2":"=v"(r):"v"(a),"v"(b));return r;}
typedef float f32x2_t __attribute__((ext_vector_type(2))); typedef __bf16 bf16x2_t __attribute__((ext_vector_type(2)));
__device__ __forceinline__ unsigned cvtpk_s(float lo,float hi){f32x2_t v={lo,hi};bf16x2_t b=__builtin_convertvector(v,bf16x2_t);return __builtin_bit_cast(unsigned,b);}
#define WAIT_BAR(N) asm volatile("s_waitcnt vmcnt(" #N ") lgkmcnt(0)\n\ts_barrier":::"memory")

__device__ __forceinline__ void qkt(f32x16&p0,f32x16&p1,const char*Kslot,const bf16x8*qr,const f32x16&negm,int r32,int hi){
  const char*kb=Kslot+hi*1024+r32*16;
  #pragma unroll
  for(int d0=0;d0<4;++d0){
    const bf16x8 b0=*reinterpret_cast<const bf16x8*>(kb+d0*2048);
    const bf16x8 b1=*reinterpret_cast<const bf16x8*>(kb+d0*2048+512);
    if(d0==0){p0=__builtin_amdgcn_mfma_f32_32x32x16_bf16(b0,qr[0],negm,0,0,0);p1=__builtin_amdgcn_mfma_f32_32x32x16_bf16(b1,qr[0],negm,0,0,0);}
    else{p0=__builtin_amdgcn_mfma_f32_32x32x16_bf16(b0,qr[d0],p0,0,0,0);p1=__builtin_amdgcn_mfma_f32_32x32x16_bf16(b1,qr[d0],p1,0,0,0);}}
}
typedef __attribute__((address_space(3))) const char* lds_cptr;
typedef short v4i16_t __attribute__((ext_vector_type(4)));
__device__ __forceinline__ void kload8(bf16x8*kf,lds_cptr kp){
  kf[0]=*(const __attribute__((address_space(3))) bf16x8*)(kp);      kf[1]=*(const __attribute__((address_space(3))) bf16x8*)(kp+512);
  kf[2]=*(const __attribute__((address_space(3))) bf16x8*)(kp+2048); kf[3]=*(const __attribute__((address_space(3))) bf16x8*)(kp+2560);
  kf[4]=*(const __attribute__((address_space(3))) bf16x8*)(kp+4096); kf[5]=*(const __attribute__((address_space(3))) bf16x8*)(kp+4608);
  kf[6]=*(const __attribute__((address_space(3))) bf16x8*)(kp+6144); kf[7]=*(const __attribute__((address_space(3))) bf16x8*)(kp+6656);
}
__device__ __forceinline__ void kload2(bf16x8*kf,lds_cptr kp,int j){ kf[2*j]=*(const __attribute__((address_space(3))) bf16x8*)(kp+j*2048); kf[2*j+1]=*(const __attribute__((address_space(3))) bf16x8*)(kp+j*2048+512); }
__device__ __forceinline__ s16x4 vtr(lds_cptr p){ return __builtin_bit_cast(s16x4,__builtin_amdgcn_ds_read_tr16_b64_v4i16((__attribute__((address_space(3))) v4i16_t*)p)); }
__device__ __forceinline__ float rowmax(const f32x16&p0,const f32x16&p1){
  float a=max3f(p0[0],p0[1],p1[0]),b=max3f(p0[2],p0[3],p1[1]);a=max3f(a,p1[2],p1[3]);
  #pragma unroll
  for(int r=4;r<16;r+=4){a=max3f(a,p0[r],p0[r+1]);b=max3f(b,p0[r+2],p0[r+3]);a=max3f(a,p1[r],p1[r+1]);b=max3f(b,p1[r+2],p1[r+3]);}
  const float m=max2f(a,b);
  auto rr=__builtin_amdgcn_permlane32_swap(__float_as_uint(m),__float_as_uint(m),false,false);
  return max2f(__uint_as_float(rr[0]),__uint_as_float(rr[1]));
}
__device__ __forceinline__ void pv(f32x16*o,int vb,bf16x8 pa0,bf16x8 pa1,bf16x8 pa2,bf16x8 pa3){
  #pragma unroll
  for(int d0=0;d0<2;++d0){s16x4 lo[4],hi[4];
    #pragma unroll
    for(int ks=0;ks<4;++ks){
      asm volatile("ds_read_b64_tr_b16 %0,%1 offset:%c2":"=&v"(lo[ks]):"v"(vb),"i"(d0*4096+ks*1024):"memory");
      asm volatile("ds_read_b64_tr_b16 %0,%1 offset:%c2":"=&v"(hi[ks]):"v"(vb),"i"(d0*4096+ks*1024+512):"memory");}
    asm volatile("s_waitcnt lgkmcnt(0)":::"memory");SBAR();
    #define PK(k) (bf16x8){lo[k][0],lo[k][1],lo[k][2],lo[k][3],hi[k][0],hi[k][1],hi[k][2],hi[k][3]}
    o[d0]=__builtin_amdgcn_mfma_f32_32x32x16_bf16(pa0,PK(0),o[d0],0,0,0);
    o[d0]=__builtin_amdgcn_mfma_f32_32x32x16_bf16(pa1,PK(1),o[d0],0,0,0);
    o[d0]=__builtin_amdgcn_mfma_f32_32x32x16_bf16(pa2,PK(2),o[d0],0,0,0);
    o[d0]=__builtin_amdgcn_mfma_f32_32x32x16_bf16(pa3,PK(3),o[d0],0,0,0);
    #undef PK
  }
}

#ifndef ATTN_STORE16
#define ATTN_STORE16(p,v) (*(u32x4*)(p)=(v))
#endif
template<int THRL,int MODE> __device__ __forceinline__ void attn_unit(int b,int h,int kvb,const int*qlist,int nvalid,const bf16*Q,const bf16*__restrict__ K,const bf16*__restrict__ V,bf16*O,bf16*PO,float*PML,char*shm){
  int tid_=threadIdx.x; asm volatile("":"+v"(tid_)); const int tid=tid_,lane=tid&63,r32=lane&31,hi=lane>>5; const int wid=__builtin_amdgcn_readfirstlane(tid>>6);
  const long rowbase=(long)b*SEQ; const int q0=kvb*QB;
  int qent=0; if(MODE==0){ int qi=wid*QBLK+r32; qi=qi<nvalid?qi:nvalid-1; qent=qlist[qi]; }
  const long qrow=(MODE==0)?(rowbase+(qent>>2)):(rowbase+q0+wid*QBLK+r32);
  const bf16*Qp=Q+qrow*DM+h*D;
  const bf16*Kh=K+(rowbase+(long)kvb*QB)*DM+h*D,*Vh=V+(rowbase+(long)kvb*QB)*DM+h*D;
  const unsigned lds0=(unsigned)(uintptr_t)shm;
  float*wsf=(float*)(shm+LDS_WS)+wid*64;
  const bf16*ksrc=Kh+(long)lane*DM+wid*8;
  const bf16*vsrc=Vh+(long)(16*(wid&3)+(lane>>2))*DM+(wid>>2)*32+(lane&3)*8;
  const unsigned kdst=lds0+LDS_K+wid*1024, vdst=lds0+LDS_V+wid*1024;
  #define DMA_K(t,slot) glds16(ksrc+(long)(t)*KVBLK*DM,(unsigned)__builtin_amdgcn_readfirstlane(kdst+(slot)))
  #define DMA_V(t,slot) glds16(vsrc+(long)(t)*KVBLK*DM,(unsigned)__builtin_amdgcn_readfirstlane(vdst+(slot)))
  const int vb0=(int)(lds0+LDS_V)+((lane>>4)&1)*32+(lane&3)*8+(4*hi+((lane&15)>>2))*64;
  const char*Kbase=shm+LDS_K; bf16x8 kf[8];
  const lds_cptr shm3=(lds_cptr)shm; const lds_cptr kp0=shm3+LDS_K+hi*1024+r32*16; const lds_cptr vp0=shm3+LDS_V+((lane>>4)&1)*32+(lane&3)*8+(4*hi+((lane&15)>>2))*64;
  const int NT=4;
  DMA_K(0,0);DMA_V(0,0);DMA_K(1,SLOTB);
  bf16x8 qr[4];
  #pragma unroll
  for(int d0=0;d0<4;++d0)qr[d0]=*reinterpret_cast<const bf16x8*>(&Qp[d0*16+hi*8]);
  float pmv_[3]={0.f,0.f,0.f},plv_[3]={0.f,0.f,0.f};
  if(MODE==1){ const long pb_=((rowbase+q0+wid*QBLK+r32)*NHEAD+h)*3; const int ns_=(kvb<3)?kvb:3;
    #pragma unroll
    for(int s_=0;s_<3;++s_) if(s_<ns_){ pmv_[s_]=PML[(pb_+s_)*2]; plv_[s_]=PML[(pb_+s_)*2+1]; } }
  float mhat=0.f,l_reg=0.f;f32x16 o[2];o[0]=f32x16{};o[1]=f32x16{};f32x16 negm=f32x16{};asm volatile("":"+v"(negm));
  const int qrel=wid*QBLK+r32;
  #define CMASK(P0,P1,t) do{ if(MODE==1){ int jb_=(t)-(NT-4); if(jb_>=0)cmask(P0,P1,jb_,qrel,hi); } }while(0)
  bool resc=false;
  #define START(P0,P1) do{ const float rm=rowmax(P0,P1); resc=false; \
    { const float dl=rm; mhat=fadd_s(mhat,dl); \
      _Pragma("unroll") for(int r=0;r<16;++r){P0[r]=fsub_s(P0[r],dl);P1[r]=fsub_s(P1[r],dl);} \
      _Pragma("unroll") for(int r=0;r<16;++r)negm[r]=-mhat; asm volatile("":"+v"(negm)); } \
    _Pragma("unroll") for(int r=0;r<16;++r)P0[r]=__builtin_amdgcn_exp2f(P0[r]); }while(0)
  #define RESC() do{ if(resc){ asm volatile("s_waitcnt lgkmcnt(0)":::"memory"); \
      _Pragma("unroll") for(int d_=0;d_<2;++d_) _Pragma("unroll") for(int r=0;r<16;++r)o[d_][r]*=wsf[crow(r,hi)]; } }while(0)
  f32x16 pA0,pA1,pB0,pB1;
  int sl_prev=0,sl_cur=0,sl_next=SLOTB;
  #define ROT() do{sl_prev=sl_cur;sl_cur=sl_next;sl_next=(sl_next==(NSLOT-1)*SLOTB)?0:sl_next+SLOTB;}while(0)
  DMA_K(2,2*SLOTB);
  WAIT_BAR(3);
  qkt(pA0,pA1,Kbase,qr,negm,r32,hi);asm volatile("s_nop 15\n\ts_nop 7":"+v"(pA0),"+v"(pA1));CMASK(pA0,pA1,0);
  START(pA0,pA1);
  _Pragma("unroll") for(int r=0;r<16;++r)pA1[r]=__builtin_amdgcn_exp2f(pA1[r]);
  WAIT_BAR(0);
  DMA_K(3,0);DMA_V(1,SLOTB);
  ROT();
  kload8(kf,kp0+sl_cur);
  WAIT_BAR(2);
  s16x4 vlo[8],vhi[8]; u32x4 pw0,pw1,pw2,pw3;
  #define PKW(P,B) cvtpk_s(P[B],P[B+1])
  #define PAF(k) __builtin_bit_cast(bf16x8,pw##k)
  #define VFR(i) (bf16x8){vlo[i][0],vlo[i][1],vlo[i][2],vlo[i][3],vhi[i][0],vhi[i][1],vhi[i][2],vhi[i][3]}
  #define PIN(x) asm volatile("":"+v"(x))
  #define MX3(a,b,c) __builtin_fmaxf(__builtin_fmaxf((a),(b)),(c))
  #define GAPA(MF,A0,A1,A2,A3,W0,W1,PW) do{ MF; sacc+=A0; sacc+=A1; sacc+=A2; sacc+=A3; PIN(sacc); W0; W1; PIN(PW); SBAR(); }while(0)
  #define EX(v) __builtin_amdgcn_exp2f(v)
  #define GAPB(MF,X,B) do{ MF; X[B]=EX(X[B]); X[B+1]=EX(X[B+1]); X[B+2]=EX(X[B+2]); X[B+3]=EX(X[B+3]); PIN(X); SBAR(); }while(0)
  #define VRD(i) do{ vlo[i]=vtr(vp_+(((i)>>2)*4096+((i)&3)*1024)); vhi[i]=vtr(vp_+(((i)>>2)*4096+((i)&3)*1024+512)); }while(0)
  #define KRD(G,j) do{ if(G){ kload2(kf,kp0+sl_next,j); SBAR(); } }while(0)
  #define STEP(C0,C1,P0,P1,t,GK,GV,GL) do{ SBAR(); \
    const lds_cptr vp_=vp0+sl_prev; \
    VRD(0); SBAR(); float sacc=(P0[0]+P0[1]); \
    GAPA(C0=__builtin_amdgcn_mfma_f32_32x32x16_bf16(kf[0],qr[0],negm,0,0,0), P0[2],P0[3],P0[4],P0[5],     pw0[0]=PKW(P0,0), pw0[1]=PKW(P0,2), pw0); \
    VRD(4); SBAR(); GAPA(C1=__builtin_amdgcn_mfma_f32_32x32x16_bf16(kf[1],qr[0],negm,0,0,0), P0[6],P0[7],P0[8],P0[9],     pw0[2]=PKW(P0,4), pw0[3]=PKW(P0,6), pw0); \
    VRD(1); SBAR(); GAPA(C0=__builtin_amdgcn_mfma_f32_32x32x16_bf16(kf[2],qr[1],C0,0,0,0),   P0[10],P0[11],P0[12],P0[13], pw1[0]=PKW(P0,8), pw1[1]=PKW(P0,10), pw1); \
    VRD(5); SBAR(); GAPA(C1=__builtin_amdgcn_mfma_f32_32x32x16_bf16(kf[3],qr[1],C1,0,0,0),   P0[14],P0[15],P1[0],P1[1],   pw1[2]=PKW(P0,12),pw1[3]=PKW(P0,14), pw1); \
    VRD(2); SBAR(); GAPA(C0=__builtin_amdgcn_mfma_f32_32x32x16_bf16(kf[4],qr[2],C0,0,0,0),   P1[2],P1[3],P1[4],P1[5],     pw2[0]=PKW(P1,0), pw2[1]=PKW(P1,2), pw2); \
    VRD(6); SBAR(); GAPA(C1=__builtin_amdgcn_mfma_f32_32x32x16_bf16(kf[5],qr[2],C1,0,0,0),   P1[6],P1[7],P1[8],P1[9],     pw2[2]=PKW(P1,4), pw2[3]=PKW(P1,6), pw2); \
    VRD(3); SBAR(); GAPA(C0=__builtin_amdgcn_mfma_f32_32x32x16_bf16(kf[6],qr[3],C0,0,0,0),   P1[10],P1[11],P1[12],P1[13], pw3[0]=PKW(P1,8), pw3[1]=PKW(P1,10), pw3); \
    VRD(7); SBAR(); GAPA(C1=__builtin_amdgcn_mfma_f32_32x32x16_bf16(kf[7],qr[3],C1,0,0,0),   P1[14],P1[15],0.f,0.f,       pw3[2]=PKW(P1,12),pw3[3]=PKW(P1,14), pw3); \
    l_reg+=sacc; \
    if(GK){DMA_K((t)+3,sl_cur);} if(GV){DMA_V((t)+1,sl_next);} \
    CMASK(C0,C1,t); \
    { float a=MX3(C0[0],C0[1],C1[0]),b=MX3(C0[2],C0[3],C1[1]); a=MX3(a,C1[2],C1[3]); \
      _Pragma("unroll") for(int r=4;r<16;r+=4){a=MX3(a,C0[r],C0[r+1]);b=MX3(b,C0[r+2],C0[r+3]);a=MX3(a,C1[r],C1[r+1]);b=MX3(b,C1[r+2],C1[r+3]);} \
      float rm=__builtin_fmaxf(a,b); { auto rr=__builtin_amdgcn_permlane32_swap(__float_as_uint(rm),__float_as_uint(rm),false,false); rm=__builtin_fmaxf(__uint_as_float(rr[0]),__uint_as_float(rr[1])); } \
      resc=false; \
      if(__builtin_expect(__any(rm>(float)THRL),0)){ const float dl=__builtin_fmaxf(rm,0.f); mhat+=dl; \
        _Pragma("unroll") for(int r=0;r<16;++r){C0[r]-=dl;C1[r]-=dl;} \
        _Pragma("unroll") for(int r=0;r<16;++r)negm[r]=-mhat; asm volatile("":"+v"(negm)); \
        const float f=__builtin_amdgcn_exp2f(-dl); l_reg*=f; if(hi==0)wsf[r32]=f; resc=true; } } \
    SBAR(); \
    GAPB(o[0]=__builtin_amdgcn_mfma_f32_32x32x16_bf16(PAF(0),VFR(0),o[0],0,0,0), C0,0); \
    GAPB(o[1]=__builtin_amdgcn_mfma_f32_32x32x16_bf16(PAF(0),VFR(4),o[1],0,0,0), C0,4); \
    KRD(GL,0); GAPB(o[0]=__builtin_amdgcn_mfma_f32_32x32x16_bf16(PAF(1),VFR(1),o[0],0,0,0), C0,8); \
    KRD(GL,1); GAPB(o[1]=__builtin_amdgcn_mfma_f32_32x32x16_bf16(PAF(1),VFR(5),o[1],0,0,0), C0,12); \
    KRD(GL,2); GAPB(o[0]=__builtin_amdgcn_mfma_f32_32x32x16_bf16(PAF(2),VFR(2),o[0],0,0,0), C1,0); \
    KRD(GL,3); GAPB(o[1]=__builtin_amdgcn_mfma_f32_32x32x16_bf16(PAF(2),VFR(6),o[1],0,0,0), C1,4); \
    GAPB(o[0]=__builtin_amdgcn_mfma_f32_32x32x16_bf16(PAF(3),VFR(3),o[0],0,0,0), C1,8); \
    GAPB(o[1]=__builtin_amdgcn_mfma_f32_32x32x16_bf16(PAF(3),VFR(7),o[1],0,0,0), C1,12); \
    }while(0)
  int t=1;
  #undef CMASK
  #define CMASK(P0,P1,t) do{}while(0)
  for(;t+5<NT;t+=2){
    STEP(pB0,pB1,pA0,pA1,t,true,true,true);     WAIT_BAR(2); RESC(); ROT();
    STEP(pA0,pA1,pB0,pB1,t+1,true,true,true);   WAIT_BAR(2); RESC(); ROT();
  }
  #undef CMASK
  #define CMASK(P0,P1,t) do{ if(MODE==1){ int jb_=(t)-(NT-4); if(jb_>=0)cmask(P0,P1,jb_,qrel,hi); } }while(0)
  #define ENDW(tt) do{ if((tt)+3<NT){WAIT_BAR(2);} else if((tt)+2<NT){WAIT_BAR(1);} else {WAIT_BAR(0);} }while(0)
  for(;t+1<NT;t+=2){
    STEP(pB0,pB1,pA0,pA1,t,(t+3<NT),(t+1<NT),(t+1<NT));       ENDW(t);   RESC(); ROT();
    STEP(pA0,pA1,pB0,pB1,t+1,(t+4<NT),(t+2<NT),(t+2<NT));     ENDW(t+1); RESC(); ROT();
  }
  STEP(pB0,pB1,pA0,pA1,NT-1,false,false,false); RESC();
  { float sacc=pB0[0]+pB0[1]; _Pragma("unroll") for(int r=2;r<16;++r)sacc+=pB0[r]; _Pragma("unroll") for(int r=0;r<16;++r)sacc+=pB1[r]; l_reg+=sacc;
    pw0=(u32x4){PKW(pB0,0),PKW(pB0,2),PKW(pB0,4),PKW(pB0,6)};pw1=(u32x4){PKW(pB0,8),PKW(pB0,10),PKW(pB0,12),PKW(pB0,14)};pw2=(u32x4){PKW(pB1,0),PKW(pB1,2),PKW(pB1,4),PKW(pB1,6)};pw3=(u32x4){PKW(pB1,8),PKW(pB1,10),PKW(pB1,12),PKW(pB1,14)};
    SBAR(); pv(o,vb0+sl_cur,PAF(0),PAF(1),PAF(2),PAF(3)); }
  #undef PKW
  #undef PAF
  #undef VFR
  #undef PIN
  #undef MX3
  #undef GAPA
  #undef GAPB
  #undef EX
  #undef VRD
  #undef KRD
  #undef STEP
  #undef ENDW
  {auto rr=__builtin_amdgcn_permlane32_swap(__float_as_uint(l_reg),__float_as_uint(l_reg),false,false);l_reg=__uint_as_float(rr[0])+__uint_as_float(rr[1]);}
  float*xt=(float*)(shm+LDS_BYTES)+wid*128;
  const int nsel=(kvb<3)?kvb:3;
  if(MODE==0){ const int qi=wid*QBLK+r32; const int dst=(qi<nvalid)?(int)(((rowbase+(qent>>2))*NHEAD+h)*3+(qent&3)):-1;
    if(hi==0){ wsf[32+r32]=__builtin_amdgcn_rcpf(l_reg); ((int*)xt)[r32]=dst; if(dst>=0){ PML[(long)dst*2]=mhat; PML[(long)dst*2+1]=l_reg; } } }
  else { if(hi==0){ const long pb=((rowbase+q0+wid*QBLK+r32)*NHEAD+h)*3; float pm[3],pl[3]; float M=mhat;
      #pragma unroll
      for(int s_=0;s_<3;++s_){ pm[s_]=0.f; pl[s_]=0.f; if(s_<nsel){ pm[s_]=pmv_[s_]; pl[s_]=plv_[s_]; M=__builtin_fmaxf(M,pm[s_]); } }
      const float aown=__builtin_amdgcn_exp2f(mhat-M); float L=aown*l_reg; float as_[3];
      #pragma unroll
      for(int s_=0;s_<3;++s_){ as_[s_]=(s_<nsel)?__builtin_amdgcn_exp2f(pm[s_]-M)*pl[s_]:0.f; L+=as_[s_]; }
      const float rL=__builtin_amdgcn_rcpf(L); wsf[32+r32]=aown*rL;
      #pragma unroll
      for(int s_=0;s_<3;++s_) xt[s_*32+r32]=as_[s_]*rL; } }
  asm volatile("s_waitcnt lgkmcnt(0)":::"memory");
  float rli[16];
  #pragma unroll
  for(int r=0;r<16;++r)rli[r]=wsf[32+crow(r,hi)];
  { bf16*stg=(bf16*)(shm+LDS_OST)+wid*2048;
    #pragma unroll
    for(int r=0;r<16;++r){const int orow=crow(r,hi);
      #pragma unroll
      for(int d0=0;d0<2;++d0)stg[orow*64+d0*32+r32]=__float2bfloat16(o[d0][r]*rli[r]);}
    asm volatile("s_waitcnt lgkmcnt(0)":::"memory");
    if(MODE==0){
      #pragma unroll
      for(int i=0;i<4;++i){const int row=i*8+(lane>>3),ch=lane&7; const u32x4 v=*(const u32x4*)(stg+row*64+ch*8); const int dst=((const int*)xt)[row];
        if(dst>=0) ATTN_STORE16(PO+(long)dst*64+ch*8,v);} }
    else { bf16*Ow=O+(rowbase+q0+wid*QBLK)*OPITCH+h*D;
      #pragma unroll
      for(int i=0;i<4;++i){const int row=i*8+(lane>>3),ch=lane&7; const u32x4 v=*(const u32x4*)(stg+row*64+ch*8);
        float f[8]; { const unsigned vw[4]={v.x,v.y,v.z,v.w};
          #pragma unroll
          for(int j=0;j<4;++j){ f[2*j]=__uint_as_float(vw[j]<<16); f[2*j+1]=__uint_as_float(vw[j]&0xffff0000u); } }
        const long pb=((rowbase+q0+wid*QBLK+row)*NHEAD+h)*3;
        #pragma unroll
        for(int s_=0;s_<3;++s_) if(s_<nsel){ const float c_=xt[s_*32+row]; const u32x4 pv=*(const u32x4*)(PO+(pb+s_)*64+ch*8); const unsigned pw[4]={pv.x,pv.y,pv.z,pv.w};
          #pragma unroll
          for(int j=0;j<4;++j){ f[2*j]+=c_*__uint_as_float(pw[j]<<16); f[2*j+1]+=c_*__uint_as_float(pw[j]&0xffff0000u); } }
        { int w0_=0,w1_=0; w0_=__builtin_amdgcn_cvt_pk_fp8_f32(f[0],f[1],w0_,false); w0_=__builtin_amdgcn_cvt_pk_fp8_f32(f[2],f[3],w0_,true); w1_=__builtin_amdgcn_cvt_pk_fp8_f32(f[4],f[5],w1_,false); w1_=__builtin_amdgcn_cvt_pk_fp8_f32(f[6],f[7],w1_,true);
          typedef unsigned u32x2_t __attribute__((ext_vector_type(2)));
          *(u32x2_t*)((unsigned char*)O+((rowbase+q0+wid*QBLK+row)*OPITCH+h*D+ch*8))=(u32x2_t){(unsigned)w0_,(unsigned)w1_}; } } } }
  asm volatile("s_waitcnt lgkmcnt(0)\n\ts_barrier":::"memory");
  #undef DMA_K
  #undef DMA_V
  #undef CMASK
  #undef START
  #undef RESC
  #undef ROT
}
constexpr int ATTN_LDS_BYTES=LDS_BYTES+8*128*4;
#undef SBAR
#undef WAIT_BAR
}

constexpr int NWAVES = 8, NTHR = 512;
constexpr int T_TOK = 65536, SEQ = 8192, NBATCH = 8, DM = 1024, DEPTH = 2;
constexpr int PMP = 1792;
constexpr int GLP = 3072;
constexpr int D_IN = 5120, NEXP = 64, NEXP1 = 65, TOPK = 6, DEXP = 256;
constexpr float EPS = 1e-6f;
constexpr int MAXROWS = 1600 * 256 + T_TOK;
constexpr size_t MiB = 1u << 20;
constexpr size_t WS_CTL = 0, CTL_ZERO_BYTES = 1 * MiB;
constexpr size_t WS_MOD = 1 * MiB;
constexpr size_t WS_KTAB = 2 * MiB;
constexpr size_t WS_A64 = 3 * MiB;
constexpr size_t WS_KMEAN = 4 * MiB;
constexpr size_t WS_WGU = 16 * MiB;
constexpr size_t WS_WD = 81 * MiB;
constexpr size_t WS_WR = WS_WD + (size_t)NEXP1 * 1024 * 256 * 2;
constexpr size_t WS_WIN = 114 * MiB;
constexpr size_t WS_WIN8 = 118 * MiB;
constexpr size_t WS_H8 = 820 * MiB;
constexpr size_t WS_WGLU = 124 * MiB;
constexpr size_t WS_WHO = 125 * MiB;
constexpr size_t WS_WMO = WS_WHO + 512 * 1024;
constexpr size_t WS_WRB = 9 * MiB;
constexpr size_t WS_RPART = 13 * MiB;
constexpr size_t WS_RSTD = 13 * MiB + 65536;
constexpr size_t WS_WOUT = 126 * MiB;
constexpr size_t WS_BT1 = 128 * MiB;
constexpr size_t WS_BT2 = 132 * MiB;
constexpr size_t WS_GL = 168 * MiB;
constexpr size_t WS_PM = 552 * MiB;
constexpr size_t WS_UG = 776 * MiB;
constexpr size_t WS_SLOC = 808 * MiB;
constexpr size_t WS_S0 = 816 * MiB;
constexpr size_t WS_HST = 820 * MiB;
constexpr size_t WS_HSEG = 888 * MiB;
constexpr size_t WS_HLAST = 884 * MiB;
constexpr size_t WS_H = 896 * MiB;
constexpr size_t WS_YS5 = 904 * MiB;
constexpr size_t WS_OH = 936 * MiB;
constexpr size_t WS_OM = 968 * MiB;
constexpr size_t WS_MERGED = 776 * MiB;
constexpr size_t WS_QL = 1000 * MiB;
constexpr size_t WS_PO = 16 * MiB;
constexpr size_t WS_PML = 1016 * MiB;
constexpr size_t WS_H2 = 114 * MiB;
constexpr size_t WS_H2_8 = 242 * MiB;
constexpr size_t WS_LOGITS = 49 * MiB;
constexpr size_t WS_TOPI = 65 * MiB;
constexpr size_t WS_TOPW = WS_TOPI + (size_t)T_TOK * 6 * 4;
constexpr size_t WS_POS = WS_TOPW + (size_t)T_TOK * 6 * 4;
constexpr size_t WS_ROWTOK = WS_POS + (size_t)T_TOK * 6 * 4;
constexpr size_t WS_ROWW = WS_ROWTOK + (size_t)MAXROWS * 4;
constexpr size_t WS_ROWDST = WS_ROWW + (size_t)MAXROWS * 4;
constexpr size_t WS_Y = 306 * MiB;
constexpr size_t WS_HID = 770 * MiB;
constexpr size_t WS_END = WS_HID + (size_t)MAXROWS * 256 * 2;
static_assert(WS_ROWDST + (size_t)MAXROWS * 4 <= 81 * MiB && (size_t)T_TOK * 7 + 1 <= (size_t)MAXROWS && WS_WGU + (size_t)65 * 512 * 1024 <= WS_LOGITS && WS_H2_8 + (size_t)T_TOK * 1024 <= WS_Y && WS_Y + (size_t)MAXROWS * 1024 <= WS_HID && WS_END <= 1024 * MiB, "ws map");
static_assert(WS_WR + 256 * 1024 * 2 <= WS_WIN && WS_BT2 + (size_t)16 * 1024 * 1152 * 2 <= WS_GL, "ws map 2");
constexpr int CW_TMO = 0;
constexpr int CW_CNT = 1024;
constexpr int CW_CUR = 1280;
constexpr int CW_QC = 2048;
constexpr int CW_BAR = 4096;
constexpr int RING_OFF = 0, RING_BYTES = 131072;
constexpr int LDSCTL_OFF = RING_BYTES, MISC_OFF = LDSCTL_OFF + 1024;
constexpr int LDS_BYTES = 147456;

#define XB_TMO      128
#define XB_XCNT(j)  (256  + 64 * (j))
#define XB_XSUB(j)  (1280 + 64 * (j))
#define XB_XGEN(j)  (2304 + 64 * (j))
#define XB_TOP      3328
#define XB_TOPGEN   3392
#define XCD_BAR_WORDS 3456
#define XB_SPIN_CAP (1u << 18)

__device__ __forceinline__ unsigned xb_ld(unsigned* p)              { return __hip_atomic_load(p, __ATOMIC_RELAXED, __HIP_MEMORY_SCOPE_AGENT); }
__device__ __forceinline__ unsigned xb_add(unsigned* p, unsigned v) { return __hip_atomic_fetch_add(p, v, __ATOMIC_RELAXED, __HIP_MEMORY_SCOPE_AGENT); }
__device__ __forceinline__ unsigned xb_xcc_id() { return (unsigned)__builtin_amdgcn_s_getreg((3 << 11) | 20) & 0xFu; }
#define XB_SPIN(cond, bar) do { unsigned _sp = 0; while (cond) { __builtin_amdgcn_s_sleep(1); \
    if ((++_sp & 255u) == 0u) { if (xb_ld(&(bar)[XB_TMO])) break; if (_sp > XB_SPIN_CAP) { atomicAdd(&(bar)[XB_TMO], 1u); break; } } } } while (0)

struct XcdBarrier {
    unsigned* bar; unsigned x;
    volatile LAS unsigned* st;
};

__device__ __forceinline__ XcdBarrier xcd_barrier_post(unsigned* bar, volatile LAS unsigned* st) {
    XcdBarrier b; b.bar = bar; b.x = xb_xcc_id(); b.st = st;
    if (threadIdx.x == 0) (void)xb_add(&bar[XB_XCNT(b.x)], 1u);
    return b;
}
__device__ __forceinline__ void xcd_barrier_complete(unsigned* bar, unsigned x, unsigned& nloc, unsigned& nx) {
    const unsigned G = gridDim.x * gridDim.y * gridDim.z;
    unsigned sum, cnt, mine, sp = 0u;
    for (;;) {
        sum = 0u; cnt = 0u; mine = 0u;
#pragma unroll
        for (unsigned j = 0; j < 16; ++j) { const unsigned c = xb_ld(&bar[XB_XCNT(j)]); sum += c; cnt += (c > 0u) ? 1u : 0u; mine = (j == x) ? c : mine; }
        if (sum == G) break;
        __builtin_amdgcn_s_sleep(1);
        if ((++sp & 255u) == 0u) { if (xb_ld(&bar[XB_TMO])) break; if (sp > XB_SPIN_CAP) { atomicAdd(&bar[XB_TMO], 1u); break; } }
    }
    nloc = mine > 0u ? mine : 1u; nx = cnt > 0u ? cnt : 1u;
}

__device__ __forceinline__ void xcd_barrier(const XcdBarrier& b) {
    asm volatile("s_waitcnt vmcnt(0)" ::: "memory");
    __syncthreads();
    if (threadIdx.x == 0) {
        unsigned* bar = b.bar;
        __builtin_amdgcn_s_waitcnt(0);
        unsigned nloc = b.st[0], nx = b.st[1];
        if (nloc == 0u) { xcd_barrier_complete(bar, b.x, nloc, nx); b.st[0] = nloc; b.st[1] = nx; }
        const unsigned old = xb_add(&bar[XB_XSUB(b.x)], 1u);
        const unsigned gen = old / nloc;
        if (old + 1u == (gen + 1u) * nloc) {
            __builtin_amdgcn_fence(__ATOMIC_RELEASE, "agent");
            asm volatile("s_waitcnt vmcnt(0)" ::: "memory");
            const unsigned og = xb_add(&bar[XB_TOP], 1u);
            const unsigned tg = og / nx;
            if (og + 1u == (tg + 1u) * nx) xb_add(&bar[XB_TOPGEN], 1u);
            else XB_SPIN(xb_ld(&bar[XB_TOPGEN]) == tg, bar);
            __builtin_amdgcn_fence(__ATOMIC_ACQUIRE, "agent");
            xb_add(&bar[XB_XGEN(b.x)], 1u);
            asm volatile("s_waitcnt vmcnt(0)" ::: "memory");
        } else {
            XB_SPIN(xb_ld(&bar[XB_XGEN(b.x)]) == gen, bar);
            __builtin_amdgcn_fence(__ATOMIC_ACQUIRE, "agent");
            asm volatile("s_waitcnt vmcnt(0)" ::: "memory");
        }
    }
    __syncthreads();
}


struct Frame {
    LAS unsigned char* lds; unsigned char* ldsg;
    volatile LAS unsigned* MISC;
    gu32* ctl;
    unsigned char* ws;
    int tid, lane, wave, vcu, G;
    float* out;
};
constexpr int PTR_OFF = 131072 + 2048;
DI const float* inp(const Frame& F, int i) { const LAS unsigned* p = (const LAS unsigned*)(F.lds + PTR_OFF) + 2 * i; const unsigned lo = __builtin_amdgcn_readfirstlane(p[0]), hi = __builtin_amdgcn_readfirstlane(p[1]); return (const float*)(GAS const float*)(((unsigned long long)hi << 32) | lo); }
DI float wave_sum(float v) {
#pragma unroll
    for (int o = 1; o < 64; o <<= 1) v += __shfl_xor(v, o);
    return v;
}
#define WGBAR() do { asm volatile("s_waitcnt vmcnt(0) lgkmcnt(0)" ::: "memory"); __builtin_amdgcn_s_barrier(); asm volatile("" ::: "memory"); } while (0)

enum { I_X = 0, I_C, I_ADAW, I_ADAB, I_N1G, I_WIN, I_LOGDT, I_LRE, I_LIM, I_BRE, I_BIM, I_CRE, I_CIM, I_SSMD, I_WGLU, I_LBL, I_HNG, I_HWO, I_MQG, I_MKG, I_MWO, I_WOUT, I_N2G,
       I_RW, I_RB, I_EWG, I_EWU, I_EWD, I_SWG, I_SWU, I_SWD };

DI int rowmap(int mode, int n) {
    if (mode == 0) return n;
    if (mode == 1) return (n < 1024) ? ((n >> 7) * 256 + (n & 127)) : (((n - 1024) >> 7) * 256 + 128 + ((n - 1024) & 127));
    if (mode == 2) return (n >> 7) * 256 + (n & 127);
    return (n >> 7) * 256 + 128 + (n & 127);
}
template <bool WIDE>
DI void transpose_item(const float* W, int K, int N, int spitch, bf16* WT, int ldk, int mode, int fp8, LAS float* scr, int item, int lane) {
    const int nblk = N / 32, kb = item / nblk, nb = item % nblk, k0 = 64 * kb, n0 = 32 * nb;
    if constexpr (WIDE) {
    { int lq = lane; asm volatile("" : "+v"(lq));
      const int kr = lq >> 3, nc = (lq & 7) * 4; const GAS float* wp = (const GAS float*)W + (size_t)(k0 + kr) * spitch + n0 + nc; LAS float* d = scr + kr * 33 + nc;
#pragma unroll 1
      for (int hh = 0; hh < 2; ++hh) { f32x4 t[4];
#pragma unroll
        for (int i = 0; i < 4; ++i) t[i] = *(const GAS f32x4*)(wp + (size_t)(8 * (4 * hh + i)) * spitch);
#pragma unroll
        for (int i = 0; i < 4; ++i) { LAS float* dd = d + (8 * (4 * hh + i)) * 33; dd[0] = t[i].x; dd[1] = t[i].y; dd[2] = t[i].z; dd[3] = t[i].w; } } }
    } else {
#pragma unroll 8
    for (int i = 0; i < 32; ++i) { const int kk = 2 * i + (lane >> 5); scr[kk * 33 + (lane & 31)] = W[(size_t)(k0 + kk) * spitch + n0 + (lane & 31)]; }
    }
    LDS_WAIT(); asm volatile("" ::: "memory");
    const int c = lane & 7;
#pragma unroll
    for (int j = 0; j < 4; ++j) { const int n = (lane >> 3) + 8 * j; const LAS float* s = scr + (8 * c) * 33 + n;
        if (fp8) { int w0 = 0, w1 = 0; const float sc = (fp8 == 2) ? 1.0f : 64.0f;
            w0 = __builtin_amdgcn_cvt_pk_fp8_f32(s[0 * 33] * sc, s[1 * 33] * sc, w0, false); w0 = __builtin_amdgcn_cvt_pk_fp8_f32(s[2 * 33] * sc, s[3 * 33] * sc, w0, true);
            w1 = __builtin_amdgcn_cvt_pk_fp8_f32(s[4 * 33] * sc, s[5 * 33] * sc, w1, false); w1 = __builtin_amdgcn_cvt_pk_fp8_f32(s[6 * 33] * sc, s[7 * 33] * sc, w1, true);
            *(GAS u32x2*)((unsigned char*)WT + (size_t)rowmap(mode, n0 + n) * ldk + k0 + 8 * c) = (u32x2){(unsigned)w0, (unsigned)w1}; }
        else { u32x4 o; o.x = pk2(s[0 * 33], s[1 * 33]); o.y = pk2(s[2 * 33], s[3 * 33]); o.z = pk2(s[4 * 33], s[5 * 33]); o.w = pk2(s[6 * 33], s[7 * 33]);
        *(GAS u32x4*)(WT + (size_t)rowmap(mode, n0 + n) * ldk + k0 + 8 * c) = o; } }
    LDS_WAIT(); asm volatile("" ::: "memory");
}
struct TJob { const float* src; size_t sstride; int nb, K, N; bf16* dst; size_t dstride; int ldk, mode; int spitch, fp8; };
DI void tp_load(const float* W, int N, int spitch, int item, int lane, f32x4 (&t)[8]) {
    int lq = lane; asm volatile("" : "+v"(lq));
    const int nblk = N / 32, kb = item / nblk, nb = item % nblk, k0 = 64 * kb, n0 = 32 * nb, kr = lq >> 3, nc = (lq & 7) * 4;
    const GAS float* wp = (const GAS float*)W + (size_t)(k0 + kr) * spitch + n0 + nc;
#pragma unroll
    for (int i = 0; i < 8; ++i) t[i] = *(const GAS f32x4*)(wp + (size_t)(8 * i) * spitch);
}
DI void tp_stage(const f32x4 (&t)[8], LAS float* scr, int lane) {
    int lq = lane; asm volatile("" : "+v"(lq));
    const int kr = lq >> 3, nc = (lq & 7) * 4; LAS float* d = scr + kr * 33 + nc;
#pragma unroll
    for (int i = 0; i < 8; ++i) { LAS float* dd = d + (8 * i) * 33; dd[0] = t[i].x; dd[1] = t[i].y; dd[2] = t[i].z; dd[3] = t[i].w; }
}
DI void tp_emit(int N, bf16* WT, int ldk, int mode, int fp8, const LAS float* scr, int item, int lane) {
    const int nblk = N / 32, kb = item / nblk, nb = item % nblk, k0 = 64 * kb, n0 = 32 * nb, c = lane & 7;
#pragma unroll
    for (int j = 0; j < 4; ++j) { const int n = (lane >> 3) + 8 * j; const LAS float* s = scr + (8 * c) * 33 + n;
        if (fp8) { int w0 = 0, w1 = 0; const float sc = (fp8 == 2) ? 1.0f : 64.0f;
            w0 = __builtin_amdgcn_cvt_pk_fp8_f32(s[0 * 33] * sc, s[1 * 33] * sc, w0, false); w0 = __builtin_amdgcn_cvt_pk_fp8_f32(s[2 * 33] * sc, s[3 * 33] * sc, w0, true);
            w1 = __builtin_amdgcn_cvt_pk_fp8_f32(s[4 * 33] * sc, s[5 * 33] * sc, w1, false); w1 = __builtin_amdgcn_cvt_pk_fp8_f32(s[6 * 33] * sc, s[7 * 33] * sc, w1, true);
            *(GAS u32x2*)((unsigned char*)WT + (size_t)rowmap(mode, n0 + n) * ldk + k0 + 8 * c) = (u32x2){(unsigned)w0, (unsigned)w1}; }
        else { u32x4 o; o.x = pk2(s[0 * 33], s[1 * 33]); o.y = pk2(s[2 * 33], s[3 * 33]); o.z = pk2(s[4 * 33], s[5 * 33]); o.w = pk2(s[6 * 33], s[7 * 33]);
        *(GAS u32x4*)(WT + (size_t)rowmap(mode, n0 + n) * ldk + k0 + 8 * c) = o; } }
}
template <bool WIDE>
DI void p0_convert(Frame& F, int l, unsigned jmask) {
    LAS float* scr = (LAS float*)(F.lds + RING_OFF + F.wave * 16384);
    const int gw = F.vcu * NWAVES + F.wave, NGW = F.G * NWAVES;
    unsigned char* ws = F.ws;
    int base = 0;
    auto run = [&](const TJob jb) {
        const int per = (jb.K / 64) * (jb.N / 32), tot = per * jb.nb;
        int first = gw - (base % NGW); if (first < 0) first += NGW;
        if constexpr (WIDE) { f32x4 t[8]; int it = first;
            if (it < tot) tp_load(jb.src + (size_t)(it / per) * jb.sstride, jb.N, jb.spitch, it % per, F.lane, t);
            for (; it < tot; it += NGW) { const int b = it / per, r = it % per, itn = it + NGW;
                tp_stage(t, scr, F.lane); LDS_WAIT(); asm volatile("" ::: "memory");
                if (itn < tot) tp_load(jb.src + (size_t)(itn / per) * jb.sstride, jb.N, jb.spitch, itn % per, F.lane, t);
                tp_emit(jb.N, jb.dst + (size_t)b * jb.dstride, jb.ldk, jb.mode, jb.fp8, scr, r, F.lane);
                LDS_WAIT(); asm volatile("" ::: "memory"); } }
        else {
        for (int it = first; it < tot; it += NGW) { const int b = it / per, r = it % per;
            transpose_item<WIDE>(jb.src + (size_t)b * jb.sstride, jb.K, jb.N, jb.spitch, jb.dst + (size_t)b * jb.dstride, jb.ldk, jb.mode, jb.fp8, scr, r, F.lane); } }
        base += tot;
    };
    if ((jmask >> 0) & 1u) run(TJob{inp(F, I_WIN) + (size_t)l * 1024 * D_IN, 0, 1, 1024, 2048, (bf16*)(ws + WS_WIN), 0, 1024, 0, D_IN, 0});
    if ((jmask >> 1) & 1u) run(TJob{inp(F, I_WGLU) + (size_t)l * 256 * 2048, 0, 1, 256, 2048, (bf16*)(ws + WS_WGLU), 0, 256, 1, 2048, 2});
    if ((jmask >> 2) & 1u) run(TJob{inp(F, I_HWO) + (size_t)l * 256 * 1024, 0, 1, 256, 1024, (bf16*)(ws + WS_WHO), 0, 256, 0, 1024, 2});
    if ((jmask >> 3) & 1u) run(TJob{inp(F, I_MWO) + (size_t)l * 256 * 1024, 0, 1, 256, 1024, (bf16*)(ws + WS_WMO), 0, 256, 0, 1024, 2});
    if ((jmask >> 4) & 1u) run(TJob{inp(F, I_WOUT) + (size_t)l * 1024 * 1024, 0, 1, 1024, 1024, (bf16*)(ws + WS_WOUT), 0, 1024, 0, 1024, 1});
    if ((jmask >> 5) & 1u) run(TJob{inp(F, I_RW) + (size_t)l * 1024 * 64, 0, 1, 1024, 64, (bf16*)(ws + WS_WR), 0, 1024, 0, 64, 0});
    if ((jmask >> 6) & 1u) run(TJob{inp(F, I_EWG) + (size_t)l * NEXP * 1024 * 256, (size_t)1024 * 256, NEXP, 1024, 256, (bf16*)(ws + WS_WGU), (size_t)512 * 512, 1024, 2, 256, 1});
    if ((jmask >> 7) & 1u) run(TJob{inp(F, I_EWU) + (size_t)l * NEXP * 1024 * 256, (size_t)1024 * 256, NEXP, 1024, 256, (bf16*)(ws + WS_WGU), (size_t)512 * 512, 1024, 3, 256, 1});
    if ((jmask >> 8) & 1u) run(TJob{inp(F, I_EWD) + (size_t)l * NEXP * 256 * 1024, (size_t)256 * 1024, NEXP, 256, 1024, (bf16*)(ws + WS_WD), (size_t)1024 * 128, 256, 0, 1024, 2});
    if ((jmask >> 9) & 1u) run(TJob{inp(F, I_SWG) + (size_t)l * 1024 * 256, 0, 1, 1024, 256, (bf16*)(ws + WS_WGU) + (size_t)NEXP * 512 * 512, 0, 1024, 2, 256, 1});
    if ((jmask >> 10) & 1u) run(TJob{inp(F, I_SWU) + (size_t)l * 1024 * 256, 0, 1, 1024, 256, (bf16*)(ws + WS_WGU) + (size_t)NEXP * 512 * 512, 0, 1024, 3, 256, 1});
    if ((jmask >> 11) & 1u) run(TJob{inp(F, I_SWD) + (size_t)l * 256 * 1024, 0, 1, 256, 1024, (bf16*)(ws + WS_WD) + (size_t)NEXP * 1024 * 128, 0, 256, 0, 1024, 2});
    if ((jmask >> 12) & 1u) run(TJob{inp(F, I_WIN) + (size_t)l * 1024 * D_IN, 0, 1, 1024, 5120, (bf16*)(ws + WS_WIN8), 0, 1024, 0, D_IN, 1});
}

DI void p0_adaln(Frame& F) {
    LAS float* cond = (LAS float*)(F.lds + RING_OFF);
    LAS float* red = (LAS float*)(F.lds + RING_OFF + 32768);
    const float* c = inp(F, I_C);
    for (int i = F.tid; i < NBATCH * DM; i += NTHR) cond[i] = fsilu(c[i]);
    WGBAR();
    float* MOD = (float*)(F.ws + WS_MOD);
    const int col = F.tid & 63, kc = F.tid >> 6;
    for (int u = F.vcu; u < DEPTH * 96; u += F.G) {
        const int l = u / 96, n0 = (u % 96) * 64;
        const float* W = inp(F, I_ADAW) + (size_t)l * DM * 6144 + n0 + col;
        float a[8];
#pragma unroll
        for (int b = 0; b < 8; ++b) a[b] = 0.f;
        for (int k0 = kc * 128; k0 < kc * 128 + 128; k0 += 16) { float w16[16];
#pragma unroll
          for (int i = 0; i < 16; ++i) w16[i] = W[(size_t)(k0 + i) * 6144];
#pragma unroll
          for (int i = 0; i < 16; ++i) { const int k = k0 + i; const float w = w16[i];
#pragma unroll
            for (int b = 0; b < 8; ++b) a[b] += w * cond[b * DM + k]; } }
#pragma unroll
        for (int b = 0; b < 8; ++b) red[(kc * 8 + b) * 64 + col] = a[b];
        WGBAR();
        { const int b = F.tid >> 6; float s = 0.f;
#pragma unroll
          for (int q = 0; q < 8; ++q) s += red[(q * 8 + b) * 64 + col];
          MOD[((size_t)l * 8 + b) * 6144 + n0 + col] = s + inp(F, I_ADAB)[(size_t)l * 6144 + n0 + col]; }
        WGBAR();
    }
}

DI void cis(float ang, float& c, float& s) { s = sinf(ang); c = cosf(ang); }

DI void p0_s5tab(Frame& F, int l) {
    LAS float* L = (LAS float*)(F.lds + RING_OFF);
    constexpr int US = 4608;
    float* KTAB = (float*)(F.ws + WS_KTAB); float* A64 = (float*)(F.ws + WS_A64);
    bf16* BT1 = (bf16*)(F.ws + WS_BT1); bf16* BT2 = (bf16*)(F.ws + WS_BT2);
    const float* cre = inp(F, I_CRE) + (size_t)l * 16 * 16 * 64; const float* cim = inp(F, I_CIM) + (size_t)l * 16 * 16 * 64;
    const float* bre = inp(F, I_BRE) + (size_t)l * 16 * 64 * 16; const float* bim = inp(F, I_BIM) + (size_t)l * 16 * 64 * 16;
    for (int ub = F.vcu; ub < 1024; ub += 4 * F.G) {
    if (F.tid < 256 && ub + (F.tid >> 6) * F.G < 1024) { const int k = F.tid >> 6, p = F.tid & 63, uu = ub + k * F.G, g = uu >> 6, j = uu & 63; LAS float* U = L + k * US;
        const float dt = expf(inp(F, I_LOGDT)[l * 16 + g]); const float lr = inp(F, I_LRE)[(l * 16 + g) * 64 + p], li = inp(F, I_LIM)[(l * 16 + g) * 64 + p];
        float cr, sr; const float mag = expf(lr * dt); cis(li * dt, cr, sr); const float ar = mag * cr, ai = mag * sr;
        const float inv = 1.0f / (lr * lr + li * li);
        U[384 + 2 * p] = ((ar - 1.0f) * lr + ai * li) * inv; U[384 + 2 * p + 1] = (ai * lr - (ar - 1.0f) * li) * inv;
        float m, c2, s2;
        m = expf((float)j * lr * dt); cis((float)j * (li * dt), c2, s2); U[2 * p] = m * c2; U[2 * p + 1] = m * s2;
        m = expf((float)(j + 1) * lr * dt); cis((float)(j + 1) * (li * dt), c2, s2); U[128 + 2 * p] = m * c2; U[128 + 2 * p + 1] = m * s2;
        m = expf((float)(63 - j) * lr * dt); cis((float)(63 - j) * (li * dt), c2, s2); U[256 + 2 * p] = m * c2; U[256 + 2 * p + 1] = m * s2;
        if (j == 0) { m = expf(64.0f * lr * dt); cis(64.0f * (li * dt), c2, s2); A64[(g * 64 + p) * 2] = m * c2; A64[(g * 64 + p) * 2 + 1] = m * s2; }
    }
    WGBAR();
    for (int ee = F.tid; ee < 4096; ee += NTHR) { const int k = ee >> 10, e = ee & 1023, uu = ub + k * F.G, g = uu >> 6, p = e >> 4, h = e & 15; LAS float* U = L + k * US; if (uu >= 1024) continue;
        const float br = bre[(g * 64 + p) * 16 + h], bi = bim[(g * 64 + p) * 16 + h], cr = U[384 + 2 * p], ci = U[384 + 2 * p + 1];
        const float xr = cr * br - ci * bi, xi = cr * bi + ci * br; U[512 + 2 * e] = xr; U[512 + 2 * e + 1] = xi;
        const float ar = U[2 * p], ai = U[2 * p + 1]; U[2560 + 2 * e] = ar * xr - ai * xi; U[2560 + 2 * e + 1] = ar * xi + ai * xr; }
    WGBAR();
    for (int it = F.tid; it < 1024; it += NTHR) { const int k = it >> 8, t1 = it & 255, uu = ub + k * F.G, g = uu >> 6, j = uu & 63, hp = t1 >> 4, h = t1 & 15; const LAS float* Z = L + k * US + 2560; float s = 0.f; if (uu >= 1024) continue;
        for (int p = 0; p < 64; ++p) s += cre[(g * 16 + hp) * 64 + p] * Z[2 * (p * 16 + h)] - cim[(g * 16 + hp) * 64 + p] * Z[2 * (p * 16 + h) + 1];
        KTAB[((g * 64 + j) * 16 + hp) * 16 + h] = s; }
    for (int ee = F.tid; ee < 8192; ee += NTHR) { const int k = ee >> 11, e = ee & 2047, uu = ub + k * F.G, g = uu >> 6, j = uu & 63, hp = e >> 7, q = e & 127, p = q & 63; const LAS float* AJ1 = L + k * US + 128; if (uu >= 1024) continue;
        const float c_r = cre[(g * 16 + hp) * 64 + p], c_i = cim[(g * 16 + hp) * 64 + p], ar = AJ1[2 * p], ai = AJ1[2 * p + 1];
        const float v = (q < 64) ? (c_r * ar - c_i * ai) : -(c_r * ai + c_i * ar);
        BT2[((size_t)(g * 1024 + j * 16 + hp)) * 1152 + 1024 + q] = (bf16)f2bf(v); }
    for (int ee = F.tid; ee < 8192; ee += NTHR) { const int k = ee >> 11, e = ee & 2047, uu = ub + k * F.G, g = uu >> 6, j = uu & 63, q = e >> 4, h = e & 15, p = q & 63; const LAS float* U = L + k * US; if (uu >= 1024) continue;
        const float ar = U[256 + 2 * p], ai = U[256 + 2 * p + 1], xr = U[512 + 2 * (p * 16 + h)], xi = U[512 + 2 * (p * 16 + h) + 1];
        const float v = (q < 64) ? (ar * xr - ai * xi) : (ar * xi + ai * xr);
        BT1[((size_t)(g * 128 + q)) * 1024 + j * 16 + h] = (bf16)f2bf(v); }
    WGBAR();
    }
}
DI void p1_s5fill(Frame& F) {
    const float* KTAB = (const float*)(F.ws + WS_KTAB); bf16* BT2 = (bf16*)(F.ws + WS_BT2);
    const size_t gt = (size_t)F.vcu * NTHR + F.tid, GT = (size_t)F.G * NTHR;
    for (size_t it = gt; it < (size_t)16 * 1024 * 128; it += GT) {
        const int kc = (int)(it & 127), n = (int)((it >> 7) & 1023), g = (int)(it >> 17);
        const int tau = n >> 4, hp = n & 15, sigma = kc >> 1, h0 = (kc & 1) * 8;
        if (sigma > (tau | 15)) continue;
        u32x4 o = (u32x4){0u, 0u, 0u, 0u};
        if (sigma <= tau) { const float* s = KTAB + ((g * 64 + (tau - sigma)) * 16 + hp) * 16 + h0;
            const f32x4 a = *(const f32x4*)s, b = *(const f32x4*)(s + 4); o.x = pk2(a.x, a.y); o.y = pk2(a.z, a.w); o.z = pk2(b.x, b.y); o.w = pk2(b.z, b.w); }
        *(u32x4*)(BT2 + ((size_t)(g * 1024 + n)) * 1152 + kc * 8) = o;
    }
}

constexpr int XPITCH = 2048;
template <bool IN16>
DI void norm_load(const void* X, int m, int lane, float (&v)[2][8]) {
#pragma unroll
    for (int j = 0; j < 2; ++j) { const int col = 8 * lane + 512 * j;
        if (IN16) unpack8(*(const GAS u32x4*)((const bf16*)X + (size_t)m * XPITCH + col), v[j]);
        else { const GAS f32x4* p = (const GAS f32x4*)((const float*)X + (size_t)m * DM + col); const f32x4 a = p[0], b = p[1]; v[j][0] = a.x; v[j][1] = a.y; v[j][2] = a.z; v[j][3] = a.w; v[j][4] = b.x; v[j][5] = b.y; v[j][6] = b.z; v[j][7] = b.w; } }
}
template <bool IN16, int NR>
DI void norm_rows(Frame& F, const void* X, const float* gain, const float* shift, const float* scale, bf16* O, unsigned char* O8, float* RSTD = nullptr) {
    const int gw = F.vcu * NWAVES + F.wave, NGW = F.G * NWAVES;
    for (int m = gw; m < T_TOK; m += NR * NGW) {
        float v[NR][2][8]; float rstd[NR];
#pragma unroll
        for (int r = 0; r < NR; ++r) { const int mm = (m + r * NGW < T_TOK) ? m + r * NGW : m; norm_load<IN16>(X, mm, F.lane, v[r]); }
#pragma unroll
        for (int r = 0; r < NR; ++r) { float s2 = 0.f;
#pragma unroll
            for (int j = 0; j < 2; ++j)
#pragma unroll
                for (int k = 0; k < 8; ++k) s2 += v[r][j][k] * v[r][j][k];
            rstd[r] = 1.0f / sqrtf(wave_sum(s2) * (1.0f / DM) + EPS); }
#pragma unroll
        for (int r = 0; r < NR; ++r) { const int mm = m + r * NGW; if (mm >= T_TOK) break; const int b = mm >> 13; const float rs = rstd[r]; if (RSTD && F.lane == 0) RSTD[mm] = rs;
#pragma unroll
            for (int j = 0; j < 2; ++j) { const int col = 8 * F.lane + 512 * j; float y[8];
#pragma unroll
                for (int h = 0; h < 2; ++h) { const f32x4 g = *(const f32x4*)(gain + col + 4 * h), sh = *(const f32x4*)(shift + b * 6144 + col + 4 * h), sc = *(const f32x4*)(scale + b * 6144 + col + 4 * h);
                    const float* xv = v[r][j];
                    y[4 * h + 0] = xv[4 * h + 0] * rs * g.x * (sc.x + 1.0f) + sh.x; y[4 * h + 1] = xv[4 * h + 1] * rs * g.y * (sc.y + 1.0f) + sh.y;
                    y[4 * h + 2] = xv[4 * h + 2] * rs * g.z * (sc.z + 1.0f) + sh.z; y[4 * h + 3] = xv[4 * h + 3] * rs * g.w * (sc.w + 1.0f) + sh.w; }
                u32x4 w; if (O) { w.x = pk2(y[0], y[1]); w.y = pk2(y[2], y[3]); w.z = pk2(y[4], y[5]); w.w = pk2(y[6], y[7]); *(GAS u32x4*)(O + (size_t)mm * DM + col) = w; }
                if (O8) { int q0 = 0, q1 = 0; q0 = __builtin_amdgcn_cvt_pk_fp8_f32(y[0], y[1], q0, false); q0 = __builtin_amdgcn_cvt_pk_fp8_f32(y[2], y[3], q0, true);
                    q1 = __builtin_amdgcn_cvt_pk_fp8_f32(y[4], y[5], q1, false); q1 = __builtin_amdgcn_cvt_pk_fp8_f32(y[6], y[7], q1, true);
                    *(GAS u32x2*)(O8 + (size_t)mm * DM + col) = (u32x2){(unsigned)q0, (unsigned)q1}; } } }
    }
}

DI void router_prep(Frame& F, int l, const float* shift2, const float* scale2) {
    const float* Wr = inp(F, I_RW) + (size_t)l * 1024 * 64; const float* g2 = inp(F, I_N2G) + l * DM;
    bf16* WRB = (bf16*)(F.ws + WS_WRB); float* PART = (float*)(F.ws + WS_RPART);
    for (int it = F.vcu * NTHR + F.tid; it < 8 * 128 * 64; it += F.G * NTHR) { const int e = it & 63, kc = (it >> 6) & 127, b = it >> 13; float w[8];
#pragma unroll
        for (int j = 0; j < 8; ++j) { const int k = kc * 8 + j; w[j] = Wr[(size_t)k * 64 + e] * g2[k] * (1.0f + scale2[b * 6144 + k]); }
        *(u32x4*)(WRB + ((size_t)(b * 256 + e)) * 1024 + kc * 8) = pack8(w); }
    LAS float* red = (LAS float*)(F.lds + RING_OFF);
    for (int u = F.vcu; u < 64; u += F.G) { const int b = u >> 3, kseg = u & 7, e = F.tid & 63, kk = F.tid >> 6; float s = 0.f;
#pragma unroll
        for (int i = 0; i < 16; ++i) { const int k = kseg * 128 + kk * 16 + i; s += shift2[b * 6144 + k] * Wr[(size_t)k * 64 + e]; }
        red[kk * 64 + e] = s;
        WGBAR();
        if (F.tid < 64) { float t = 0.f;
#pragma unroll
            for (int q = 0; q < 8; ++q) t += red[q * 64 + F.tid];
            PART[(b * 8 + kseg) * 64 + F.tid] = t; }
        WGBAR(); }
}

typedef const f32x4 (&AccRef)[2][2][4][2];
DI unsigned fp8x4(float a, float b, float c, float d) { int w = __builtin_bit_cast(int, a); w = __builtin_amdgcn_cvt_pk_fp8_f32(a, b, w, false); w = __builtin_amdgcn_cvt_pk_fp8_f32(c, d, w, true); return (unsigned)w; }
DI void unfp8x4(unsigned w, float (&o)[4]) { const f32x2 lo = __builtin_amdgcn_cvt_pk_f32_fp8((int)w, false), hi = __builtin_amdgcn_cvt_pk_f32_fp8((int)w, true); o[0] = lo.x; o[1] = lo.y; o[2] = hi.x; o[3] = hi.y; }
DI void plain_avoff(int lda, const int (&R)[2], const int (&C)[2], unsigned (&v)[2][2]) {
#pragma unroll
    for (int h = 0; h < 2; ++h)
#pragma unroll
        for (int i = 0; i < 2; ++i) v[h][i] = (unsigned)(((h * 128 + R[i]) * lda + C[i]) * 2);
}
DI void acc8(AccRef acc, int ai, int bj, int m, float (&v)[8]) {
    const f32x4 a = acc[ai][bj][m][0], b = acc[ai][bj][m][1]; v[0] = a.x; v[1] = a.y; v[2] = a.z; v[3] = a.w; v[4] = b.x; v[5] = b.y; v[6] = b.z; v[7] = b.w;
}
struct PlainBase {
    static constexpr bool SEG2 = false, GATHER = false, MIXED = false;
    const char* A; const char* B; int lda, lda2, ldb, K; pg8::TileOrder ord;
    DI void setup(const void* A_, int lda_, const void* B_, int K_, int M, int N, int G, int c) { A = (const char*)A_; B = (const char*)B_; lda = lda_; lda2 = lda_; ldb = K_; K = K_; ord.init(M, N, G, c); }
    DI bool next(int i, pg8::GU& u) const { int pm, pn; if (!ord.next(i, pm, pn)) return false;
        u.pm = pm; u.pn = pn; u.e = 0; u.A = A + (size_t)pm * 256 * lda * 2; u.A2 = u.A; u.B = B + (size_t)pn * 256 * ldb * 2; u.nt1 = u.nt = K / 64; u.kstepA = 128; u.kstepA2 = 128; u.bjump = 0; u.lda = lda; u.lda2 = lda; return true; }
};
struct PolWin : PlainBase {
    static constexpr int NST = 16; static constexpr bool PERM = true;
    unsigned char* wsb;
    DI void epi(AccRef acc, const pg8::GU& u, int wr, int wc, int fr, int fq) const {
        int pitch; int coff[2]; const bool sig = u.pn >= 8;
#pragma unroll
        for (int bj = 0; bj < 2; ++bj) { const int c0 = bj * 128 + wc * 32 + fq * 8;
            coff[bj] = (u.pn == 0) ? ((c0 >> 4) * (T_TOK * 16) + (c0 & 15)) : (u.pn < 8) ? ((u.pn - 1) * 256 + c0) : ((u.pn - 8) * 256 + c0); }
        const size_t boff = (u.pn == 0) ? WS_UG : (u.pn < 8) ? WS_PM : WS_GL; pitch = (u.pn == 0) ? 16 : (u.pn < 8) ? PMP : GLP; bf16* base = (bf16*)(wsb + boff);
#pragma unroll
        for (int ai = 0; ai < 2; ++ai)
#pragma unroll
            for (int m = 0; m < 4; ++m) { const size_t t = (size_t)(u.pm * 256 + ai * 128 + wr * 64 + m * 16 + fr);
#pragma unroll
                for (int bj = 0; bj < 2; ++bj) { float v[8]; acc8(acc, ai, bj, m, v);
                    if (sig) {
#pragma unroll
                        for (int j = 0; j < 8; ++j) v[j] = fsigmoid(v[j]); }
                    *(u32x4*)(base + t * pitch + coff[bj]) = pack8(v); }
                asm volatile("" ::: "memory"); __builtin_amdgcn_sched_barrier(0); }
    }
};
constexpr float W8_SCALE = 64.0f;
constexpr bool WIN_ALL_F8 = true;
constexpr unsigned WIN_F8_TILES = 0xFFFFFu;
struct PolWinMix {
    static constexpr int NST = 8; static constexpr bool PERM = true, PERM16F8 = true, SEG2 = true, GATHER = false, MIXED = true;
    const char* H; const char* H8; const char* WIN; const char* WIN8; unsigned char* wsb; pg8::TileOrder ord;
    static constexpr int lda = 1024, lda2 = 512, ldb = 1024, ldb2 = 512;
    DI bool next(int i, pg8::GU& u) const { int pm, pn; if (!ord.next(i, pm, pn)) return false; u.pm = pm; u.pn = pn; const bool f8 = ((WIN_F8_TILES >> pn) & 1u) != 0; u.e = f8 ? 1 : 0;
        u.A = H + (size_t)pm * 256 * 1024 * 2; u.A2 = H8 + (size_t)pm * 256 * 1024; u.B = f8 ? (WIN8 + (size_t)pn * 256 * 1024) : (WIN + (size_t)pn * 256 * 1024 * 2);
        u.nt = f8 ? 8 : 16; u.nt1 = f8 ? 0 : 16; u.kstepA = 128; u.kstepA2 = 128; u.bjump = 0; u.lda = 1024; u.lda2 = 512; return true; }
    DI void epi(AccRef acc, const pg8::GU& u, int wr, int wc, int fr, int fq) const {
        if (u.pn >= 8) {
            unsigned char* base = wsb + WS_GL + ((size_t)u.pm * 256 + wr * 64 + fr) * GLP + (u.pn - 8) * 256 + wc * 64 + fq * 16;
#pragma unroll
            for (int ai = 0; ai < 2; ++ai)
#pragma unroll
                for (int m = 0; m < 4; ++m) { u32x4 o;
#pragma unroll
                    for (int bj = 0; bj < 2; ++bj) { float v[8]; acc8(acc, ai, bj, m, v);
#pragma unroll
                        for (int j = 0; j < 8; ++j) v[j] = fsigmoid(v[j] * (1.0f / W8_SCALE));
                        int w0 = __builtin_bit_cast(int, v[0]), w1 = __builtin_bit_cast(int, v[4]);
                        w0 = __builtin_amdgcn_cvt_pk_fp8_f32(v[0], v[1], w0, false); w0 = __builtin_amdgcn_cvt_pk_fp8_f32(v[2], v[3], w0, true);
                        w1 = __builtin_amdgcn_cvt_pk_fp8_f32(v[4], v[5], w1, false); w1 = __builtin_amdgcn_cvt_pk_fp8_f32(v[6], v[7], w1, true);
                        if (bj == 0) { o.x = (unsigned)w0; o.y = (unsigned)w1; } else { o.z = (unsigned)w0; o.w = (unsigned)w1; } }
                    *(u32x4*)(base + (size_t)(ai * 128 + m * 16) * GLP) = o;
                    if (m == 3) { asm volatile("" ::: "memory"); __builtin_amdgcn_sched_barrier(0); } }
            return; }
        if (((WIN_F8_TILES & 0xFFu) == 0xFFu) || u.e != 0) {
            const int c16 = wc * 64 + fq * 16; bf16* base = (u.pn == 0) ? (bf16*)(wsb + WS_UG) + ((size_t)(c16 >> 4) * T_TOK) * 16 : (bf16*)(wsb + WS_PM) + (u.pn - 1) * 256 + c16; const int pitch = (u.pn == 0) ? 16 : PMP;
#pragma unroll
            for (int ai = 0; ai < 2; ++ai)
#pragma unroll
                for (int m = 0; m < 4; ++m) { const size_t t = (size_t)(u.pm * 256 + ai * 128 + wr * 64 + m * 16 + fr);
#pragma unroll
                    for (int bj = 0; bj < 2; ++bj) { float v[8]; acc8(acc, ai, bj, m, v);
#pragma unroll
                        for (int j = 0; j < 8; ++j) v[j] *= (1.0f / W8_SCALE);
                        *(u32x4*)(base + t * pitch + bj * 8) = pack8(v); }
                    asm volatile("" ::: "memory"); __builtin_amdgcn_sched_barrier(0); }
            return; }
        if constexpr ((WIN_F8_TILES & 0xFFu) != 0xFFu) {
        int pitch; int coff[2];
#pragma unroll
        for (int bj = 0; bj < 2; ++bj) { const int c0 = bj * 128 + wc * 32 + fq * 8;
            coff[bj] = (u.pn == 0) ? ((c0 >> 4) * (T_TOK * 16) + (c0 & 15)) : ((u.pn - 1) * 256 + c0); }
        const size_t boff = (u.pn == 0) ? WS_UG : WS_PM; pitch = (u.pn == 0) ? 16 : PMP; bf16* base = (bf16*)(wsb + boff);
#pragma unroll
        for (int ai = 0; ai < 2; ++ai)
#pragma unroll
            for (int m = 0; m < 4; ++m) { const size_t t = (size_t)(u.pm * 256 + ai * 128 + wr * 64 + m * 16 + fr);
#pragma unroll
                for (int bj = 0; bj < 2; ++bj) { float v[8]; acc8(acc, ai, bj, m, v);
                    *(u32x4*)(base + t * pitch + coff[bj]) = pack8(v); }
                asm volatile("" ::: "memory"); __builtin_amdgcn_sched_barrier(0); }
        }
    }
};
DI void gates8(const u32x2 w, float (&g)[8]) {
    const f32x2 a = __builtin_amdgcn_cvt_pk_f32_fp8((int)w.x, false), b = __builtin_amdgcn_cvt_pk_f32_fp8((int)w.x, true), c = __builtin_amdgcn_cvt_pk_f32_fp8((int)w.y, false), d = __builtin_amdgcn_cvt_pk_f32_fp8((int)w.y, true);
    g[0] = a.x; g[1] = a.y; g[2] = b.x; g[3] = b.y; g[4] = c.x; g[5] = c.y; g[6] = d.x; g[7] = d.y;
}
struct PolS5a {
    static constexpr int NST = 16; static constexpr bool PERM = false, SEG2 = false, GATHER = false, MIXED = false;
    const char* UG; const char* BT1; float* SLOC; int ldb, G, c; static constexpr int lda = 1024, lda2 = 1024;
    DI bool next(int i, pg8::GU& u) const { const int L = i * G + c; if (L >= 64) return false; u.pm = L & 3; u.e = L >> 2; u.pn = 0;
        u.A = UG + ((size_t)u.e * T_TOK * 16 + (size_t)u.pm * 256 * 1024) * 2; u.A2 = u.A; u.B = BT1 + (size_t)u.e * 128 * 1024 * 2; u.nt1 = u.nt = 16; u.kstepA = 128; u.kstepA2 = 128; u.bjump = 0; u.lda = 1024; u.lda2 = 1024; return true; }
    DI void epi(AccRef acc, const pg8::GU& u, int wr, int wc, int fr, int fq) const {
#pragma unroll
        for (int ai = 0; ai < 2; ++ai)
#pragma unroll
            for (int m = 0; m < 4; ++m) { const int row = u.pm * 256 + ai * 128 + wr * 64 + m * 16 + fr;
#pragma unroll
                for (int n = 0; n < 2; ++n) *(f32x4*)(SLOC + ((size_t)row * 16 + u.e) * 128 + wc * 32 + n * 16 + fq * 4) = acc[ai][0][m][n]; }
    }
};
struct PolS5b {
    static constexpr int NST = 16; static constexpr bool PERM = true, SEG2 = true, GATHER = false, MIXED = false;
    const char* UG; const char* S0; const char* BT2; const float* Dsk; unsigned char* YS5; int ldb, G, c; static constexpr int lda = 1024, lda2 = 2048;
    DI bool next(int i, pg8::GU& u) const { const int L = i * G + c; if (L >= 256) return false; u.e = L >> 4; u.pm = (L >> 2) & 3; u.pn = 3 - (L & 3);
        u.A = UG + ((size_t)u.e * T_TOK * 16 + (size_t)u.pm * 256 * 1024) * 2; u.A2 = S0 + ((size_t)u.pm * 256 * 2048 + (size_t)u.e * 128) * 2;
        u.B = BT2 + ((size_t)u.e * 1024 + (size_t)u.pn * 256) * 1152 * 2; u.nt1 = 4 * (u.pn + 1); u.nt = u.nt1 + 2; u.kstepA = 128; u.kstepA2 = 128; u.bjump = (1024 - u.nt1 * 64) * 2; u.lda = 1024; u.lda2 = 2048; return true; }
    DI void epi(AccRef acc, const pg8::GU& u, int wr, int wc, int fr, int fq) const {
        const bf16* Ug = (const bf16*)UG + (size_t)u.e * T_TOK * 16;
        const int h0 = (fq & 1) * 8;
        const f32x4 d0 = *(const f32x4*)(Dsk + u.e * 16 + h0), d1 = *(const f32x4*)(Dsk + u.e * 16 + h0 + 4);
        const float dd[8] = {d0.x, d0.y, d0.z, d0.w, d1.x, d1.y, d1.z, d1.w};
#pragma unroll
        for (int ai = 0; ai < 2; ++ai) { u32x4 uq[4][2];
#pragma unroll
            for (int m = 0; m < 4; ++m)
#pragma unroll
                for (int bj = 0; bj < 2; ++bj) { const int row = u.pm * 256 + ai * 128 + wr * 64 + m * 16 + fr, cc = u.pn * 256 + bj * 128 + wc * 32 + fq * 8; uq[m][bj] = *(const u32x4*)(Ug + ((size_t)row * 64 + (cc >> 4)) * 16 + h0); }
#pragma unroll
            for (int m = 0; m < 4; ++m) { const int row = u.pm * 256 + ai * 128 + wr * 64 + m * 16 + fr;
#pragma unroll
                for (int bj = 0; bj < 2; ++bj) { const int cc = u.pn * 256 + bj * 128 + wc * 32 + fq * 8, tau = cc >> 4; const size_t t = (size_t)row * 64 + tau;
                    float v[8], uu[8]; acc8(acc, ai, bj, m, v); unpack8(uq[m][bj], uu);
#pragma unroll
                    for (int j = 0; j < 8; ++j) v[j] = gelu_tanh(v[j] + dd[j] * uu[j]);
                    *(u32x2*)(YS5 + t * 256 + u.e * 16 + h0) = (u32x2){fp8x4(v[0], v[1], v[2], v[3]), fp8x4(v[4], v[5], v[6], v[7])}; } }
            asm volatile("" ::: "memory"); __builtin_amdgcn_sched_barrier(0); }
    }
};
struct PolGlu {
    static constexpr int NST = 4; static constexpr bool PERM = true, PERMSW = true, SEG2 = false, GATHER = false, MIXED = true;
    const char* A; const char* B; pg8::TileOrder ord; static constexpr int lda = 128, lda2 = 128, ldb = 128, ldb2 = 128;
    const unsigned char* GL; unsigned char* MERGED;
    DI bool next(int i, pg8::GU& u) const { int pm, pn; if (!ord.next(i, pm, pn)) return false; u.pm = pm; u.pn = pn; u.e = 1; u.A = A + (size_t)pm * 256 * 256; u.A2 = u.A; u.B = B + (size_t)pn * 256 * 256;
        u.nt1 = u.nt = 2; u.kstepA = 128; u.kstepA2 = 128; u.bjump = 0; u.lda = 128; u.lda2 = 128; return true; }
    DI void epi(AccRef acc, const pg8::GU& u, int wr, int wc, int fr, int fq) const {
        const int up = fq >> 1, c16 = u.pn * 128 + wc * 32 + (fq & 1) * 16, n0 = c16 + up * 8; u32x2 gq[2][4];
#pragma unroll
        for (int ai = 0; ai < 2; ++ai)
#pragma unroll
            for (int m = 0; m < 4; ++m) { const size_t t = (size_t)(u.pm * 256 + ai * 128 + wr * 64 + m * 16 + fr); gq[ai][m] = *(const u32x2*)(GL + t * GLP + n0); }
        unsigned char* base = MERGED + ((size_t)u.pm * 256 + wr * 64 + up * 16 + fr) * DM + c16;
#pragma unroll
        for (int ai = 0; ai < 2; ++ai)
#pragma unroll
            for (int mp = 0; mp < 2; ++mp) { unsigned q[2][2];
#pragma unroll
                for (int h = 0; h < 2; ++h) { const int m = 2 * mp + h;
                    float z1[8], z2[8], g[8]; acc8(acc, ai, 0, m, z1); acc8(acc, ai, 1, m, z2); gates8(gq[ai][m], g);
#pragma unroll
                    for (int j = 0; j < 8; ++j) z1[j] = g[j] * z1[j] * fsigmoid(z2[j]);
                    q[h][0] = fp8x4(z1[0], z1[1], z1[2], z1[3]); q[h][1] = fp8x4(z1[4], z1[5], z1[6], z1[7]); }
                const auto s0 = __builtin_amdgcn_permlane32_swap(q[0][0], q[1][0], false, false), s1 = __builtin_amdgcn_permlane32_swap(q[0][1], q[1][1], false, false);
                *(u32x4*)(base + (size_t)(ai * 128 + mp * 32) * DM) = (u32x4){s0[0], s1[0], s0[1], s1[1]}; }
    }
};
struct PolRmw {
    static constexpr int NST = 8; static constexpr bool PERM = true, PERM16 = true, SEG2 = false, GATHER = false, MIXED = true;
    const char* A1; const char* A2; const char* B1; const char* B2; const unsigned char* GL; unsigned char* MERGED; pg8::TileOrder ord; int nper;
    static constexpr int lda = 128, lda2 = 128, ldb = 128, ldb2 = 128;
    DI bool next(int i, pg8::GU& u) const { if (i >= 2 * nper) return false; const int br = (i >= nper) ? 1 : 0; int pm, pn; if (!ord.next(i - br * nper, pm, pn)) return false;
        u.pm = pm; u.pn = pn; u.e = 1; u.A = A1 + (size_t)br * (size_t)(A2 - A1) + (size_t)pm * 256 * 256; u.A2 = u.A; u.B = B1 + (size_t)br * (size_t)(B2 - B1) + (size_t)pn * 256 * 256;
        u.nt = 2; u.nt1 = 2; u.kstepA = 128; u.kstepA2 = 128; u.bjump = br; u.lda = 128; u.lda2 = 128; return true; }
    DI void epi(AccRef acc, const pg8::GU& u, int wr, int wc, int fr, int fq) const {
        const int gcol = (u.bjump + 1) * 1024, c16 = u.pn * 256 + wc * 64 + fq * 16;
#pragma unroll
        for (int ai = 0; ai < 2; ++ai) { u32x4 gq[4], oq[4];
#pragma unroll
            for (int m = 0; m < 4; ++m) { const size_t t = (size_t)(u.pm * 256 + ai * 128 + wr * 64 + m * 16 + fr); gq[m] = *(const u32x4*)(GL + t * GLP + gcol + c16); oq[m] = *(const u32x4*)(MERGED + t * DM + c16); }
#pragma unroll
            for (int m = 0; m < 4; ++m) { const size_t t = (size_t)(u.pm * 256 + ai * 128 + wr * 64 + m * 16 + fr); unsigned od[4];
#pragma unroll
                for (int d = 0; d < 4; ++d) { const f32x4 v = acc[ai][d >> 1][m][d & 1]; float g[4], o[4];
                    unfp8x4(d == 0 ? gq[m].x : d == 1 ? gq[m].y : d == 2 ? gq[m].z : gq[m].w, g); unfp8x4(d == 0 ? oq[m].x : d == 1 ? oq[m].y : d == 2 ? oq[m].z : oq[m].w, o);
                    od[d] = fp8x4(o[0] + g[0] * v.x, o[1] + g[1] * v.y, o[2] + g[2] * v.z, o[3] + g[3] * v.w); }
                *(u32x4*)(MERGED + t * DM + c16) = (u32x4){od[0], od[1], od[2], od[3]}; }
            asm volatile("" ::: "memory"); __builtin_amdgcn_sched_barrier(0); }
    }
};
template <bool IN16>
struct PolWout {
    static constexpr int NST = 16; static constexpr bool PERM = true, SEG2 = false, GATHER = false, MIXED = true;
    const char* A; const char* B; pg8::TileOrder ord; static constexpr int lda = 512, lda2 = 512, ldb = 512, ldb2 = 512;
    const void* Xin; bf16* X; const float* gate;
    DI bool next(int i, pg8::GU& u) const { int pm, pn; if (!ord.next(i, pm, pn)) return false; u.pm = pm; u.pn = pn; u.e = 1; u.A = A + (size_t)pm * 256 * 1024; u.A2 = u.A; u.B = B + (size_t)pn * 256 * 1024;
        u.nt1 = u.nt = 8; u.kstepA = 128; u.kstepA2 = 128; u.bjump = 0; u.lda = 512; u.lda2 = 512; return true; }
    DI void epi(AccRef acc, const pg8::GU& u, int wr, int wc, int fr, int fq) const {
        const int b = u.pm >> 5; float g[2][8];
#pragma unroll
        for (int bj = 0; bj < 2; ++bj) { const float* gp = gate + b * 6144 + u.pn * 256 + bj * 128 + wc * 32 + fq * 8; const f32x4 a = *(const f32x4*)gp * (1.0f / W8_SCALE), c = *(const f32x4*)(gp + 4) * (1.0f / W8_SCALE);
            g[bj][0] = a.x; g[bj][1] = a.y; g[bj][2] = a.z; g[bj][3] = a.w; g[bj][4] = c.x; g[bj][5] = c.y; g[bj][6] = c.z; g[bj][7] = c.w; }
#pragma unroll
        for (int ai = 0; ai < 2; ++ai) { u32x4 xq[4][2]; f32x4 xa[4][2], xc[4][2];
#pragma unroll
            for (int m = 0; m < 4; ++m) { const size_t t = (size_t)(u.pm * 256 + ai * 128 + wr * 64 + m * 16 + fr);
#pragma unroll
                for (int bj = 0; bj < 2; ++bj) { const int n0 = u.pn * 256 + bj * 128 + wc * 32 + fq * 8;
                    if (IN16) xq[m][bj] = *(const u32x4*)((const bf16*)Xin + t * XPITCH + n0);
                    else { xa[m][bj] = *(const f32x4*)((const float*)Xin + t * DM + n0); xc[m][bj] = *(const f32x4*)((const float*)Xin + t * DM + n0 + 4); } } }
#pragma unroll
            for (int m = 0; m < 4; ++m) { const size_t t = (size_t)(u.pm * 256 + ai * 128 + wr * 64 + m * 16 + fr);
#pragma unroll
                for (int bj = 0; bj < 2; ++bj) { const int n0 = u.pn * 256 + bj * 128 + wc * 32 + fq * 8; float v[8], x[8]; acc8(acc, ai, bj, m, v);
                    if (IN16) unpack8(xq[m][bj], x);
                    else { const f32x4 a = xa[m][bj], c = xc[m][bj]; x[0] = a.x; x[1] = a.y; x[2] = a.z; x[3] = a.w; x[4] = c.x; x[5] = c.y; x[6] = c.z; x[7] = c.w; }
#pragma unroll
                    for (int j = 0; j < 8; ++j) x[j] += g[bj][j] * v[j];
                    *(u32x4*)(X + t * XPITCH + n0) = pack8(x); } }
            asm volatile("" ::: "memory"); __builtin_amdgcn_sched_barrier(0); }
    }
};
struct PolRouter : PlainBase {
    static constexpr int NST = 0; static constexpr bool PERM = false;
    float* LOG; const float* RSTD; const float* PART; const char* Bb;
    DI bool next(int i, pg8::GU& u) const { if (!PlainBase::next(i, u)) return false; u.B = Bb + (size_t)(u.pm >> 5) * 256 * 1024 * 2; return true; }
    DI void epi(AccRef acc, const pg8::GU& u, int wr, int wc, int fr, int fq) const {
        if (wc < 2) { const int b = u.pm >> 5; f32x4 bias[2];
#pragma unroll
            for (int n = 0; n < 2; ++n) { f32x4 sb = (f32x4){0.f, 0.f, 0.f, 0.f};
#pragma unroll
                for (int q = 0; q < 8; ++q) sb += *(const f32x4*)(PART + (b * 8 + q) * 64 + wc * 32 + n * 16 + fq * 4);
                bias[n] = sb; }
            float rs[2][4];
#pragma unroll
            for (int ai = 0; ai < 2; ++ai)
#pragma unroll
                for (int m = 0; m < 4; ++m) rs[ai][m] = RSTD[(size_t)(u.pm * 256 + ai * 128 + wr * 64 + m * 16 + fr)];
#pragma unroll
            for (int ai = 0; ai < 2; ++ai)
#pragma unroll
                for (int m = 0; m < 4; ++m) { const size_t t = (size_t)(u.pm * 256 + ai * 128 + wr * 64 + m * 16 + fr);
#pragma unroll
                    for (int n = 0; n < 2; ++n) *(f32x4*)(LOG + t * 64 + wc * 32 + n * 16 + fq * 4) = acc[ai][0][m][n] * rs[ai][m] + bias[n]; } }
    }
};
struct GroupSched {
    const LAS int* blkpfx; int nNt, G, c;
    DI bool pick(int i, int& rb, int& pn, int& e) const { const int total = blkpfx[NEXP1] * nNt; const int L = i * G + c; if (L >= total) return false;
        rb = __builtin_amdgcn_readfirstlane(L / nNt); pn = __builtin_amdgcn_readfirstlane(L % nNt);
        int lj = threadIdx.x; asm volatile("" : "+v"(lj)); lj &= 63;
        const int vj = blkpfx[lj], v64 = blkpfx[NEXP];
        const unsigned long long mk = __ballot(vj <= rb);
        e = (rb >= __builtin_amdgcn_readfirstlane(v64)) ? NEXP : (__builtin_popcountll(mk) - 1);
        e = __builtin_amdgcn_readfirstlane(e); return true; }
};
constexpr float HID8_SCALE = 16.0f;
struct PolGateUp {
    static constexpr int NST = 4; static constexpr bool PERM = true, PERMSW = true, SEG2 = false, GATHER = true, MIXED = true;
    GroupSched gs; const char* H2; const char* WGU; const int* ROWTOK; const float* ROWW; unsigned char* HID; static constexpr int lda = 512, lda2 = 512, ldb = 1024, ldb2 = 512;
    DI bool next(int i, pg8::GU& u) const { int rb, pn, e; if (!gs.pick(i, rb, pn, e)) return false; u.pm = rb; u.pn = pn; u.e = 1;
        u.A = H2; u.A2 = H2; u.B = WGU + ((size_t)e * 512 + (size_t)pn * 256) * 1024; u.nt1 = u.nt = 8; u.kstepA = 128; u.kstepA2 = 128; u.bjump = 0; u.lda = 512; u.lda2 = 512; return true; }
    DI void avoff(const pg8::GU& u, const int (&R)[2], const int (&C)[2], unsigned (&v)[2][2]) const {
#pragma unroll
        for (int h = 0; h < 2; ++h)
#pragma unroll
            for (int i = 0; i < 2; ++i) { const int tok = ROWTOK[(size_t)u.pm * 256 + h * 128 + R[i]]; v[h][i] = (unsigned)(tok * 1024 + C[i] * 2); }
    }
    struct Pre { float w[2][4]; };
    DI void pre(const pg8::GU& u, int wr, int fr, Pre& p) const {
#pragma unroll
        for (int ai = 0; ai < 2; ++ai)
#pragma unroll
            for (int m = 0; m < 4; ++m) p.w[ai][m] = ROWW[(size_t)u.pm * 256 + ai * 128 + wr * 64 + m * 16 + fr]; }
    DI void epi(AccRef acc, const pg8::GU& u, int wr, int wc, int fr, int fq, Pre& p, const pg8::GU& un, bool has_next) const {
        float wq[2][4];
#pragma unroll
        for (int ai = 0; ai < 2; ++ai)
#pragma unroll
            for (int m = 0; m < 4; ++m) wq[ai][m] = p.w[ai][m];
        if (has_next) pre(un, wr, fr, p);
        const int up = fq >> 1;
        unsigned char* base = HID + ((size_t)u.pm * 256 + wr * 64 + up * 16 + fr) * 256 + u.pn * 128 + wc * 32 + (fq & 1) * 16;
#pragma unroll
        for (int ai = 0; ai < 2; ++ai)
#pragma unroll
            for (int mp = 0; mp < 2; ++mp) { unsigned q[2][2];
#pragma unroll
                for (int h = 0; h < 2; ++h) { const int m = 2 * mp + h; const float ws = wq[ai][m] * (HID8_SCALE / (W8_SCALE * W8_SCALE));
                    float z1[8], z2[8]; acc8(acc, ai, 0, m, z1); acc8(acc, ai, 1, m, z2);
#pragma unroll
                    for (int j = 0; j < 8; ++j) {
                        const float r = __builtin_amdgcn_rcpf(1.0f + __builtin_amdgcn_exp2f((-1.4426950408889634f / W8_SCALE) * z1[j]));
                        z1[j] = __builtin_amdgcn_fmed3f((ws * z1[j]) * (z2[j] * r), -448.0f, 448.0f); }
                    int w0 = 0, w1 = 0;
                    w0 = __builtin_amdgcn_cvt_pk_fp8_f32(z1[0], z1[1], w0, false); w0 = __builtin_amdgcn_cvt_pk_fp8_f32(z1[2], z1[3], w0, true);
                    w1 = __builtin_amdgcn_cvt_pk_fp8_f32(z1[4], z1[5], w1, false); w1 = __builtin_amdgcn_cvt_pk_fp8_f32(z1[6], z1[7], w1, true);
                    q[h][0] = (unsigned)w0; q[h][1] = (unsigned)w1; }
                const auto s0 = __builtin_amdgcn_permlane32_swap(q[0][0], q[1][0], false, false), s1 = __builtin_amdgcn_permlane32_swap(q[0][1], q[1][1], false, false);
                *(u32x4*)(base + (size_t)(ai * 128 + mp * 32) * 256) = (u32x4){s0[0], s1[0], s0[1], s1[1]}; }
    }
};
constexpr float Y8_SCALE = 16.0f;
static_assert(Y8_SCALE == HID8_SCALE, "the down accumulator is stored unscaled");
struct PolDown {
    static constexpr int NST = 8; static constexpr bool PERM = true, PERM16 = true, SEG2 = false, GATHER = false, MIXED = true;
    GroupSched gs; const char* HIDp; const char* WD; unsigned char* Y8; const int* ROWDST; static constexpr int lda = 128, lda2 = 128, ldb = 128, ldb2 = 128;
    DI bool next(int i, pg8::GU& u) const { int rb, pn, e; if (!gs.pick(i, rb, pn, e)) return false; u.pm = rb; u.pn = pn; u.e = 1;
        u.A = HIDp + (size_t)rb * 256 * 256; u.A2 = u.A; u.B = WD + ((size_t)e * 1024 + (size_t)pn * 256) * 256; u.nt1 = u.nt = 2; u.kstepA = 128; u.kstepA2 = 128; u.bjump = 0; u.lda = 128; u.lda2 = 128; return true; }
    struct Pre { int d[2][4]; };
    DI void pre(const pg8::GU& u, int wr, int fr, Pre& p) const {
#pragma unroll
        for (int ai = 0; ai < 2; ++ai)
#pragma unroll
            for (int m = 0; m < 4; ++m) p.d[ai][m] = ROWDST[(size_t)u.pm * 256 + ai * 128 + wr * 64 + m * 16 + fr]; }
    DI void epi(AccRef acc, const pg8::GU& u, int wr, int wc, int fr, int fq, Pre& p, const pg8::GU& un, bool has_next) const {
        int dst[2][4];
#pragma unroll
        for (int ai = 0; ai < 2; ++ai)
#pragma unroll
            for (int m = 0; m < 4; ++m) dst[ai][m] = p.d[ai][m];
        if (has_next) pre(un, wr, fr, p);
        unsigned char* base = Y8 + u.pn * 256 + wc * 64 + fq * 16;
#pragma unroll
        for (int ai = 0; ai < 2; ++ai)
#pragma unroll
            for (int m = 0; m < 4; ++m) { u32x4 o;
#pragma unroll
                for (int bj = 0; bj < 2; ++bj) { const f32x4 a = acc[ai][bj][m][0], b = acc[ai][bj][m][1];
                    int w0 = __builtin_bit_cast(int, a.x), w1 = __builtin_bit_cast(int, b.x);
                    w0 = __builtin_amdgcn_cvt_pk_fp8_f32(a.x, a.y, w0, false); w0 = __builtin_amdgcn_cvt_pk_fp8_f32(a.z, a.w, w0, true);
                    w1 = __builtin_amdgcn_cvt_pk_fp8_f32(b.x, b.y, w1, false); w1 = __builtin_amdgcn_cvt_pk_fp8_f32(b.z, b.w, w1, true);
                    if (bj == 0) { o.x = (unsigned)w0; o.y = (unsigned)w1; } else { o.z = (unsigned)w0; o.w = (unsigned)w1; } }
                *(u32x4*)(base + (size_t)dst[ai][m] * 1024) = o; }
    }
};

DI void s5_carry_unit(Frame& F, int u) {
    const int b = u >> 4, g = u & 15, p = F.tid & 63, cg = F.tid >> 6;
    const float* SLOC = (const float*)(F.ws + WS_SLOC); bf16* S0 = (bf16*)(F.ws + WS_S0); const float* A64 = (const float*)(F.ws + WS_A64);
    LAS float* R15 = (LAS float*)(F.lds + RING_OFF);
    const float Ar = A64[(g * 64 + p) * 2], Ai = A64[(g * 64 + p) * 2 + 1];
    float xr[16], xi[16];
#pragma unroll
    for (int k = 0; k < 16; ++k) { const size_t base = ((size_t)(b * 128 + cg * 16 + k) * 16 + g) * 128; xr[k] = SLOC[base + p]; xi[k] = SLOC[base + 64 + p]; }
    float rr = 0.f, ri = 0.f;
#pragma unroll
    for (int k = 0; k < 16; ++k) { const float nr = Ar * rr - Ai * ri + xr[k], ni = Ar * ri + Ai * rr + xi[k]; rr = nr; ri = ni; xr[k] = rr; xi[k] = ri; }
    R15[(cg * 64 + p) * 2] = rr; R15[(cg * 64 + p) * 2 + 1] = ri;
    float A16r = Ar, A16i = Ai;
#pragma unroll
    for (int q = 0; q < 4; ++q) { const float nr = A16r * A16r - A16i * A16i, ni = 2.f * A16r * A16i; A16r = nr; A16i = ni; }
    WGBAR();
    float Gr = 0.f, Gi = 0.f;
    for (int q = 0; q < cg; ++q) { const float tr = R15[(q * 64 + p) * 2], ti = R15[(q * 64 + p) * 2 + 1]; const float nr = A16r * Gr - A16i * Gi + tr, ni = A16r * Gi + A16i * Gr + ti; Gr = nr; Gi = ni; }
    float pr = 1.f, pi = 0.f;
#pragma unroll
    for (int k = 0; k < 16; ++k) {
        float sr = pr * Gr - pi * Gi, si = pr * Gi + pi * Gr;
        if (k > 0) { sr += xr[k - 1]; si += xi[k - 1]; }
        const size_t base = ((size_t)(b * 128 + cg * 16 + k) * 16 + g) * 128;
        S0[base + p] = (bf16)f2bf(sr); S0[base + 64 + p] = (bf16)f2bf(si);
        const float nr = pr * Ar - pi * Ai, ni = pr * Ai + pi * Ar; pr = nr; pi = ni;
    }
    WGBAR();
}

constexpr int HG_FT = 0, HG_CUM = 8192, HG_SEG = 25600, HG_QT = 27648, HG_QE = 36864, HG_KT = 46080, HG_INT = 69120, HG_ST = 78336, HG_PS = 87552, HG_OUT = 105984;
constexpr int HP = 72;
constexpr int CP = 68;
DI float hg_lb_calc(Frame& F, int l, int col) { if (l == 0) return 0.f; const float x0 = inp(F, I_LBL)[col], x1 = inp(F, I_LBL)[256 + col]; return 1.0f / (1.0f + expf(x0 - x1)); }
constexpr int HG_LBTAB = LDSCTL_OFF + 13312;
DI void hg_lb_table(Frame& F, int l) { LAS float* T = (LAS float*)(F.lds + HG_LBTAB); if (F.tid < 256) T[F.tid] = hg_lb_calc(F, l, F.tid); asm volatile("s_waitcnt lgkmcnt(0)" ::: "memory"); __builtin_amdgcn_s_barrier(); asm volatile("" ::: "memory"); }
DI float hg_lb(Frame& F, int l, int col) { if (l == 0) return 0.f; return ((const LAS float*)(F.lds + HG_LBTAB))[col]; }
#define LBAR() do { asm volatile("s_waitcnt lgkmcnt(0)" ::: "memory"); __builtin_amdgcn_s_barrier(); asm volatile("" ::: "memory"); } while (0)
struct HgRegs { u32x4 ft, inp, q, g; f32x4 s0, s1; unsigned short fc[8]; float sg[2]; };
DI void hg_fetch(Frame& F, int u, bool h3, HgRegs& r) {
    const bf16* PM = (const bf16*)(F.ws + WS_PM); const float* HST = (const float*)(F.ws + WS_HST);
    const int bh = u >> 7, c = u & 127, b = bh >> 2, head = bh & 3, tok0 = b * SEQ + c * 64;
    const int t = F.tid >> 3, kc = F.tid & 7; const bf16* row = PM + (size_t)(tok0 + t) * PMP + head * 64 + kc * 8;
    r.inp = *(const u32x4*)(row + 512); if (h3) r.ft = *(const u32x4*)(row + 256);
    { const int k = F.tid & 63, seg = F.tid >> 6; const bf16* col = PM + (size_t)(tok0 + seg * 8) * PMP + head * 64 + 256 + k;
#pragma unroll
      for (int j = 0; j < 8; ++j) r.fc[j] = col[(size_t)j * PMP];
      if (h3) { r.sg[0] = ((const float*)(F.ws + WS_HSEG))[(size_t)u * 512 + seg * 64 + k]; r.sg[1] = ((const float*)(F.ws + WS_HLAST))[(size_t)u * 64 + k]; } }
    if (h3) { r.q = *(const u32x4*)(row); r.g = *(const u32x4*)(row + 768); const float* sp = HST + (size_t)u * 4096 + t * 64 + kc * 8; r.s0 = *(const f32x4*)sp; r.s1 = *(const f32x4*)(sp + 4); }
}
template <bool H3>
DI void hg_stepA(Frame& F, const HgRegs& r, float lbk, float (&fv)[8], float (&cum)[8], float& last, int u) {
    LAS float* CUM = (LAS float*)(F.lds + HG_CUM); LAS float* SEG = (LAS float*)(F.lds + HG_SEG);
    const int k = F.tid & 63, seg = F.tid >> 6; float run = 0.f;
#pragma unroll
    for (int j = 0; j < 8; ++j) { const float fr = bf2f(r.fc[j]); const float f = lbk + (1.0f - lbk) * fsigmoid(fr); fv[j] = f; run += __builtin_amdgcn_logf(f); cum[j] = run; }
    float off = 0.f, tot = 0.f;
    if constexpr (H3) { off = r.sg[0]; tot = r.sg[1]; }
    else {
        SEG[seg * 64 + k] = run;
        LBAR();
#pragma unroll
        for (int s = 0; s < 8; ++s) { const float v = SEG[s * 64 + k]; tot += v; if (s < seg) off += v; }
        ((float*)(F.ws + WS_HSEG))[(size_t)u * 512 + seg * 64 + k] = off;
    }
    last = tot;
#pragma unroll
    for (int j = 0; j < 8; ++j) { cum[j] += off; if constexpr (H3) CUM[(seg * 8 + j) * CP + k] = cum[j]; }
}
typedef short hg_s4 __attribute__((ext_vector_type(4)));
DI void hg_store_inpT(Frame& F, const HgRegs& r) {
    LAS bf16* INT = (LAS bf16*)(F.lds + HG_INT);
    const int s = F.tid >> 3, vc = F.tid & 7;
    *(LAS u32x4*)(INT + s * HP + vc * 8) = r.inp;
}
DI bf16x8 hg_trB(const LAS bf16* T, int v16, int s0, int lane) {
    const int quad = lane >> 4, q = (lane & 15) >> 2, pp = lane & 3;
    const LAS bf16* a = T + (s0 + 8 * quad + q) * HP + v16 + 4 * pp;
    const hg_s4 lo = __builtin_amdgcn_ds_read_tr16_b64_v4i16((LAS hg_s4*)a), hi = __builtin_amdgcn_ds_read_tr16_b64_v4i16((LAS hg_s4*)(a + 4 * HP));
    return __builtin_shufflevector(lo, hi, 0, 1, 2, 3, 4, 5, 6, 7);
}
DI void hgrn_h1_unit(Frame& F, int l, int u, const HgRegs& r) {
    float* HST = (float*)(F.ws + WS_HST); float* HLAST = (float*)(F.ws + WS_HLAST);
    const int bh = u >> 7, head = bh & 3;
    const int k = F.tid & 63, seg = F.tid >> 6;
    const float lbk = hg_lb(F, l, head * 64 + k);
    float fv[8], cum[8], last;
    hg_stepA<false>(F, r, lbk, fv, cum, last, u);
    LAS bf16* KST = (LAS bf16*)(F.lds + HG_QT);
    { float ks[8];
#pragma unroll
      for (int j = 0; j < 8; ++j) ks[j] = (1.0f - fv[j]) * __builtin_amdgcn_exp2f(last - cum[j]);
      *(LAS u32x4*)(KST + k * HP + seg * 8) = pack8(ks); }
    if (seg == 0) HLAST[(size_t)u * 64 + k] = last;
    hg_store_inpT(F, r);
    LBAR();
    { const int w = F.wave, kt = w >> 1, vts = (w & 1) * 2, row = F.lane & 15, quad = F.lane >> 4;
      const LAS bf16* INT = (const LAS bf16*)(F.lds + HG_INT);
#pragma unroll
      for (int vt = 0; vt < 2; ++vt) { f32x4 acc = (f32x4){0.f, 0.f, 0.f, 0.f};
#pragma unroll
          for (int ks = 0; ks < 2; ++ks) { const bf16x8 a = *(const LAS bf16x8*)(KST + (kt * 16 + row) * HP + ks * 32 + quad * 8), bb = hg_trB(INT, (vts + vt) * 16, ks * 32, F.lane);
              acc = __builtin_amdgcn_mfma_f32_16x16x32_bf16(a, bb, acc, 0, 0, 0); }
#pragma unroll
          for (int j = 0; j < 4; ++j) HST[(size_t)u * 4096 + (kt * 16 + quad * 4 + j) * 64 + (vts + vt) * 16 + row] = acc[j]; } }
}
DI void hgrn_h1_phase(Frame& F, int l) {
    int u0, n;
    if (F.G == 256) { if (F.vcu < 64) { u0 = F.vcu * 7; n = 7; } else { u0 = 448 + (F.vcu - 64) * 19; n = 19; } }
    else { const int per = (4096 + F.G - 1) / F.G; u0 = F.vcu * per; n = (u0 + per <= 4096) ? per : (4096 - u0 > 0 ? 4096 - u0 : 0); }
    if (n <= 0) return;
    hg_lb_table(F, l);
    HgRegs cur, nxt;
    hg_fetch(F, u0, false, cur);
    for (int k = 0; k < n; ++k) { if (k + 1 < n) hg_fetch(F, u0 + k + 1, false, nxt); hgrn_h1_unit(F, l, u0 + k, cur); cur = nxt; }
    LBAR();
}
DI void hgrn_carry_unit(Frame& F, int u) {
    float* HST = (float*)(F.ws + WS_HST); const float* HLAST = (const float*)(F.ws + WS_HLAST);
    const int bh = u >> 3, v = F.tid & 63, k = (F.tid >> 6) + 8 * (u & 7);
    float s = 0.f;
    float d[8], dec[8];
#pragma unroll
    for (int j = 0; j < 8; ++j) { const size_t uu = (size_t)bh * 128 + j; d[j] = HST[uu * 4096 + k * 64 + v]; dec[j] = HLAST[uu * 64 + k]; }
    for (int c0 = 0; c0 < 128; c0 += 8) {
        float dn[8], decn[8]; const int cn = (c0 + 8 < 128) ? c0 + 8 : c0;
#pragma unroll
        for (int j = 0; j < 8; ++j) { const size_t uu = (size_t)bh * 128 + cn + j; dn[j] = HST[uu * 4096 + k * 64 + v]; decn[j] = HLAST[uu * 64 + k]; }
#pragma unroll
        for (int j = 0; j < 8; ++j) { const size_t uu = (size_t)bh * 128 + c0 + j; HST[uu * 4096 + k * 64 + v] = s; s = __builtin_amdgcn_exp2f(dec[j]) * s + d[j]; }
#pragma unroll
        for (int j = 0; j < 8; ++j) { d[j] = dn[j]; dec[j] = decn[j]; }
    }
}
DI void hgrn_h3_unit(Frame& F, int l, int u, const HgRegs& r, const float (&hng)[8]) {
    unsigned char* OH = F.ws + WS_OH;
    const int bh = u >> 7, c = u & 127, b = bh >> 2, head = bh & 3, tok0 = b * SEQ + c * 64;
    { const int k = F.tid & 63; const float lbk = hg_lb(F, l, head * 64 + k); float fv[8], cum[8], last; hg_stepA<true>(F, r, lbk, fv, cum, last, u); }
    hg_store_inpT(F, r);
    { LAS bf16* ST = (LAS bf16*)(F.lds + HG_ST); const int k = F.tid >> 3, vc = F.tid & 7;
      const float sv[8] = {r.s0.x, r.s0.y, r.s0.z, r.s0.w, r.s1.x, r.s1.y, r.s1.z, r.s1.w};
      *(LAS u32x4*)(ST + k * HP + vc * 8) = (u32x4){pk2(sv[0], sv[1]), pk2(sv[2], sv[3]), pk2(sv[4], sv[5]), pk2(sv[6], sv[7])}; }
    LBAR();
    {
      const LAS bf16* FT = (const LAS bf16*)(F.lds + HG_FT); const LAS float* CUM = (const LAS float*)(F.lds + HG_CUM);
      LAS bf16* QT = (LAS bf16*)(F.lds + HG_QT); LAS bf16* QE = (LAS bf16*)(F.lds + HG_QE); LAS bf16* KT = (LAS bf16*)(F.lds + HG_KT);
      const int t = F.tid >> 3, kc = F.tid & 7, ib = t >> 4;
      float q[8], fr[8], cm[8], rf[8], o1[8], o2[8];
      unpack8(r.q, q);
      unpack8(r.ft, fr);
      { const LAS f32x4* c4 = (const LAS f32x4*)(CUM + t * CP + kc * 8); const f32x4 a = c4[0], b = c4[1];
        cm[0] = a.x; cm[1] = a.y; cm[2] = a.z; cm[3] = a.w; cm[4] = b.x; cm[5] = b.y; cm[6] = b.z; cm[7] = b.w;
        f32x4 ra = (f32x4){0.f, 0.f, 0.f, 0.f}, rb = ra;
        if (ib > 0) { const LAS f32x4* r4 = (const LAS f32x4*)(CUM + (16 * ib - 1) * CP + kc * 8); ra = r4[0]; rb = r4[1]; }
        rf[0] = ra.x; rf[1] = ra.y; rf[2] = ra.z; rf[3] = ra.w; rf[4] = rb.x; rf[5] = rb.y; rf[6] = rb.z; rf[7] = rb.w; }
      { float lb8[8];
        if (l == 0) {
#pragma unroll
            for (int j = 0; j < 8; ++j) lb8[j] = 0.f; }
        else { const LAS f32x4* t4 = (const LAS f32x4*)((const LAS float*)(F.lds + HG_LBTAB) + head * 64 + kc * 8); const f32x4 a = t4[0], b = t4[1]; lb8[0] = a.x; lb8[1] = a.y; lb8[2] = a.z; lb8[3] = a.w; lb8[4] = b.x; lb8[5] = b.y; lb8[6] = b.z; lb8[7] = b.w; }
#pragma unroll
        for (int j = 0; j < 8; ++j) { const float lbk = lb8[j]; fr[j] = 1.0f - (lbk + (1.0f - lbk) * fsigmoid(fr[j])); } }
#pragma unroll
      for (int j = 0; j < 8; ++j) { o1[j] = q[j] * __builtin_amdgcn_exp2f(cm[j] - rf[j]); o2[j] = q[j] * __builtin_amdgcn_exp2f(cm[j]); }
      *(LAS u32x4*)(QT + t * HP + kc * 8) = pack8(o1); *(LAS u32x4*)(QE + t * HP + kc * 8) = pack8(o2);
      for (int i2 = ib; i2 < 4; ++i2) { const int rowoff = (i2 == 0) ? 0 : (i2 == 1) ? 16 : (i2 == 2) ? 48 : 96;
          float r2v[8];
          { f32x4 ra = (f32x4){0.f, 0.f, 0.f, 0.f}, rb = ra;
            if (i2 > 0) { const LAS f32x4* r4 = (const LAS f32x4*)(CUM + (16 * i2 - 1) * CP + kc * 8); ra = r4[0]; rb = r4[1]; }
            r2v[0] = ra.x; r2v[1] = ra.y; r2v[2] = ra.z; r2v[3] = ra.w; r2v[4] = rb.x; r2v[5] = rb.y; r2v[6] = rb.z; r2v[7] = rb.w; }
#pragma unroll
          for (int j = 0; j < 8; ++j) { const float r2 = r2v[j]; o1[j] = fr[j] * __builtin_amdgcn_exp2f(fminf(r2 - cm[j], 115.41560327111707f)); }
          *(LAS u32x4*)(KT + (rowoff + t) * HP + kc * 8) = pack8(o1); }
    }
    asm volatile("s_waitcnt lgkmcnt(0)" ::: "memory"); __builtin_amdgcn_s_barrier(); asm volatile("" ::: "memory");
    { const int w = F.wave, ib = w >> 1, vh = w & 1, row = F.lane & 15, quad = F.lane >> 4;
      const LAS bf16* QT = (const LAS bf16*)(F.lds + HG_QT); const LAS bf16* QE = (const LAS bf16*)(F.lds + HG_QE); const LAS bf16* KT = (const LAS bf16*)(F.lds + HG_KT);
      const LAS bf16* INT = (const LAS bf16*)(F.lds + HG_INT); const LAS bf16* ST = (const LAS bf16*)(F.lds + HG_ST);
      LAS bf16* PS = (LAS bf16*)(F.lds + HG_PS) + w * 16 * HP; LAS float* OUT = (LAS float*)(F.lds + HG_OUT);
      const int rowoff = (ib == 0) ? 0 : (ib == 1) ? 16 : (ib == 2) ? 48 : 96;
      const bf16x8 qa0 = *(const LAS bf16x8*)(QT + (16 * ib + row) * HP + quad * 8), qa1 = *(const LAS bf16x8*)(QT + (16 * ib + row) * HP + 32 + quad * 8);
      f32x4 accO[2] = {(f32x4){0.f, 0.f, 0.f, 0.f}, (f32x4){0.f, 0.f, 0.f, 0.f}};
      const int tq = (F.lane & 15) >> 2, tp = F.lane & 3;
      for (int st = 0; st <= ib; ++st) {
          const bf16x8 b0 = *(const LAS bf16x8*)(KT + (rowoff + st * 16 + row) * HP + quad * 8), b1 = *(const LAS bf16x8*)(KT + (rowoff + st * 16 + row) * HP + 32 + quad * 8);
          f32x4 sT = (f32x4){0.f, 0.f, 0.f, 0.f};
          sT = __builtin_amdgcn_mfma_f32_16x16x32_bf16(b0, qa0, sT, 0, 0, 0); sT = __builtin_amdgcn_mfma_f32_16x16x32_bf16(b1, qa1, sT, 0, 0, 0);
          if (st == ib) {
#pragma unroll
              for (int j = 0; j < 4; ++j) if (quad * 4 + j > row) sT[j] = 0.f; }
          const hg_s4 p4 = (hg_s4){(short)f2bf(sT[0]), (short)f2bf(sT[1]), (short)f2bf(sT[2]), (short)f2bf(sT[3])};
#pragma unroll
          for (int vt = 0; vt < 2; ++vt) { const hg_s4 b4 = __builtin_amdgcn_ds_read_tr16_b64_v4i16((LAS hg_s4*)(INT + (st * 16 + 4 * quad + tq) * HP + (vh * 2 + vt) * 16 + 4 * tp));
              accO[vt] = __builtin_amdgcn_mfma_f32_16x16x16bf16_1k(p4, b4, accO[vt], 0, 0, 0); }
      }
#pragma unroll
      for (int vt = 0; vt < 2; ++vt) { f32x4 acc = accO[vt]; const int vrow = (vh * 2 + vt) * 16 + row;
#pragma unroll
          for (int ks = 0; ks < 2; ++ks) { const bf16x8 a = *(const LAS bf16x8*)(QE + (16 * ib + row) * HP + ks * 32 + quad * 8), bb = hg_trB(ST, (vh * 2 + vt) * 16, ks * 32, F.lane);
              acc = __builtin_amdgcn_mfma_f32_16x16x32_bf16(a, bb, acc, 0, 0, 0); }
#pragma unroll
          for (int j = 0; j < 4; ++j) OUT[(16 * ib + quad * 4 + j) * CP + vrow] = acc[j]; }
    }
    asm volatile("s_waitcnt lgkmcnt(0)" ::: "memory"); __builtin_amdgcn_s_barrier(); asm volatile("" ::: "memory");
    { const LAS float* OUT = (const LAS float*)(F.lds + HG_OUT); const int t = F.tid >> 3, vc = F.tid & 7;
      float o[8], g[8]; float ss = 0.f;

      { const LAS f32x4* o4 = (const LAS f32x4*)(OUT + t * CP + vc * 8); const f32x4 a = o4[0], b = o4[1]; o[0] = a.x; o[1] = a.y; o[2] = a.z; o[3] = a.w; o[4] = b.x; o[5] = b.y; o[6] = b.z; o[7] = b.w; }
#pragma unroll
      for (int j = 0; j < 8; ++j) ss += o[j] * o[j];
      ss += __shfl_xor(ss, 1); ss += __shfl_xor(ss, 2); ss += __shfl_xor(ss, 4);
      const float rstd = 1.0f / sqrtf(ss * (1.0f / 64.0f) + EPS);
      unpack8(r.g, g);
#pragma unroll
      for (int j = 0; j < 8; ++j) o[j] = o[j] * rstd * hng[j] * fsilu(g[j]);
      *(u32x2*)(OH + (size_t)(tok0 + t) * 256 + head * 64 + vc * 8) = (u32x2){fp8x4(o[0], o[1], o[2], o[3]), fp8x4(o[4], o[5], o[6], o[7])}; }
}
DI void hgrn_h3_phase(Frame& F, int l) {
    HgRegs cur, nxt; int u = F.vcu; if (u >= 4096) return;
    hg_lb_table(F, l);
    float hng[8];
#pragma unroll
    for (int j = 0; j < 8; ++j) hng[j] = inp(F, I_HNG)[l * 64 + (F.tid & 7) * 8 + j];
    hg_fetch(F, u, true, cur);
    for (; u < 4096; u += F.G) { const int un = u + F.G; if (un < 4096) hg_fetch(F, un, true, nxt); hgrn_h3_unit(F, l, u, cur, hng); cur = nxt; }
    LBAR();
}

DI void moba_prep_unit(Frame& F, int l, int u) {
    bf16* PM = (bf16*)(F.ws + WS_PM); float* KMEAN = (float*)(F.ws + WS_KMEAN);
    LAS float* KS = (LAS float*)(F.lds + RING_OFF);
    const int b = u >> 5, blk = u & 31, tg = F.tid >> 5, hd = (F.tid >> 3) & 3, dc = F.tid & 7;
    float qg[8], kg[8], ksum[8];
#pragma unroll
    for (int j = 0; j < 8; ++j) { qg[j] = inp(F, I_MQG)[l * 64 + dc * 8 + j] * attn_body::C2; kg[j] = inp(F, I_MKG)[l * 64 + dc * 8 + j]; ksum[j] = 0.f; }
    _Pragma("unroll 1") for (int ih = 0; ih < 4; ++ih) {
        u32x4 qr[4], kr[4];
#pragma unroll
        for (int i8 = 0; i8 < 4; ++i8) { const size_t row = (size_t)b * SEQ + blk * 256 + (ih * 4 + i8) * 16 + tg;
            qr[i8] = *(const u32x4*)(PM + row * PMP + 1024 + hd * 64 + dc * 8); kr[i8] = *(const u32x4*)(PM + row * PMP + 1280 + hd * 64 + dc * 8); }
#pragma unroll
        for (int i8 = 0; i8 < 4; ++i8) { const size_t row = (size_t)b * SEQ + blk * 256 + (ih * 4 + i8) * 16 + tg;
            bf16* qp = PM + row * PMP + 1024 + hd * 64 + dc * 8; bf16* kp = PM + row * PMP + 1280 + hd * 64 + dc * 8;
            float q[8], k[8]; unpack8(qr[i8], q); unpack8(kr[i8], k);
            float sq = 0.f, sk = 0.f;
#pragma unroll
            for (int j = 0; j < 8; ++j) { sq += q[j] * q[j]; sk += k[j] * k[j]; }
            sq += __shfl_xor(sq, 1); sq += __shfl_xor(sq, 2); sq += __shfl_xor(sq, 4); sk += __shfl_xor(sk, 1); sk += __shfl_xor(sk, 2); sk += __shfl_xor(sk, 4);
            const float rq = 1.0f / sqrtf(sq * (1.0f / 64.0f) + EPS), rk = 1.0f / sqrtf(sk * (1.0f / 64.0f) + EPS);
#pragma unroll
            for (int j = 0; j < 8; ++j) { q[j] = q[j] * rq * qg[j]; k[j] = k[j] * rk * kg[j]; ksum[j] += k[j]; }
            *(u32x4*)qp = pack8(q); *(u32x4*)kp = pack8(k); }
    }
#pragma unroll
    for (int j = 0; j < 8; ++j) KS[tg * 256 + hd * 64 + dc * 8 + j] = ksum[j];
    WGBAR();
    if (F.tid < 256) { float s = 0.f;
#pragma unroll
        for (int q = 0; q < 16; ++q) s += KS[q * 256 + F.tid];
        KMEAN[((size_t)(b * 4 + (F.tid >> 6)) * 32 + blk) * 64 + (F.tid & 63)] = s * (1.0f / 256.0f); }
    WGBAR();
}
DI int ql_base(int bh, int j) { return (bh * 496 + 31 * j - (j * (j - 1)) / 2) * 256; }
DI void moba_select_unit(Frame& F, int l, int u) {
    const bf16* PM = (const bf16*)(F.ws + WS_PM); const float* KMEAN = (const float*)(F.ws + WS_KMEAN); int* QL = (int*)(F.ws + WS_QL);
    LAS float* KM = (LAS float*)(F.lds + RING_OFF);
    int* hist = (int*)(F.ldsg + RING_OFF + 32768); LAS int* basel = (LAS int*)(F.lds + RING_OFF + 32768 + 512);
    const int b = u >> 5, blk = u & 31;
    for (int i = F.tid; i < 4 * 32 * 64 / 4; i += NTHR) ((LAS f32x4*)KM)[i] = ((const f32x4*)(KMEAN + (size_t)b * 4 * 32 * 64))[i];
    if (F.tid < 128) hist[F.tid] = 0;
    WGBAR();
    int sj[2][3], sr[2][3];
    for (int r = 0; r < 2; ++r) {
        const int p = F.tid + NTHR * r, tokl = p & 255, hd = __builtin_amdgcn_readfirstlane(p >> 8);
        const size_t row = (size_t)b * SEQ + blk * 256 + tokl;
        float q[64];
#pragma unroll
        for (int c8 = 0; c8 < 8; ++c8) { float t8[8]; unpack8(*(const u32x4*)(PM + row * PMP + 1024 + hd * 64 + c8 * 8), t8);
#pragma unroll
            for (int j = 0; j < 8; ++j) q[c8 * 8 + j] = t8[j]; }
        float v0 = -INFINITY, v1 = -INFINITY, v2 = -INFINITY; int i0 = -1, i1 = -1, i2 = -1;
        for (int j = 0; j < blk; ++j) { const LAS f32x4* km = (const LAS f32x4*)(KM + (hd * 32 + j) * 64); float g = 0.f;
#pragma unroll
            for (int d4 = 0; d4 < 16; ++d4) { const f32x4 kk = km[d4]; g += q[d4 * 4] * kk.x + q[d4 * 4 + 1] * kk.y + q[d4 * 4 + 2] * kk.z + q[d4 * 4 + 3] * kk.w; }
            if (g > v0) { v2 = v1; i2 = i1; v1 = v0; i1 = i0; v0 = g; i0 = j; } else if (g > v1) { v2 = v1; i2 = i1; v1 = g; i1 = j; } else if (g > v2) { v2 = g; i2 = j; } }
        sj[r][0] = i0; sj[r][1] = i1; sj[r][2] = i2;
#pragma unroll
        for (int s = 0; s < 3; ++s) sr[r][s] = (sj[r][s] >= 0) ? atomicAdd(&hist[hd * 32 + sj[r][s]], 1) : 0;
    }
    WGBAR();
    if (F.tid < 128) { const int c = hist[F.tid]; basel[F.tid] = c ? (int)atomicAdd((unsigned*)(F.ctl + CW_QC + l * 1024 + b * 128 + F.tid), (unsigned)c) : 0; }
    WGBAR();
    for (int r = 0; r < 2; ++r) { const int p = F.tid + NTHR * r, tokl = p & 255, hd = p >> 8;
#pragma unroll
        for (int s = 0; s < 3; ++s) if (sj[r][s] >= 0) QL[ql_base(b * 4 + hd, sj[r][s]) + basel[hd * 32 + sj[r][s]] + sr[r][s]] = ((blk * 256 + tokl) << 2) | s; }
    WGBAR();
}
DI void moba_gather_phase(Frame& F, int l, unsigned char* lds) {
    LAS int* QCL = (LAS int*)(F.lds + LDSCTL_OFF + 4096);
    LAS int* PFX = (LAS int*)(F.lds + LDSCTL_OFF + 8192);
    for (int i = F.tid; i < 1024; i += NTHR) QCL[i] = (int)__hip_atomic_load(F.ctl + CW_QC + l * 1024 + i, RLX_AGENT);
    WGBAR();
    if (F.tid < 32) { int acc = 0; for (int j = 0; j < 32; ++j) { const int cnt = (j < 31) ? QCL[F.tid * 32 + j] : 0; acc += (cnt + 255) >> 8; } PFX[1056 + F.tid] = acc; }
    WGBAR();
    if (F.tid < 32) { int base = 0; for (int q = 0; q < F.tid; ++q) base += PFX[1056 + q];
        for (int j = 0; j < 32; ++j) { PFX[F.tid * 32 + j] = base; const int cnt = (j < 31) ? QCL[F.tid * 32 + j] : 0; base += (cnt + 255) >> 8; }
        if (F.tid == 31) PFX[1024] = base; }
    WGBAR();
    const int total = PFX[1024];
    const attn_body::bf16* pm = (const attn_body::bf16*)(F.ws + WS_PM); const int* QL = (const int*)(F.ws + WS_QL);
    const int rank = (F.G == 256) ? ((3 - (F.vcu & 3)) * 64 + (F.vcu >> 2)) : F.vcu;
    for (int U = rank; U < total; U += F.G) {
        int lo = 0, hi = 1023;
#pragma unroll
        for (int s = 0; s < 10; ++s) { const int mid = (lo + hi + 1) >> 1; if (PFX[mid] <= U) lo = mid; else hi = mid - 1; }
        const int id = __builtin_amdgcn_readfirstlane(lo), c = U - PFX[id], bh = id >> 5, j = id & 31;
        const int nv = QCL[id] - c * 256;
        attn_body::attn_unit<8, 0>(bh >> 2, bh & 3, j, QL + ql_base(bh, j) + c * 256, nv < 256 ? nv : 256, pm + 1024, pm + 1280, pm + 1536, (attn_body::bf16*)nullptr, (attn_body::bf16*)(F.ws + WS_PO), (float*)(F.ws + WS_PML), (char*)lds + RING_OFF);
    }
}
DI void moba_own_phase(Frame& F, unsigned char* lds) {
    const attn_body::bf16* pm = (const attn_body::bf16*)(F.ws + WS_PM);
    for (int U = F.vcu; U < 1024; U += F.G) { const int bh = U >> 5, qb = U & 31;
        attn_body::attn_unit<8, 1>(bh >> 2, bh & 3, qb, (const int*)nullptr, 256, pm + 1024, pm + 1280, pm + 1536, (attn_body::bf16*)(F.ws + WS_OM), (attn_body::bf16*)(F.ws + WS_PO), (float*)(F.ws + WS_PML), (char*)lds + RING_OFF); }
}

DI void moe_route_unit(Frame& F, int l, int u) {
    const float* LOG = (const float*)(F.ws + WS_LOGITS); int* TOPI = (int*)(F.ws + WS_TOPI); float* TOPW = (float*)(F.ws + WS_TOPW);
    int* hist = (int*)(F.ldsg + RING_OFF); LAS float* biasl = (LAS float*)(F.lds + RING_OFF + 512);
    if (F.tid < 64) { hist[F.tid] = 0; biasl[F.tid] = inp(F, I_RB)[l * 64 + F.tid]; }
    WGBAR();
    const size_t t = (size_t)u * 512 + F.tid;
    float key[64];
#pragma unroll
    for (int c4 = 0; c4 < 16; ++c4) { const f32x4 v = *(const f32x4*)(LOG + t * 64 + c4 * 4);
        key[c4 * 4] = fsigmoid(v.x) + biasl[c4 * 4]; key[c4 * 4 + 1] = fsigmoid(v.y) + biasl[c4 * 4 + 1]; key[c4 * 4 + 2] = fsigmoid(v.z) + biasl[c4 * 4 + 2]; key[c4 * 4 + 3] = fsigmoid(v.w) + biasl[c4 * 4 + 3]; }
    int idx[6]; float sc[6]; float sum = 0.f;
#pragma unroll
    for (int k = 0; k < 6; ++k) { float best = -INFINITY; int bi = 0;
#pragma unroll
        for (int e = 0; e < 64; ++e) if (key[e] > best) { best = key[e]; bi = e; }
#pragma unroll
        for (int e = 0; e < 64; ++e) if (e == bi) key[e] = -INFINITY;
        idx[k] = bi; sc[k] = best - biasl[bi]; sum += sc[k]; }
    const float inv = 2.5f / sum;
#pragma unroll
    for (int k = 0; k < 6; ++k) { TOPI[t * 6 + k] = idx[k]; TOPW[t * 6 + k] = sc[k] * inv; atomicAdd(&hist[idx[k]], 1); }
    WGBAR();
    if (F.tid < 64) atomicAdd((unsigned*)(F.ctl + CW_CNT + l * 64 + F.tid), (unsigned)hist[F.tid]);
    WGBAR();
}
DI void moe_route_unit256(Frame& F, int l, int pm) {
    const float* LOG = (const float*)(F.ws + WS_LOGITS); int* TOPI = (int*)(F.ws + WS_TOPI); float* TOPW = (float*)(F.ws + WS_TOPW);
    int* hist = (int*)(F.ldsg + RING_OFF); LAS float* biasl = (LAS float*)(F.lds + RING_OFF + 512);
    if (F.tid < 64) { hist[F.tid] = 0; biasl[F.tid] = inp(F, I_RB)[l * 64 + F.tid]; }
    WGBAR();
    const size_t t = (size_t)pm * 256 + (F.tid & 255); const bool act = F.tid < 256;
    float key[64];
#pragma unroll
    for (int c4 = 0; c4 < 16; ++c4) { const f32x4 v = *(const f32x4*)(LOG + t * 64 + c4 * 4);
        key[c4 * 4] = fsigmoid(v.x) + biasl[c4 * 4]; key[c4 * 4 + 1] = fsigmoid(v.y) + biasl[c4 * 4 + 1]; key[c4 * 4 + 2] = fsigmoid(v.z) + biasl[c4 * 4 + 2]; key[c4 * 4 + 3] = fsigmoid(v.w) + biasl[c4 * 4 + 3]; }
    int idx[6]; float sc[6]; float sum = 0.f;
#pragma unroll
    for (int k = 0; k < 6; ++k) { float best = -INFINITY; int bi = 0;
#pragma unroll
        for (int e = 0; e < 64; ++e) if (key[e] > best) { best = key[e]; bi = e; }
#pragma unroll
        for (int e = 0; e < 64; ++e) if (e == bi) key[e] = -INFINITY;
        idx[k] = bi; sc[k] = best - biasl[bi]; sum += sc[k]; }
    const float inv = 2.5f / sum;
    if (act) {
#pragma unroll
    for (int k = 0; k < 6; ++k) { TOPI[t * 6 + k] = idx[k]; TOPW[t * 6 + k] = sc[k] * inv; atomicAdd(&hist[idx[k]], 1); } }
    WGBAR();
    if (F.tid < 64) atomicAdd((unsigned*)(F.ctl + CW_CNT + l * 64 + F.tid), (unsigned)hist[F.tid]);
    WGBAR();
}
DI void moe_tables(Frame& F, int l, LAS int* blkpfx, LAS int* rowpfx) {
    LAS int* cn = rowpfx + 80;
    if (F.tid < NEXP) cn[F.tid] = (int)__hip_atomic_load(F.ctl + CW_CNT + l * 64 + F.tid, RLX_AGENT);
    WGBAR();
    if (F.tid == 0) { int acc = 0;
        for (int e = 0; e < NEXP; ++e) { const int cnt = cn[e]; blkpfx[e] = acc; rowpfx[e] = acc * 256; acc += (cnt + 255) >> 8; }
        blkpfx[NEXP] = acc; rowpfx[NEXP] = acc * 256; blkpfx[NEXP1] = acc + T_TOK / 256; rowpfx[NEXP1] = (acc + T_TOK / 256) * 256; }
    WGBAR();
}
DI void moe_scatter_unit(Frame& F, int l, int u, const LAS int* rowpfx) {
    const int* TOPI = (const int*)(F.ws + WS_TOPI); const float* TOPW = (const float*)(F.ws + WS_TOPW); int* ROWDST = (int*)(F.ws + WS_ROWDST); int* ROWTOK = (int*)(F.ws + WS_ROWTOK); float* ROWW = (float*)(F.ws + WS_ROWW);
    int* hist = (int*)(F.ldsg + RING_OFF); LAS int* basel = (LAS int*)(F.lds + RING_OFF + 512);
    if (F.tid < 64) hist[F.tid] = 0;
    WGBAR();
    const size_t t = (size_t)u * 512 + F.tid; int e[6], r[6];
#pragma unroll
    for (int k = 0; k < 6; ++k) { e[k] = TOPI[t * 6 + k]; r[k] = atomicAdd(&hist[e[k]], 1); }
    WGBAR();
    if (F.tid < 64) basel[F.tid] = (int)atomicAdd((unsigned*)(F.ctl + CW_CUR + l * 64 + F.tid), (unsigned)hist[F.tid]);
    WGBAR();
    float tw[6];
#pragma unroll
    for (int k = 0; k < 6; ++k) tw[k] = TOPW[t * 6 + k];
#pragma unroll
    for (int k = 0; k < 6; ++k) { const int pos = rowpfx[e[k]] + basel[e[k]] + r[k]; ROWDST[pos] = (int)t * 7 + k; ROWTOK[pos] = (int)t; ROWW[pos] = tw[k]; }
    WGBAR();
}
DI void moe_fill_rows(Frame& F, int l, const LAS int* rowpfx) {
    int* ROWTOK = (int*)(F.ws + WS_ROWTOK); float* ROWW = (float*)(F.ws + WS_ROWW); int* ROWDST = (int*)(F.ws + WS_ROWDST);
    for (int e = F.vcu; e < NEXP; e += F.G) { const int cnt = (int)__hip_atomic_load(F.ctl + CW_CNT + l * 64 + e, RLX_AGENT); const int lo = rowpfx[e] + cnt, hi = rowpfx[e + 1];
        for (int i = lo + F.tid; i < hi; i += NTHR) { ROWTOK[i] = 0; ROWW[i] = 0.f; ROWDST[i] = T_TOK * 7; } }
    const int sh0 = rowpfx[NEXP];
    for (int t = F.vcu * NTHR + F.tid; t < T_TOK; t += F.G * NTHR) { ROWTOK[sh0 + t] = t; ROWW[sh0 + t] = 1.0f; ROWDST[sh0 + t] = t * 7 + 6; }
}
template <bool NORM>
DI void moe_combine(Frame& F, const float* gate, const bf16* Xin, void* Xout, const LAS int* rowpfx, const float* ngain, const float* nshift, const float* nscale, bf16* Hn, unsigned char* Hn8) {
    const unsigned char* Y8 = (const unsigned char*)(F.ws + WS_Y);
    const int gw = F.vcu * NWAVES + F.wave, NGW = F.G * NWAVES;
    for (int t = gw; t < T_TOK; t += NGW) {
        const int b = t >> 13;
        u32x4 w[7];
#pragma unroll
        for (int k = 0; k < 7; ++k) w[k] = *(const u32x4*)(Y8 + ((size_t)t * 7 + k) * 1024 + F.lane * 16);
        const bf16* xp = Xin + (size_t)t * XPITCH + F.lane * 16; const float* gp = gate + b * 6144 + F.lane * 16;
        float xo[2][8]; unpack8(*(const u32x4*)xp, xo[0]); unpack8(*(const u32x4*)(xp + 8), xo[1]);
        if (!NORM) { asm volatile("s_waitcnt vmcnt(0)" ::: "memory"); }
        f32x4 xn[4]; float ss = 0.f;
#pragma unroll
        for (int q = 0; q < 4; ++q) { f32x4 a = (f32x4){0.f, 0.f, 0.f, 0.f};
#pragma unroll
            for (int k = 0; k < 7; ++k) { const unsigned ww = (q == 0) ? w[k].x : (q == 1) ? w[k].y : (q == 2) ? w[k].z : w[k].w;
                const f32x2 lo = __builtin_amdgcn_cvt_pk_f32_fp8((int)ww, false), hi = __builtin_amdgcn_cvt_pk_f32_fp8((int)ww, true); a.x += lo.x; a.y += lo.y; a.z += hi.x; a.w += hi.y; }
            const f32x4 x = (f32x4){xo[q >> 1][(q & 1) * 4 + 0], xo[q >> 1][(q & 1) * 4 + 1], xo[q >> 1][(q & 1) * 4 + 2], xo[q >> 1][(q & 1) * 4 + 3]}, g = *(const f32x4*)(gp + q * 4);
            xn[q] = x + g * a * (1.0f / Y8_SCALE);
            if (NORM) ss += (xn[q].x * xn[q].x + xn[q].y * xn[q].y) + (xn[q].z * xn[q].z + xn[q].w * xn[q].w); }
        if (NORM) { bf16* xq = (bf16*)Xout + (size_t)t * XPITCH + F.lane * 16;
            *(u32x4*)xq = (u32x4){pk2(xn[0].x, xn[0].y), pk2(xn[0].z, xn[0].w), pk2(xn[1].x, xn[1].y), pk2(xn[1].z, xn[1].w)};
            *(u32x4*)(xq + 8) = (u32x4){pk2(xn[2].x, xn[2].y), pk2(xn[2].z, xn[2].w), pk2(xn[3].x, xn[3].y), pk2(xn[3].z, xn[3].w)}; }
        else { float* xq = (float*)Xout + (size_t)t * DM + F.lane * 16;
#pragma unroll
            for (int q = 0; q < 4; ++q) *(f32x4*)(xq + q * 4) = xn[q]; }
        if (NORM) { const float rstd = 1.0f / sqrtf(wave_sum(ss) * (1.0f / DM) + EPS); const int col = F.lane * 16; u32x4 hb[2]; unsigned h8[4];
#pragma unroll
            for (int q = 0; q < 4; ++q) { const f32x4 g = *(const f32x4*)(ngain + col + q * 4), sh = *(const f32x4*)(nshift + b * 6144 + col + q * 4), sc = *(const f32x4*)(nscale + b * 6144 + col + q * 4);
                const f32x4 y = xn[q] * rstd * g * (sc + 1.0f) + sh;
                const unsigned p0 = pk2(y.x, y.y), p1 = pk2(y.z, y.w); if (q & 1) { hb[q >> 1].z = p0; hb[q >> 1].w = p1; } else { hb[q >> 1].x = p0; hb[q >> 1].y = p1; }
                int qq = 0; qq = __builtin_amdgcn_cvt_pk_fp8_f32(y.x, y.y, qq, false); qq = __builtin_amdgcn_cvt_pk_fp8_f32(y.z, y.w, qq, true); h8[q] = (unsigned)qq; }
            if (Hn) { *(u32x4*)(Hn + (size_t)t * DM + col) = hb[0]; *(u32x4*)(Hn + (size_t)t * DM + col + 8) = hb[1]; }
            *(u32x4*)(Hn8 + (size_t)t * DM + col) = (u32x4){h8[0], h8[1], h8[2], h8[3]}; }
    }
}

#ifndef ONLY
#define ONLY -1
#endif
#define PH(n) (ONLY < 0 || ONLY == (n))
#ifndef ONLY5
#define ONLY5 -1
#endif
#define PH5(n) (ONLY5 < 0 || ONLY5 == (n))
#ifdef PROBE_MASK
#define PROBE_PHASE(p) do { if (blockIdx.x == 0 && threadIdx.x == 0) { volatile LAS unsigned long long* _pp = (volatile LAS unsigned long long*)(F.lds + MISC_OFF + 64); const unsigned long long _n = __builtin_amdgcn_s_memrealtime(); if ((PROBE_MASK >> (p)) & 1) _pp[0] += _n - _pp[1]; _pp[1] = _n; } } while (0)
#else
#define PROBE_PHASE(p) do { } while (0)
#endif
#define GRID_BAR() do { XcdBarrier _b = bar; GAS unsigned* _p = (GAS unsigned*)_b.bar; asm volatile("" : "+s"(_p)); _b.bar = (unsigned*)_p; unsigned _x = _b.x; asm volatile("" : "+s"(_x)); _b.x = _x; xcd_barrier(_b); } while (0)
#define PHASE_BEGIN() do { int _t = threadIdx.x; asm volatile("" : "+v"(_t)); F.tid = _t; F.lane = _t & 63; F.wave = __builtin_amdgcn_readfirstlane(_t >> 6); GAS unsigned char* _w = (GAS unsigned char*)ws0; asm volatile("" : "+s"(_w)); F.ws = (unsigned char*)_w; ws = F.ws; F.ctl = (gu32*)(F.ws + WS_CTL); MOD = (float*)(ws + WS_MOD); modl = MOD + (size_t)l * 8 * 6144; } while (0)
template <int l> DI void run_layer(Frame& F, const XcdBarrier& bar, unsigned char* ws0, unsigned char* lds, LAS int* blkpfx, LAS int* rowpfx, int bx) {
    unsigned char* ws = ws0; float* MOD = (float*)(ws + WS_MOD);
        bf16* XA = (bf16*)F.out; bf16* XB = (bf16*)F.out + 1024;
        const float* modl = MOD + (size_t)l * 8 * 6144;
        if (PH(0)) { PHASE_BEGIN();
        if (l == 0) p0_adaln(F);
        p0_s5tab(F, l);
        p0_convert<false>(F, l, WIN_ALL_F8 ? 0x101Eu : 0x101Fu);
        }
        GRID_BAR();
        PROBE_PHASE(0);
        if (l == 0) {
        if (PH(1)) { PHASE_BEGIN();
        norm_rows<false, 2>(F, inp(F, I_X), inp(F, I_N1G) + l * DM, modl + 0, modl + 1024, WIN_ALL_F8 ? (bf16*)nullptr : (bf16*)(ws + WS_H), ws + WS_H8);
        }
        GRID_BAR();
        PROBE_PHASE(1);
        }
        if (PH(2)) { PHASE_BEGIN();
        { PolWinMix P; P.H = (const char*)(ws + WS_H); P.H8 = (const char*)(ws + WS_H8); P.WIN = (const char*)(ws + WS_WIN); P.WIN8 = (const char*)(ws + WS_WIN8); P.wsb = ws; P.ord.init(T_TOK, D_IN, F.G, bx);
          pg8::gemm_phase(F.lds + RING_OFF, P); }
        }
        GRID_BAR();
        PROBE_PHASE(2);
        if (PH(3)) { PHASE_BEGIN();
        p1_s5fill(F);
        { PolS5a P; P.UG = (const char*)(ws + WS_UG); P.BT1 = (const char*)(ws + WS_BT1); P.SLOC = (float*)(ws + WS_SLOC); P.ldb = 1024; P.G = F.G; P.c = F.vcu;
          pg8::gemm_phase(F.lds + RING_OFF, P); }
        PROBE_PHASE(20);
        hgrn_h1_phase(F, l);
        PROBE_PHASE(21);
        for (int u = F.vcu; u < 256; u += F.G) moba_prep_unit(F, l, u);
        }
        GRID_BAR();
        PROBE_PHASE(3);
        if (PH(4)) { PHASE_BEGIN();
        for (int u = F.vcu; u < 128; u += F.G) s5_carry_unit(F, u);
        for (int u = F.vcu; u < 256; u += F.G) hgrn_carry_unit(F, u);
        if (F.G == 256) {
            const int c = F.vcu & 127; moba_select_unit(F, l, (c >> 4) * 32 + (c & 15) + (F.vcu >= 128 ? 16 : 0)); }
        else for (int u = F.vcu; u < 256; u += F.G) moba_select_unit(F, l, u);
        }
        GRID_BAR();
        PROBE_PHASE(4);
        if (PH(5)) { PHASE_BEGIN();
        if (PH5(0)) { PolS5b P; P.UG = (const char*)(ws + WS_UG); P.S0 = (const char*)(ws + WS_S0); P.BT2 = (const char*)(ws + WS_BT2); P.Dsk = inp(F, I_SSMD) + l * 256; P.YS5 = ws + WS_YS5; P.ldb = 1152; P.G = F.G; P.c = F.vcu;
          pg8::gemm_phase(F.lds + RING_OFF, P); }
        PROBE_PHASE(17);
        if (PH5(1)) hgrn_h3_phase(F, l);
        PROBE_PHASE(18);
        if (PH5(2)) moba_gather_phase(F, l, lds);
        }
        GRID_BAR();
        PROBE_PHASE(5);
        if (PH(6)) { PHASE_BEGIN();
        moba_own_phase(F, lds);
        { PolGlu P; P.A = (const char*)(ws + WS_YS5); P.B = (const char*)(ws + WS_WGLU); P.ord.init(T_TOK, 2048, F.G, bx); P.GL = (const unsigned char*)(ws + WS_GL); P.MERGED = ws + WS_MERGED;
          pg8::gemm_phase(F.lds + RING_OFF, P); }
        }
        GRID_BAR();
        PROBE_PHASE(6);
        if (PH(7)) { PHASE_BEGIN();
        { PolRmw P; P.A1 = (const char*)(ws + WS_OH); P.A2 = (const char*)(ws + WS_OM); P.B1 = (const char*)(ws + WS_WHO); P.B2 = (const char*)(ws + WS_WMO);
          P.GL = (const unsigned char*)(ws + WS_GL); P.MERGED = ws + WS_MERGED; P.ord.init(T_TOK, DM, F.G, bx); P.nper = (P.ord.nwg > P.ord.c) ? (P.ord.nwg - P.ord.c + P.ord.G - 1) / P.ord.G : 0;
          pg8::gemm_phase(F.lds + RING_OFF, P); }
        }
        GRID_BAR();
        PROBE_PHASE(7);
        if (PH(9)) { PHASE_BEGIN();
        { PolWout<(l != 0)> P; P.A = (const char*)(ws + WS_MERGED); P.B = (const char*)(ws + WS_WOUT); P.ord.init(T_TOK, DM, F.G, bx); P.Xin = (l == 0) ? (const void*)inp(F, I_X) : (const void*)XB; P.X = XA; P.gate = modl + 2048;
          pg8::gemm_phase(F.lds + RING_OFF, P); }
        }
        GRID_BAR();
        PROBE_PHASE(9);
        if (PH(10)) { PHASE_BEGIN();
        norm_rows<true, 4>(F, XA, inp(F, I_N2G) + l * DM, modl + 3072, modl + 4096, (bf16*)nullptr, ws + WS_H2_8, (float*)(ws + WS_RSTD));
        p0_convert<true>(F, l, 0x0FC0u);
        WGBAR();
        router_prep(F, l, modl + 3072, modl + 4096);
        }
        GRID_BAR();
        PROBE_PHASE(10);
        if (PH(11)) { PHASE_BEGIN();
        { PolRouter P; P.setup(XA, XPITCH, ws + WS_WRB, DM, T_TOK, 256, F.G, bx); P.Bb = (const char*)(ws + WS_WRB); P.LOG = (float*)(ws + WS_LOGITS); P.RSTD = (const float*)(ws + WS_RSTD); P.PART = (const float*)(ws + WS_RPART);
          pg8::gemm_phase(F.lds + RING_OFF, P);
          if (F.G == 256) { int pm, pn; P.ord.next(0, pm, pn); WGBAR(); moe_route_unit256(F, l, pm); } }
        }
        if (F.G != 256) {
        GRID_BAR();
        for (int u = F.vcu; u < T_TOK / 512; u += F.G) moe_route_unit(F, l, u);
        }
        GRID_BAR();
        PROBE_PHASE(12);
        if (PH(13)) { PHASE_BEGIN();
        moe_tables(F, l, blkpfx, rowpfx);
        for (int u = F.vcu; u < T_TOK / 512; u += F.G) moe_scatter_unit(F, l, u, rowpfx);
        moe_fill_rows(F, l, rowpfx);
        }
        GRID_BAR();
        PROBE_PHASE(13);
        if (PH(14)) { PHASE_BEGIN();
        { PolGateUp P; P.gs.blkpfx = blkpfx; P.gs.nNt = 2; P.gs.G = F.G; P.gs.c = F.vcu; P.H2 = (const char*)(ws + WS_H2_8); P.WGU = (const char*)(ws + WS_WGU);
          P.ROWTOK = (const int*)(ws + WS_ROWTOK); P.ROWW = (const float*)(ws + WS_ROWW); P.HID = ws + WS_HID;
          pg8::gemm_phase(F.lds + RING_OFF, P); }
        }
        GRID_BAR();
        PROBE_PHASE(14);
        if (PH(15)) { PHASE_BEGIN();
        { PolDown P; P.gs.blkpfx = blkpfx; P.gs.nNt = 4; P.gs.G = F.G; P.gs.c = F.vcu; P.HIDp = (const char*)(ws + WS_HID); P.WD = (const char*)(ws + WS_WD); P.Y8 = (unsigned char*)(ws + WS_Y); P.ROWDST = (const int*)(ws + WS_ROWDST);
          pg8::gemm_phase(F.lds + RING_OFF, P); }
        }
        GRID_BAR();
        PROBE_PHASE(15);
        if (PH(16)) { PHASE_BEGIN();
        if (l == 0) moe_combine<true>(F, modl + 5120, XA, XB, rowpfx, inp(F, I_N1G) + DM, MOD + (size_t)8 * 6144 + 0, MOD + (size_t)8 * 6144 + 1024, WIN_ALL_F8 ? (bf16*)nullptr : (bf16*)(ws + WS_H), ws + WS_H8);
        else moe_combine<false>(F, modl + 5120, XA, F.out, rowpfx, nullptr, nullptr, nullptr, nullptr, nullptr);
        }
        GRID_BAR();
        PROBE_PHASE(16);
}
struct Args { const float* in[31]; float* out; unsigned char* ws; int pad0, pad1; };
__global__ void __launch_bounds__(NTHR, 2) fwd_kernel(Args args) {
    extern __shared__ __attribute__((aligned(16))) unsigned char lds[];
    Frame F;
    F.lds = (LAS unsigned char*)lds; F.ldsg = lds;
    F.MISC = (volatile LAS unsigned*)(F.lds + MISC_OFF);
    F.tid = threadIdx.x; F.lane = F.tid & 63; F.wave = __builtin_amdgcn_readfirstlane(F.tid >> 6);
    F.G = gridDim.x; { const int bx = blockIdx.x; F.vcu = (F.G % 8 == 0) ? (bx % 8) * (F.G / 8) + bx / 8 : bx; }
    F.ws = args.ws; F.ctl = (gu32*)(args.ws + WS_CTL); F.out = args.out;
    for (int u = F.tid; u < (LDS_BYTES - LDSCTL_OFF) / 4; u += NTHR) ((LAS unsigned*)(F.lds + LDSCTL_OFF))[u] = 0u;
    __syncthreads();
    if (F.tid < 31) ((LAS unsigned long long*)(F.lds + PTR_OFF))[F.tid] = (unsigned long long)args.in[F.tid];
    __syncthreads();
    XcdBarrier bar = xcd_barrier_post((unsigned*)(F.ctl + CW_BAR), F.MISC + 8);
    unsigned char* ws = F.ws;
    LAS int* blkpfx = (LAS int*)(F.lds + LDSCTL_OFF); LAS int* rowpfx = (LAS int*)(F.lds + LDSCTL_OFF + 320);
    float* MOD = (float*)(ws + WS_MOD);
    const int bx = (int)blockIdx.x;
#ifdef PROBE_MASK
    if (blockIdx.x == 0 && threadIdx.x == 0) { volatile LAS unsigned long long* _pp = (volatile LAS unsigned long long*)(F.lds + MISC_OFF + 64); _pp[0] = 0; _pp[1] = __builtin_amdgcn_s_memrealtime(); }
#endif
    run_layer<0>(F, bar, args.ws, lds, blkpfx, rowpfx, bx);
    run_layer<1>(F, bar, args.ws, lds, blkpfx, rowpfx, bx);
#ifdef PROBE_MASK
    if (blockIdx.x == 0 && threadIdx.x == 0) { const unsigned long long t0 = __builtin_amdgcn_s_memrealtime(); const unsigned long long _pa = ((volatile LAS unsigned long long*)(F.lds + MISC_OFF + 64))[0]; while (__builtin_amdgcn_s_memrealtime() - t0 < 3ull * _pa) __builtin_amdgcn_s_sleep(8); }
#endif
}

extern "C" void kernel_launch(void* const* d_in, const int* in_sizes, int n_in, void* d_out, int out_size, void* d_ws, size_t ws_size, hipStream_t stream) {
    static int grid = 0;
    if (grid == 0) {
        if (n_in != 31 || in_sizes[0] != T_TOK * DM || out_size != T_TOK * DM || ws_size < WS_END) {
            fprintf(stderr, "kernel_launch: unexpected shapes (n_in %d, in0 %d, out %d, ws %zu, need %zu); nothing launched\n", n_in, n_in > 0 ? in_sizes[0] : -1, out_size, ws_size, (size_t)WS_END); grid = -1; return; }
        int dev = 0, cus = 0, per_cu = 0;
        if (hipGetDevice(&dev) != hipSuccess || hipDeviceGetAttribute(&cus, hipDeviceAttributeMultiprocessorCount, dev) != hipSuccess) { grid = -1; return; }
        if (hipFuncSetAttribute((const void*)fwd_kernel, hipFuncAttributeMaxDynamicSharedMemorySize, LDS_BYTES) != hipSuccess) { fprintf(stderr, "kernel_launch: hipFuncSetAttribute failed\n"); grid = -1; return; }
        if (hipOccupancyMaxActiveBlocksPerMultiprocessor(&per_cu, (const void*)fwd_kernel, NTHR, LDS_BYTES) != hipSuccess || per_cu < 1) { fprintf(stderr, "kernel_launch: occupancy query says %d\n", per_cu); }
        (void)hipGetLastError();
        grid = cus;
    }
    if (grid < 0) return;
    if (hipMemsetAsync((char*)d_ws + WS_CTL, 0, CTL_ZERO_BYTES, stream) != hipSuccess) return;
    Args a{};
    for (int i = 0; i < 31; ++i) a.in[i] = (const float*)d_in[i];
    a.out = (float*)d_out; a.ws = (unsigned char*)d_ws; a.pad0 = 0; a.pad1 = 0;
    hipLaunchKernelGGL(fwd_kernel, dim3(grid), dim3(NTHR), LDS_BYTES, stream, a);
}
```
